# Optimizing an MI355X kernel written in HIP

```python
import math
import jax
import jax.numpy as jnp
from jax import lax
import numpy as np

D_MODEL = 1024
BATCH = 4
SEQ = 4096
DEPTH = 1
DEC_BATCH = 32
DEC_SEQ = 8
PAST_LEN = 8192
PAGE_SIZE = 128

N_ATT_HEADS = 16
ATT_HEAD_DIM = 64
N_KV_HEADS = 4
GQA = N_ATT_HEADS // N_KV_HEADS
ATT_WIDTH = N_ATT_HEADS * ATT_HEAD_DIM
KV_WIDTH = 2 * N_KV_HEADS * ATT_HEAD_DIM
BLK = 64
N_SEL = 16
WINDOW = 512
N_BRANCH = 3
Q_BLOCK = 128
N_BUCKETS = 32
MAX_DISTANCE = 128
SSD_HEADS = 16
SSD_HEAD_DIM = 64
SSD_INNER = SSD_HEADS * SSD_HEAD_DIM
SSD_GROUPS = 2
SSD_STATE = 128
CONV_W = 4
CONV_DIM = SSD_INNER + 2 * SSD_GROUPS * SSD_STATE
CHUNK = 128
D_MIX = ATT_WIDTH + SSD_INNER
D_FF = 2816
IN_SPLITS = (ATT_WIDTH, KV_WIDTH, KV_WIDTH, KV_WIDTH, N_BRANCH * N_ATT_HEADS, SSD_INNER, CONV_DIM, SSD_HEADS)
D_IN = ATT_WIDTH + 3 * KV_WIDTH + N_BRANCH * N_ATT_HEADS + SSD_INNER + CONV_DIM + SSD_HEADS
EPS = 1e-6

kernel_name = 'hymba_nsa_ssd_macaron_step'


def rmsnorm(x, g):
    xf = x.astype(jnp.float32)
    y = xf * lax.rsqrt(jnp.mean(xf * xf, axis=-1, keepdims=True) + EPS)
    return (y * g.astype(jnp.float32)).astype(x.dtype)


def swiglu(x, w_in, w_out):
    gate, up = jnp.split(x @ w_in, 2, axis=-1)
    return (jax.nn.silu(gate) * up) @ w_out


def ffn_sublayer(x, pre_g, post_g, w_in, w_out):
    return x + 0.5 * rmsnorm(swiglu(rmsnorm(x, pre_g), w_in, w_out), post_g)


def masked_softmax(s, mask):
    s = jnp.where(mask, s, -jnp.inf)
    m = jnp.max(s, axis=-1, keepdims=True)
    m = jnp.where(jnp.isfinite(m), m, 0.0)
    p = jnp.exp(s - m)
    return p / jnp.maximum(jnp.sum(p, axis=-1, keepdims=True), 1e-30)


def rel_bucket(dist):
    n = jnp.maximum(dist, 0)
    max_exact = N_BUCKETS // 2
    nf = jnp.maximum(n, 1).astype(jnp.float32)
    log_b = max_exact + (jnp.log(nf / max_exact) / math.log(MAX_DISTANCE / max_exact)
                         * (N_BUCKETS - max_exact)).astype(jnp.int32)
    return jnp.where(n < max_exact, n, jnp.minimum(log_b, N_BUCKETS - 1))


def split_in_proj(u):
    offs, acc = [], 0
    for s in IN_SPLITS[:-1]:
        acc += s
        offs.append(acc)
    return jnp.split(u, offs, axis=-1)


def mixer_inputs(x, pre_g, w_in):
    b, t = x.shape[0], x.shape[1]
    q, ckv, skv, wkv, gates, z, xbc, dt = split_in_proj(rmsnorm(x, pre_g) @ w_in)
    kv_shape = (b, t, N_KV_HEADS, 2, ATT_HEAD_DIM)
    return (q.reshape(b, t, N_KV_HEADS, GQA, ATT_HEAD_DIM), ckv.reshape(kv_shape), skv.reshape(kv_shape),
            wkv.reshape(kv_shape), gates, z, xbc, dt)


def mixer_output(x, o_att, o_ssd, att_out_norm, post_g, w_out):
    o = jnp.concatenate([rmsnorm(o_att, att_out_norm), o_ssd.astype(o_att.dtype)], axis=-1) @ w_out
    return x + rmsnorm(o, post_g)


def compress_blocks(kv_blocks, cmp_pe, w_cmp):
    out = jnp.einsum('bnlhcd,lcde->bnhce', kv_blocks, w_cmp, preferred_element_type=jnp.float32)
    return out + jnp.einsum('lcd,lcde->ce', cmp_pe, w_cmp, preferred_element_type=jnp.float32)


def nsa_query_block(q, pos, gates, kc, vc, fetch_sel, wkv, wpos, rel_table):
    b, t = q.shape[0], q.shape[1]
    nb = kc.shape[1]
    f32 = jnp.float32
    scale = ATT_HEAD_DIM ** -0.5
    table = rel_table.astype(f32)

    def head_bias(dist):
        bias = table[rel_bucket(dist)]
        return bias.reshape(dist.shape + (N_KV_HEADS, GQA)).transpose(2, 3, 0, 1)

    blk = jnp.arange(nb, dtype=jnp.int32)
    c_dist = pos[:, None] - ((blk + 1) * BLK - 1)[None, :]
    s_c = jnp.einsum('btkgd,bnkd->bkgtn', q, kc, preferred_element_type=f32) * scale + head_bias(c_dist)
    p_c = masked_softmax(s_c, c_dist >= 0)
    o_c = jnp.einsum('bkgtn,bnkd->btkgd', p_c, vc.astype(f32))

    cur = (pos // BLK)[:, None]
    forced = (blk[None] == 0) | (blk[None] == cur) | (blk[None] == cur - 1)
    imp = jnp.sum(p_c, axis=2)
    score = jnp.where(forced, jnp.inf, jnp.where(blk[None] <= cur, imp, -jnp.inf))
    top_s, idx = lax.top_k(score, min(N_SEL, nb))
    idx = idx.transpose(0, 2, 1, 3)
    sel_ok = (top_s > -jnp.inf).transpose(0, 2, 1, 3)
    k_sel, v_sel = fetch_sel(idx)
    n = idx.shape[-1]
    kpos = idx[..., None] * BLK + jnp.arange(BLK, dtype=jnp.int32)
    s_dist = pos[None, :, None, None, None] - kpos
    s_mask = sel_ok[..., None] & (s_dist >= 0)
    kv_ix = jnp.arange(N_KV_HEADS)[None, None, :, None, None]
    s_bias = table.reshape(N_BUCKETS, N_KV_HEADS, GQA)[rel_bucket(s_dist), kv_ix]
    s_s = jnp.einsum('btkgd,btknld->btkgnl', q, k_sel, preferred_element_type=f32) * scale \
        + jnp.moveaxis(s_bias, -1, 3)
    p_s = masked_softmax(s_s.reshape(b, t, N_KV_HEADS, GQA, n * BLK),
                         s_mask.reshape(b, t, N_KV_HEADS, 1, n * BLK))
    o_s = jnp.einsum('btkgm,btkmd->btkgd', p_s,
                     v_sel.reshape(b, t, N_KV_HEADS, n * BLK, ATT_HEAD_DIM).astype(f32))

    w_dist = pos[:, None] - wpos[None, :]
    w_mask = (w_dist >= 0) & (w_dist < WINDOW) & (wpos[None, :] >= 0)
    s_w = jnp.einsum('btkgd,bskd->bkgts', q, wkv[..., 0, :], preferred_element_type=f32) * scale + head_bias(w_dist)
    p_w = masked_softmax(s_w, w_mask)
    o_w = jnp.einsum('bkgts,bskd->btkgd', p_w, wkv[..., 1, :].astype(f32))

    g = jax.nn.sigmoid(gates.astype(f32)).reshape(b, t, N_KV_HEADS, GQA, N_BRANCH)
    o = g[..., 0:1] * o_c + g[..., 1:2] * o_s + g[..., 2:3] * o_w
    return o.reshape(b, t, ATT_WIDTH).astype(q.dtype)


def nsa_prompt(q, gates, cmp_kv, slc_kv, win_kv, cmp_pe, w_cmp, rel_table):
    b, s = q.shape[0], q.shape[1]
    nb = s // BLK
    ckv = compress_blocks(cmp_kv.reshape(b, nb, BLK, N_KV_HEADS, 2, ATT_HEAD_DIM), cmp_pe, w_cmp)
    kc, vc = ckv[..., 0, :], ckv[..., 1, :]
    slc_blocks = slc_kv.reshape(b, nb, BLK, N_KV_HEADS, 2, ATT_HEAD_DIM)
    b_ix = jnp.arange(b)[:, None, None, None]
    h_ix = jnp.arange(N_KV_HEADS)[None, None, :, None]

    def fetch(idx):
        rows = slc_blocks[b_ix, idx, :, h_ix]
        return rows[..., 0, :], rows[..., 1, :]

    win_pad = jnp.pad(win_kv, ((0, 0), (WINDOW, 0), (0, 0), (0, 0), (0, 0)))
    nq = s // Q_BLOCK
    qb = jnp.moveaxis(q.reshape(b, nq, Q_BLOCK, N_KV_HEADS, GQA, ATT_HEAD_DIM), 1, 0)
    gb = jnp.moveaxis(gates.reshape(b, nq, Q_BLOCK, N_BRANCH * N_ATT_HEADS), 1, 0)

    def one_block(args):
        i, q_i, g_i = args
        s0 = i * Q_BLOCK
        pos = s0 + jnp.arange(Q_BLOCK, dtype=jnp.int32)
        wkv = lax.dynamic_slice_in_dim(win_pad, s0, WINDOW + Q_BLOCK, axis=1)
        wpos = s0 - WINDOW + jnp.arange(WINDOW + Q_BLOCK, dtype=jnp.int32)
        return nsa_query_block(q_i, pos, g_i, kc, vc, fetch, wkv, wpos, rel_table)

    o = lax.map(one_block, (jnp.arange(nq, dtype=jnp.int32), qb, gb))
    return jnp.moveaxis(o, 0, 1).reshape(b, s, ATT_WIDTH)


def nsa_sample(q, gates, cmp_new, slc_new, win_new, cache_cmp, cache_slc, cache_win, page_table,
               cmp_pe, w_cmp, rel_table):
    b, t = q.shape[0], q.shape[1]
    npb = PAST_LEN // BLK
    nbn = -(-t // BLK)
    bpp = PAGE_SIZE // BLK
    pad = ((0, 0), (0, nbn * BLK - t), (0, 0), (0, 0), (0, 0))
    new_shape = (b, nbn, BLK, N_KV_HEADS, 2, ATT_HEAD_DIM)
    past_cmp = cache_cmp[page_table].reshape(b, npb, BLK, N_KV_HEADS, 2, ATT_HEAD_DIM)
    ckv = jnp.concatenate([compress_blocks(past_cmp, cmp_pe, w_cmp),
                           compress_blocks(jnp.pad(cmp_new, pad).reshape(new_shape), cmp_pe, w_cmp)], axis=1)
    kc, vc = ckv[..., 0, :], ckv[..., 1, :]
    pool = cache_slc.reshape((-1, bpp, BLK, N_KV_HEADS, 2, ATT_HEAD_DIM))
    new_blocks = jnp.pad(slc_new, pad).reshape(new_shape)
    b_ix = jnp.arange(b)[:, None, None, None]
    h_ix = jnp.arange(N_KV_HEADS)[None, None, :, None]

    def fetch(idx):
        in_past = (idx < npb)[..., None, None, None]
        pidx = jnp.minimum(idx, npb - 1)
        phys = page_table[b_ix, pidx // bpp]
        from_pool = pool[phys, pidx % bpp, :, h_ix]
        from_new = new_blocks[b_ix, jnp.clip(idx - npb, 0, nbn - 1), :, h_ix]
        rows = jnp.where(in_past, from_pool, from_new)
        return rows[..., 0, :], rows[..., 1, :]

    w_buf = cache_win.shape[1]
    wkv = jnp.concatenate([cache_win.astype(win_new.dtype), win_new], axis=1)
    wpos = PAST_LEN - w_buf + jnp.arange(w_buf + t, dtype=jnp.int32)
    pos = PAST_LEN + jnp.arange(t, dtype=jnp.int32)
    o = nsa_query_block(q, pos, gates, kc, vc, fetch, wkv, wpos, rel_table)
    return o, wkv[:, -min(WINDOW, w_buf + t):]


def causal_dwconv(xpad, w, bias):
    out = lax.conv_general_dilated(xpad, w[:, None, :].astype(xpad.dtype), window_strides=(1,), padding='VALID',
                                   dimension_numbers=('NWC', 'WIO', 'NWC'), feature_group_count=xpad.shape[-1])
    return out + bias


def ssd_scan(x, dt, a, b_in, c_in, h0):
    bsz, seq, nh, hp = x.shape
    r = nh // SSD_GROUPS
    cl = min(CHUNK, seq)
    nc = seq // cl
    f32 = jnp.float32
    xdt = (x.astype(f32) * dt[..., None]).reshape(bsz, nc, cl, SSD_GROUPS, r, hp)
    la = jnp.moveaxis((dt * a).reshape(bsz, nc, cl, SSD_GROUPS, r), 2, -1)
    bc = b_in.astype(f32).reshape(bsz, nc, cl, SSD_GROUPS, SSD_STATE)
    cc = c_in.astype(f32).reshape(bsz, nc, cl, SSD_GROUPS, SSD_STATE)
    cs = jnp.cumsum(la, axis=-1)
    causal = jnp.tril(jnp.ones((cl, cl), bool))
    decay = jnp.where(causal, jnp.exp(jnp.where(causal, cs[..., :, None] - cs[..., None, :], 0.0)), 0.0)
    cb = jnp.einsum('bclgn,bcsgn->bcgls', cc, bc)
    y_diag = jnp.einsum('bcgrls,bcsgrp->bclgrp', cb[:, :, :, None] * decay, xdt)
    to_end = jnp.exp(cs[..., -1:] - cs)
    chunk_states = jnp.einsum('bclgn,bcgrl,bclgrp->bcgrpn', bc, to_end, xdt)
    chunk_decay = jnp.exp(cs[..., -1])

    def step(h, inp):
        st, dc = inp
        return h * dc[..., None, None] + st, h

    h_last, h_start = lax.scan(step, h0.astype(f32).reshape(bsz, SSD_GROUPS, r, hp, SSD_STATE),
                               (jnp.moveaxis(chunk_states, 1, 0), jnp.moveaxis(chunk_decay, 1, 0)))
    h_start = jnp.moveaxis(h_start, 0, 1)
    y_off = jnp.einsum('bclgn,bcgrpn,bcgrl->bclgrp', cc, h_start, jnp.exp(cs))
    y = (y_diag + y_off).reshape(bsz, seq, nh, hp)
    return y, h_last.reshape(bsz, nh, hp, SSD_STATE)


def ssd_mixer(z, xbc, dt_raw, conv_prev, h0, conv_w, conv_b, dt_bias, a_log, d_skip, ssd_norm):
    bsz, seq = xbc.shape[0], xbc.shape[1]
    f32 = jnp.float32
    xpad = jnp.concatenate([conv_prev.astype(xbc.dtype), xbc], axis=1)
    new_conv = xpad[:, -(CONV_W - 1):]
    u = jax.nn.silu(causal_dwconv(xpad, conv_w, conv_b).astype(f32))
    xs = u[..., :SSD_INNER].reshape(bsz, seq, SSD_HEADS, SSD_HEAD_DIM)
    bm = u[..., SSD_INNER:SSD_INNER + SSD_GROUPS * SSD_STATE].reshape(bsz, seq, SSD_GROUPS, SSD_STATE)
    cm = u[..., SSD_INNER + SSD_GROUPS * SSD_STATE:].reshape(bsz, seq, SSD_GROUPS, SSD_STATE)
    dt = jax.nn.softplus(dt_raw.astype(f32) + dt_bias.astype(f32))
    a = -jnp.exp(a_log.astype(f32))
    y, h_last = ssd_scan(xs, dt, a, bm, cm, h0)
    y = (y + d_skip.astype(f32)[:, None] * xs).reshape(bsz, seq, SSD_INNER) * jax.nn.silu(z.astype(f32))
    yg = y.reshape(bsz, seq, SSD_GROUPS, SSD_INNER // SSD_GROUPS)
    yg = yg * lax.rsqrt(jnp.mean(yg * yg, axis=-1, keepdims=True) + EPS)
    y = yg.reshape(bsz, seq, SSD_INNER) * ssd_norm.astype(f32)
    return y.astype(z.dtype), h_last.astype(z.dtype), new_conv


def setup_inputs(seed: int = 0) -> dict:
    key = jax.random.key(seed)
    ks = list(jax.random.split(key, 32))

    def nrm(i, shape, scale):
        return jax.random.normal(ks[i], shape, jnp.float32) * scale

    n_pages = PAST_LEN // PAGE_SIZE
    n_used = DEC_BATCH * n_pages
    n_pool = n_used + max(1, n_used // 4)
    page_table = jax.random.permutation(ks[0], n_pool)[:n_used].reshape(DEC_BATCH, n_pages).astype(jnp.int32)
    w_buf = min(WINDOW, PAST_LEN)
    kv = (N_KV_HEADS, 2, ATT_HEAD_DIM)
    dt0 = jnp.exp(jax.random.uniform(ks[1], (DEPTH, SSD_HEADS), jnp.float32, math.log(1e-3), math.log(1e-1)))
    return {
        'x_prompt': nrm(2, (BATCH, SEQ, D_MODEL), 1.0),
        'x_sample': nrm(3, (DEC_BATCH, DEC_SEQ, D_MODEL), 1.0),
        'cache_cmp_kv': nrm(4, (DEPTH, n_pool, PAGE_SIZE) + kv, 1.0),
        'cache_slc_kv': nrm(5, (DEPTH, n_pool, PAGE_SIZE) + kv, 1.0),
        'cache_win_kv': nrm(6, (DEPTH, DEC_BATCH, w_buf) + kv, 1.0),
        'state_ssm': nrm(7, (DEPTH, DEC_BATCH, SSD_HEADS, SSD_HEAD_DIM, SSD_STATE), 0.3),
        'state_conv': nrm(8, (DEPTH, DEC_BATCH, CONV_W - 1, CONV_DIM), 1.0),
        'page_table': page_table,
        'rel_table': nrm(9, (N_BUCKETS, N_ATT_HEADS), 0.5),
        'ffn1_pre': 1.0 + nrm(10, (DEPTH, D_MODEL), 0.05),
        'ffn1_post': 1.0 + nrm(11, (DEPTH, D_MODEL), 0.05),
        'ffn1_w_in': nrm(12, (DEPTH, D_MODEL, 2 * D_FF), D_MODEL ** -0.5),
        'ffn1_w_out': nrm(13, (DEPTH, D_FF, D_MODEL), D_FF ** -0.5),
        'mix_pre': 1.0 + nrm(14, (DEPTH, D_MODEL), 0.05),
        'mix_post': 1.0 + nrm(15, (DEPTH, D_MODEL), 0.05),
        'w_in': nrm(16, (DEPTH, D_MODEL, D_IN), D_MODEL ** -0.5),
        'w_out': nrm(17, (DEPTH, D_MIX, D_MODEL), D_MIX ** -0.5),
        'att_out_norm': 1.0 + nrm(18, (DEPTH, ATT_WIDTH), 0.05),
        'cmp_pe': nrm(19, (DEPTH, BLK, 2, ATT_HEAD_DIM), 0.5),
        'w_cmp': nrm(20, (DEPTH, BLK, 2, ATT_HEAD_DIM, ATT_HEAD_DIM), (BLK * ATT_HEAD_DIM) ** -0.5),
        'conv_w': nrm(21, (DEPTH, CONV_W, CONV_DIM), CONV_W ** -0.5),
        'conv_b': nrm(22, (DEPTH, CONV_DIM), 0.02),
        'dt_bias': dt0 + jnp.log(-jnp.expm1(-dt0)),
        'a_log': jnp.log(jax.random.uniform(ks[23], (DEPTH, SSD_HEADS), jnp.float32, 1.0, 16.0)),
        'd_skip': 1.0 + nrm(24, (DEPTH, SSD_HEADS), 0.1),
        'ssd_norm': 1.0 + nrm(25, (DEPTH, SSD_INNER), 0.05),
        'ffn2_pre': 1.0 + nrm(26, (DEPTH, D_MODEL), 0.05),
        'ffn2_post': 1.0 + nrm(27, (DEPTH, D_MODEL), 0.05),
        'ffn2_w_in': nrm(28, (DEPTH, D_MODEL, 2 * D_FF), D_MODEL ** -0.5),
        'ffn2_w_out': nrm(29, (DEPTH, D_FF, D_MODEL), D_FF ** -0.5),
    }


def reference(x_prompt, x_sample, cache_cmp_kv, cache_slc_kv, cache_win_kv, state_ssm, state_conv, page_table,
              rel_table, ffn1_pre, ffn1_post, ffn1_w_in, ffn1_w_out, mix_pre, mix_post, w_in, w_out, att_out_norm,
              cmp_pe, w_cmp, conv_w, conv_b, dt_bias, a_log, d_skip, ssd_norm,
              ffn2_pre, ffn2_post, ffn2_w_in, ffn2_w_out):
    yp, ys = x_prompt, x_sample
    pc, psl, pw, pssm, pconv = [], [], [], [], []
    sc, ssl, sw, sssm, sconv = [], [], [], [], []
    for l in range(DEPTH):
        yp = ffn_sublayer(yp, ffn1_pre[l], ffn1_post[l], ffn1_w_in[l], ffn1_w_out[l])
        ys = ffn_sublayer(ys, ffn1_pre[l], ffn1_post[l], ffn1_w_in[l], ffn1_w_out[l])

        q, ckv, skv, wkv, gates, z, xbc, dt = mixer_inputs(yp, mix_pre[l], w_in[l])
        o_att = nsa_prompt(q, gates, ckv, skv, wkv, cmp_pe[l], w_cmp[l], rel_table)
        conv0 = jnp.zeros((yp.shape[0], CONV_W - 1, CONV_DIM), xbc.dtype)
        h0 = jnp.zeros((yp.shape[0], SSD_HEADS, SSD_HEAD_DIM, SSD_STATE), jnp.float32)
        o_ssd, h_new, conv_new = ssd_mixer(z, xbc, dt, conv0, h0, conv_w[l], conv_b[l], dt_bias[l], a_log[l],
                                           d_skip[l], ssd_norm[l])
        yp = mixer_output(yp, o_att, o_ssd, att_out_norm[l], mix_post[l], w_out[l])
        pc.append(ckv)
        psl.append(skv)
        pw.append(wkv[:, -min(WINDOW, wkv.shape[1]):])
        pssm.append(h_new)
        pconv.append(conv_new)

        q, ckv, skv, wkv, gates, z, xbc, dt = mixer_inputs(ys, mix_pre[l], w_in[l])
        o_att, win_state = nsa_sample(q, gates, ckv, skv, wkv, cache_cmp_kv[l], cache_slc_kv[l], cache_win_kv[l],
                                      page_table, cmp_pe[l], w_cmp[l], rel_table)
        o_ssd, h_new, conv_new = ssd_mixer(z, xbc, dt, state_conv[l], state_ssm[l], conv_w[l], conv_b[l],
                                           dt_bias[l], a_log[l], d_skip[l], ssd_norm[l])
        ys = mixer_output(ys, o_att, o_ssd, att_out_norm[l], mix_post[l], w_out[l])
        sc.append(ckv)
        ssl.append(skv)
        sw.append(win_state)
        sssm.append(h_new)
        sconv.append(conv_new)

        yp = ffn_sublayer(yp, ffn2_pre[l], ffn2_post[l], ffn2_w_in[l], ffn2_w_out[l])
        ys = ffn_sublayer(ys, ffn2_pre[l], ffn2_post[l], ffn2_w_in[l], ffn2_w_out[l])

    p_cmp_kv = jnp.stack(pc)
    p_slc_kv = jnp.stack(psl)
    p_win_kv = jnp.stack(pw)
    p_ssm = jnp.stack(pssm)
    p_conv = jnp.stack(pconv)
    s_cmp_kv = jnp.stack(sc)
    s_slc_kv = jnp.stack(ssl)
    s_win_kv = jnp.stack(sw)
    s_ssm = jnp.stack(sssm)
    s_conv = jnp.stack(sconv)
    return (yp, ys, p_cmp_kv, p_slc_kv, p_win_kv, p_ssm, p_conv, s_cmp_kv, s_slc_kv, s_win_kv, s_ssm, s_conv)
```

```cpp
#include <hip/hip_runtime.h>
#include <cstdio>
#include <cstdint>
namespace pg8 {
#define PG8_LAS __attribute__((address_space(3)))
typedef unsigned short bf16_t;
typedef short bf16x8 __attribute__((ext_vector_type(8)));
typedef float f32x4 __attribute__((ext_vector_type(4)));
typedef unsigned u32x4 __attribute__((ext_vector_type(4)));
constexpr int BM = 256, BK = 64, HALF = 128, HTB = HALF * BK * 2  , STAGE_BYTES = 8 * HTB, NXCD = 8, WGM = 8;

__host__ __device__ __forceinline__ int lds_byte(int r, int c) { const int st = (r >> 4) * 2 + (c >> 5), rr = r & 15, cc = c & 31, ob = rr * 64 + cc * 2; return st * 1024 + (ob ^ (((ob >> 9) & 1) << 5)); }
__host__ __device__ __forceinline__ void stage_rc(int b, int& R, int& C) { const int st = b / 1024, sb = b % 1024, swz = sb ^ (((sb >> 9) & 1) << 5); R = (st >> 1) * 16 + swz / 64; C = (st & 1) * 32 + (swz % 64) / 2; }
__host__ __device__ __forceinline__ int perm32(int rho) { const int n = rho >> 4, i = rho & 15; return 8 * (i >> 2) + 4 * n + (i & 3); }

struct Unit { int pm, pn; };
struct Gemm { const bf16_t* A; const bf16_t* Bt; int M, N, K; };

struct StaticOrder {
    int nM, nN, nwg, G, c;
    __host__ __device__ void init(int M, int N, int G_, int c_) { nM = M / BM; nN = N / BM; nwg = nM * nN; G = G_; c = c_; }
    __host__ __device__ bool next(int i, Unit& u) const {
        const long L = (long)i * G + c; if (L >= nwg) return false;
        int wgid = (int)L; { const int q = nwg / NXCD, r = nwg % NXCD, xcd = wgid % NXCD, off = wgid / NXCD; wgid = (xcd < r ? xcd * (q + 1) : r * (q + 1) + (xcd - r) * q) + off; }
        const int nig = WGM * nN, gid = wgid / nig, fm = gid * WGM, gsz = (nM - fm) < WGM ? (nM - fm) : WGM;
        u.pm = fm + ((wgid % nig) % gsz); u.pn = (wgid % nig) / gsz; return true;
    }
    __device__ __forceinline__ void a_ready(const Unit&) const {}
    __device__ __forceinline__ void done(const Unit&) const {}
};

__device__ __forceinline__ unsigned cvt_pk_bf16(float lo, float hi) { unsigned r; asm volatile("v_cvt_pk_bf16_f32 %0, %1, %2" : "=v"(r) : "v"(lo), "v"(hi)); return r; }
template <class Epi, class Sched, bool ALIGN_EPI = false, bool SP2 = false>
__device__ __forceinline__ void gemm_phase(PG8_LAS unsigned char* lds, const Gemm g, const Sched& S, const Epi& E) {
    const int tid = threadIdx.x, wid = __builtin_amdgcn_readfirstlane(tid >> 6), lane = tid & 63, wr = wid >> 2, wc = wid & 3, fr = lane & 15, fq = lane >> 4;
    const int K = g.K, nt = K / BK;
    unsigned voffA[2], voffB[2];
#pragma unroll
    for (int i = 0; i < 2; ++i) { int R, C; stage_rc(tid * 16 + i * 8192, R, C); const int Rb = Epi::PERM ? ((R & ~31) + perm32(R & 31)) : R;
        voffA[i] = (unsigned)(R * K + C) * 2u; voffB[i] = (unsigned)(Rb * K + C) * 2u; }
    const size_t kstep = (size_t)(BK * 2);
    const size_t hstep = (size_t)HALF * K * 2;
    const size_t tstep = 2 * hstep;
    const unsigned ldsw = (unsigned)wid * 1024u;
    const int aoff = lds_byte(wr * 64 + fr, fq * 8), boff = lds_byte(wc * 32 + fr, fq * 8);
#define PG8_SA(b, h) (((b) * 2 + (h)) * HTB)
#define PG8_SB(b, h) ((4 + (b) * 2 + (h)) * HTB)
#define PG8_STAGE(bufoff, gbase, voff) do { _Pragma("unroll") for (int _i = 0; _i < 2; ++_i) \
        __builtin_amdgcn_global_load_lds((const unsigned*)((const char*)(gbase) + (voff)[_i]), (PG8_LAS unsigned*)(lds + (bufoff) + ldsw + _i * 8192), 16, 0, 0); } while (0)
#define PG8_LDA(dst, b, h) do { _Pragma("unroll") for (int m = 0; m < 4; ++m) _Pragma("unroll") for (int k = 0; k < 2; ++k) dst[m][k] = *(const PG8_LAS bf16x8*)(lds + PG8_SA(b, h) + aoff + m * 2048 + k * 1024); } while (0)
#define PG8_LDB(dst, b, h) do { _Pragma("unroll") for (int n = 0; n < 2; ++n) _Pragma("unroll") for (int k = 0; k < 2; ++k) dst[n][k] = *(const PG8_LAS bf16x8*)(lds + PG8_SB(b, h) + boff + n * 2048 + k * 1024); } while (0)
#define PG8_MMA(ai, bj, At, Bt) do { __builtin_amdgcn_s_setprio(1); _Pragma("unroll") for (int m = 0; m < 4; ++m) _Pragma("unroll") for (int n = 0; n < 2; ++n) _Pragma("unroll") for (int k = 0; k < 2; ++k) \
        acc[ai][bj][m][n] = __builtin_amdgcn_mfma_f32_16x16x32_bf16(Bt[n][k], At[m][k], acc[ai][bj][m][n], 0, 0, 0); __builtin_amdgcn_s_setprio(0); } while (0)
#define PG8_WAIT_V(n) asm volatile("s_waitcnt vmcnt(" #n ")" ::: "memory")
#define PG8_WAIT_L(n) asm volatile("s_waitcnt lgkmcnt(" #n ")" ::: "memory")
#define PG8_BAR __builtin_amdgcn_s_barrier()
#define PG8_SCHED __builtin_amdgcn_sched_barrier(0)
    Unit cur, nxt; int ui = 0;
    if (!S.next(0, cur)) return;
    f32x4 acc[2][2][4][2];
#pragma unroll
    for (int a = 0; a < 2; ++a)
#pragma unroll
        for (int b = 0; b < 2; ++b)
#pragma unroll
            for (int m = 0; m < 4; ++m)
#pragma unroll
                for (int n = 0; n < 2; ++n) acc[a][b][m][n] = (f32x4){0.f, 0.f, 0.f, 0.f};
    bf16x8 At[4][2], B0[2][2], B1[2][2];
    const char* cA = (const char*)g.A + (size_t)cur.pm * tstep; const char* cB = (const char*)g.Bt + (size_t)cur.pn * tstep;
    S.a_ready(cur);
    if constexpr (SP2) {
        PG8_STAGE(PG8_SB(0, 0), cB, voffB); PG8_STAGE(PG8_SB(0, 1), cB + hstep, voffB); PG8_STAGE(PG8_SA(0, 0), cA, voffA); PG8_STAGE(PG8_SA(0, 1), cA + hstep, voffA);
        if (wr == 1) PG8_BAR;
        PG8_WAIT_V(2); PG8_BAR;
        PG8_STAGE(PG8_SB(1, 0), cB + kstep, voffB); PG8_STAGE(PG8_SA(1, 0), cA + kstep, voffA); PG8_STAGE(PG8_SB(1, 1), cB + hstep + kstep, voffB);
        PG8_WAIT_V(6); PG8_BAR;
    } else {
        PG8_STAGE(PG8_SB(0, 0), cB, voffB); PG8_STAGE(PG8_SA(0, 0), cA, voffA); PG8_STAGE(PG8_SB(0, 1), cB + hstep, voffB); PG8_STAGE(PG8_SA(0, 1), cA + hstep, voffA);
        if (wr == 1) PG8_BAR;
        PG8_WAIT_V(4); PG8_BAR;
        PG8_STAGE(PG8_SB(1, 0), cB + kstep, voffB); PG8_STAGE(PG8_SA(1, 0), cA + kstep, voffA); PG8_STAGE(PG8_SB(1, 1), cB + hstep + kstep, voffB);
        PG8_WAIT_V(6); PG8_BAR;
    }
    for (;;) {
        const bool has_next = S.next(ui + 1, nxt);
        const char* nA = has_next ? (const char*)g.A + (size_t)nxt.pm * tstep : cA; const char* nB = has_next ? (const char*)g.Bt + (size_t)nxt.pn * tstep : cB;
        for (int t = 0; t < nt; t += 2) {
            const bool last = (t == nt - 2);
            const char* a1 = cA + (size_t)(t + 1) * kstep;
            const char* a2 = last ? nA : cA + (size_t)(t + 2) * kstep; const char* b2 = last ? nB : cB + (size_t)(t + 2) * kstep;
            const char* a3 = a2 + kstep; const char* b3 = b2 + kstep;
            if (last && has_next) S.a_ready(nxt);
            if constexpr (SP2) {
            PG8_LDB(B0, 0, 0); PG8_LDB(B1, 0, 1); PG8_SCHED; PG8_LDA(At, 0, 0); PG8_STAGE(PG8_SA(1, 1), a1 + hstep, voffA);
            PG8_WAIT_V(8); PG8_WAIT_L(0); PG8_BAR; PG8_MMA(0, 0, At, B0); PG8_MMA(0, 1, At, B1); PG8_BAR; PG8_SCHED;
            PG8_LDA(At, 0, 1); PG8_STAGE(PG8_SB(0, 0), b2, voffB); PG8_STAGE(PG8_SB(0, 1), b2 + hstep, voffB); PG8_STAGE(PG8_SA(0, 0), a2, voffA);
            PG8_WAIT_V(8); PG8_WAIT_L(0); PG8_BAR; PG8_MMA(1, 0, At, B0); PG8_MMA(1, 1, At, B1); PG8_BAR; PG8_SCHED;
            PG8_LDB(B0, 1, 0); PG8_LDB(B1, 1, 1); PG8_SCHED; PG8_LDA(At, 1, 0); PG8_STAGE(PG8_SA(0, 1), a2 + hstep, voffA);
            PG8_WAIT_V(8); PG8_WAIT_L(0); PG8_BAR; PG8_MMA(0, 0, At, B0); PG8_MMA(0, 1, At, B1); PG8_BAR; PG8_SCHED;
            PG8_LDA(At, 1, 1); PG8_STAGE(PG8_SB(1, 0), b3, voffB); PG8_STAGE(PG8_SB(1, 1), b3 + hstep, voffB); PG8_STAGE(PG8_SA(1, 0), a3, voffA);
            PG8_WAIT_V(8); PG8_WAIT_L(0); PG8_BAR; PG8_MMA(1, 0, At, B0); PG8_MMA(1, 1, At, B1); PG8_BAR; PG8_SCHED;
            } else {
            PG8_LDB(B0, 0, 0); PG8_SCHED; PG8_LDA(At, 0, 0); PG8_STAGE(PG8_SA(1, 1), a1 + hstep, voffA);
            PG8_WAIT_L(8); PG8_BAR; PG8_WAIT_L(0); PG8_MMA(0, 0, At, B0); PG8_BAR; PG8_SCHED;
            PG8_LDB(B1, 0, 1); PG8_STAGE(PG8_SB(0, 0), b2, voffB);
            PG8_BAR; PG8_WAIT_L(0); PG8_MMA(0, 1, At, B1); PG8_BAR;
            PG8_LDA(At, 0, 1); PG8_STAGE(PG8_SA(0, 0), a2, voffA);
            PG8_BAR; PG8_WAIT_L(0); PG8_MMA(1, 0, At, B0); PG8_BAR; PG8_SCHED;
            PG8_STAGE(PG8_SB(0, 1), b2 + hstep, voffB);
            PG8_WAIT_V(6); PG8_BAR; PG8_MMA(1, 1, At, B1); PG8_BAR;
            PG8_LDB(B0, 1, 0); PG8_SCHED; PG8_LDA(At, 1, 0); PG8_STAGE(PG8_SA(0, 1), a2 + hstep, voffA);
            PG8_WAIT_L(8); PG8_BAR; PG8_WAIT_L(0); PG8_MMA(0, 0, At, B0); PG8_BAR; PG8_SCHED;
            PG8_LDB(B1, 1, 1); PG8_STAGE(PG8_SB(1, 0), b3, voffB);
            PG8_BAR; PG8_WAIT_L(0); PG8_MMA(0, 1, At, B1); PG8_BAR;
            PG8_LDA(At, 1, 1); PG8_STAGE(PG8_SA(1, 0), a3, voffA);
            PG8_BAR; PG8_WAIT_L(0); PG8_MMA(1, 0, At, B0); PG8_BAR; PG8_SCHED;
            PG8_STAGE(PG8_SB(1, 1), b3 + hstep, voffB);
            PG8_WAIT_V(6); PG8_BAR; PG8_MMA(1, 1, At, B1); PG8_BAR;
            }
        }
        if constexpr (ALIGN_EPI) { if (wr == 0) PG8_BAR; }
        if constexpr (!Epi::AFTER_DRAIN) { E(acc, cur, wr, wc, fr, fq); S.done(cur); }
        if (!has_next) break;
#pragma unroll
        for (int a = 0; a < 2; ++a)
#pragma unroll
            for (int b = 0; b < 2; ++b)
#pragma unroll
                for (int m = 0; m < 4; ++m)
#pragma unroll
                    for (int n = 0; n < 2; ++n) acc[a][b][m][n] = (f32x4){0.f, 0.f, 0.f, 0.f};
        cur = nxt; cA = nA; cB = nB; ++ui;
        if constexpr (ALIGN_EPI) { if (wr == 1) PG8_BAR; }
    }
    PG8_WAIT_V(0);
    if constexpr (!ALIGN_EPI) { if (wr == 0) PG8_BAR; }
    PG8_BAR;
    if constexpr (Epi::AFTER_DRAIN) { E.fused(acc, cur, wr, wc, fr, fq, lds, wid, lane); S.done(cur); }
#undef PG8_SA
#undef PG8_SB
#undef PG8_STAGE
#undef PG8_LDA
#undef PG8_LDB
#undef PG8_MMA
#undef PG8_WAIT_V
#undef PG8_WAIT_L
#undef PG8_BAR
#undef PG8_SCHED
}
}
#define GAS __attribute__((address_space(1)))
#define LAS __attribute__((address_space(3)))
typedef unsigned short bf16;
typedef unsigned v4u __attribute__((ext_vector_type(4)));
typedef float f32x4 __attribute__((ext_vector_type(4)));
typedef short bf16x8 __attribute__((ext_vector_type(8)));
typedef GAS unsigned gu32;
typedef GAS unsigned long long gu64;
#define RLX_AGENT __ATOMIC_RELAXED, __HIP_MEMORY_SCOPE_AGENT
#define LDS_WAIT() asm volatile("s_waitcnt lgkmcnt(0)" ::: "memory")
#define VM_WAIT() asm volatile("s_waitcnt vmcnt(0)" ::: "memory")
__device__ __forceinline__ unsigned long long rt() { return __builtin_amdgcn_s_memrealtime(); }
__device__ __forceinline__ unsigned f2bf(float f) { unsigned u = __builtin_bit_cast(unsigned, f); return (u + 0x7fffu + ((u >> 16) & 1u)) >> 16; }
__device__ __forceinline__ unsigned pk2(float lo, float hi) { return f2bf(lo) | (f2bf(hi) << 16); }
#define XB_TMO      128
#define XB_XCNT(j)  (256  + 64 * (j))
#define XB_XSUB(j)  (1280 + 64 * (j))
#define XB_XGEN(j)  (2304 + 64 * (j))
#define XB_TOP      3328
#define XB_TOPGEN   3392
#define XCD_BAR_WORDS 3456
#define XB_SPIN_CAP (1u << 18)

__device__ __forceinline__ unsigned xb_ld(unsigned* p)              { return __hip_atomic_load(p, __ATOMIC_RELAXED, __HIP_MEMORY_SCOPE_AGENT); }
__device__ __forceinline__ unsigned xb_add(unsigned* p, unsigned v) { return __hip_atomic_fetch_add(p, v, __ATOMIC_RELAXED, __HIP_MEMORY_SCOPE_AGENT); }
__device__ __forceinline__ unsigned xb_xcc_id() { return (unsigned)__builtin_amdgcn_s_getreg((3 << 11) | 20) & 0xFu; }
#define XB_SPIN(cond, bar) do { unsigned _sp = 0; while (cond) { __builtin_amdgcn_s_sleep(1); \
    if ((++_sp & 255u) == 0u) { if (xb_ld(&(bar)[XB_TMO])) break; if (_sp > XB_SPIN_CAP) { atomicAdd(&(bar)[XB_TMO], 1u); break; } } } } while (0)

struct XcdBarrier {
    unsigned* bar; unsigned x;
    volatile LAS unsigned* st;
};

__device__ __forceinline__ XcdBarrier xcd_barrier_post(unsigned* bar, volatile LAS unsigned* st) {
    XcdBarrier b; b.bar = bar; b.x = xb_xcc_id(); b.st = st;
    if (threadIdx.x == 0) (void)xb_add(&bar[XB_XCNT(b.x)], 1u);
    return b;
}
__device__ __forceinline__ void xcd_barrier_complete(unsigned* bar, unsigned x, unsigned& nloc, unsigned& nx) {
    const unsigned G = gridDim.x * gridDim.y * gridDim.z;
    unsigned sum, cnt, mine, sp = 0u;
    for (;;) {
        sum = 0u; cnt = 0u; mine = 0u;
#pragma unroll
        for (unsigned j = 0; j < 16; ++j) { const unsigned c = xb_ld(&bar[XB_XCNT(j)]); sum += c; cnt += (c > 0u) ? 1u : 0u; mine = (j == x) ? c : mine; }
        if (sum == G) break;
        __builtin_amdgcn_s_sleep(1);
        if ((++sp & 255u) == 0u) { if (xb_ld(&bar[XB_TMO])) break; if (sp > XB_SPIN_CAP) { atomicAdd(&bar[XB_TMO], 1u); break; } }
    }
    nloc = mine > 0u ? mine : 1u; nx = cnt > 0u ? cnt : 1u;
}

__device__ __forceinline__ void xcd_barrier(const XcdBarrier& b) {
    asm volatile("s_waitcnt vmcnt(0)" ::: "memory");
    __syncthreads();
    if (threadIdx.x == 0) {
        unsigned* bar = b.bar;
        __builtin_amdgcn_s_waitcnt(0);
        unsigned nloc = b.st[0], nx = b.st[1];
        if (nloc == 0u) { xcd_barrier_complete(bar, b.x, nloc, nx); b.st[0] = nloc; b.st[1] = nx; }
        const unsigned old = xb_add(&bar[XB_XSUB(b.x)], 1u);
        const unsigned gen = old / nloc;
        if (old + 1u == (gen + 1u) * nloc) {
            __builtin_amdgcn_fence(__ATOMIC_RELEASE, "agent");
            asm volatile("s_waitcnt vmcnt(0)" ::: "memory");
            const unsigned og = xb_add(&bar[XB_TOP], 1u);
            const unsigned tg = og / nx;
            if (og + 1u == (tg + 1u) * nx) xb_add(&bar[XB_TOPGEN], 1u);
            else XB_SPIN(xb_ld(&bar[XB_TOPGEN]) == tg, bar);
            __builtin_amdgcn_fence(__ATOMIC_ACQUIRE, "agent");
            xb_add(&bar[XB_XGEN(b.x)], 1u);
            asm volatile("s_waitcnt vmcnt(0)" ::: "memory");
        } else {
            XB_SPIN(xb_ld(&bar[XB_XGEN(b.x)]) == gen, bar);
            __builtin_amdgcn_fence(__ATOMIC_ACQUIRE, "agent");
            asm volatile("s_waitcnt vmcnt(0)" ::: "memory");
        }
    }
    __syncthreads();
}

constexpr int NWAVES = 8;
constexpr int DM = 1024, NB = 4, SEQ = 4096, NPR = NB * SEQ, SBAT = 32, STOK = 8, NSA = SBAT * STOK, MT = NPR + NSA;
constexpr int DFF = 2816, DIN = 5184, DINP = 5376, DMIX = 2048, KVW = 512, CONVD = 1536;
constexpr int PAST = 8192, NPAGES = 64, NPB = 128;
constexpr float EPS = 1e-6f;
constexpr float C2 = 0.125f * 1.4426950408889634f;
constexpr float LOG2E = 1.4426950408889634f;

constexpr size_t O_YP = 0, O_YS = 16777216, O_PCMP = 17039360, O_PSLC = 25427968, O_PWIN = 33816576, O_PSSM = 34865152, O_PCONV = 35389440,
                 O_SCMP = 35407872, O_SSLC = 35538944, O_SWIN = 35670016, O_SSSM = 44058624, O_SCONV = 48252928, O_END = 48400384;

constexpr size_t MiB = 1u << 20;
constexpr size_t WS_CTL = 0, CTL_ZERO_BYTES = 1 * MiB;
constexpr size_t WS_W1A = 2 * MiB, WS_W1B = 13 * MiB, WS_WIN = 19 * MiB, WS_WOUT = 30 * MiB, WS_W2A = 34 * MiB, WS_W2B = 45 * MiB, WS_WCF = 51 * MiB, WS_PEB = 52 * MiB;
constexpr size_t WS_GATES = 53 * MiB, WS_DT = 57 * MiB, WS_SSQA = 59 * MiB, WS_SSQY = 61 * MiB, WS_DC = 63 * MiB, WS_KCP = 64 * MiB, WS_KCS = 65 * MiB;
constexpr size_t WS_XN = 70 * MiB, WS_Q = 103 * MiB, WS_CKV = 136 * MiB, WS_SKV = 153 * MiB, WS_WKV = 170 * MiB, WS_Z = 187 * MiB, WS_XBC = 220 * MiB;
constexpr size_t WS_ACT = 269 * MiB, WS_O32 = 359 * MiB, WS_X1 = 424 * MiB, WS_MIX = 489 * MiB, WS_ST = 554 * MiB, WS_END = 620 * MiB;
constexpr int CW_BAR = 4096;

constexpr int LDS_BYTES = 163840;
constexpr int MISC_OFF = LDS_BYTES - 256;

__device__ __forceinline__ float wave_sum(float v) {
#pragma unroll
    for (int o = 1; o < 64; o <<= 1) v += __shfl_xor(v, o);
    return v;
}
__device__ __forceinline__ float fast_exp2(float x) { return __builtin_amdgcn_exp2f(x); }
__device__ __forceinline__ float fast_rcp(float x) { return __builtin_amdgcn_rcpf(x); }
__device__ __forceinline__ float silu_f(float x) { return x * fast_rcp(1.0f + fast_exp2(-x * LOG2E)); }
__device__ __forceinline__ float sigmoid_f(float x) { return fast_rcp(1.0f + fast_exp2(-x * LOG2E)); }
__device__ __forceinline__ float bf2f(unsigned short h) { return __uint_as_float(((unsigned)h) << 16); }

struct EpiSwiglu {
    static constexpr bool PERM = true, AFTER_DRAIN = false;
    bf16* O;
    __device__ __forceinline__ void operator()(const pg8::f32x4 (&acc)[2][2][4][2], const pg8::Unit& u, int wr, int wc, int fr, int fq) const {
        const int row0 = u.pm * 256 + wr * 64 + fr, col0 = u.pn * 128 + wc * 32 + 8 * fq;
#pragma unroll
        for (int ai = 0; ai < 2; ++ai)
#pragma unroll
            for (int m = 0; m < 4; ++m) {
                bf16* rowp = O + (size_t)(row0 + ai * 128 + m * 16) * DFF + col0;
                const pg8::f32x4 g0 = acc[ai][0][m][0], g1 = acc[ai][0][m][1], u0 = acc[ai][1][m][0], u1 = acc[ai][1][m][1];
                pg8::u32x4 w;
                w.x = pg8::cvt_pk_bf16(silu_f(g0[0]) * u0[0], silu_f(g0[1]) * u0[1]); w.y = pg8::cvt_pk_bf16(silu_f(g0[2]) * u0[2], silu_f(g0[3]) * u0[3]);
                w.z = pg8::cvt_pk_bf16(silu_f(g1[0]) * u1[0], silu_f(g1[1]) * u1[1]); w.w = pg8::cvt_pk_bf16(silu_f(g1[2]) * u1[2], silu_f(g1[3]) * u1[3]);
                *(pg8::u32x4*)rowp = w;
            }
    }
};
struct EpiF32 {
    static constexpr bool PERM = false, AFTER_DRAIN = false;
    float* C;
    __device__ __forceinline__ void operator()(const pg8::f32x4 (&acc)[2][2][4][2], const pg8::Unit& u, int wr, int wc, int fr, int fq) const {
        const int row0 = u.pm * 256 + wr * 64 + fr, col0 = u.pn * 256 + wc * 32 + 4 * fq;
#pragma unroll
        for (int ai = 0; ai < 2; ++ai)
#pragma unroll
            for (int m = 0; m < 4; ++m) { float* rowp = C + (size_t)(row0 + ai * 128 + m * 16) * DM + col0;
#pragma unroll
                for (int bj = 0; bj < 2; ++bj)
#pragma unroll
                    for (int n = 0; n < 2; ++n) *(pg8::f32x4*)(rowp + bj * 128 + n * 16) = acc[ai][bj][m][n]; }
    }
};
struct EpiInProj {
    static constexpr bool PERM = true, AFTER_DRAIN = false;
    bf16 *Q, *CKV, *Z, *XBC; float *GATES, *DT, *out;
    __device__ __forceinline__ void operator()(const pg8::f32x4 (&acc)[2][2][4][2], const pg8::Unit& u, int wr, int wc, int fr, int fq) const {
        const int pn = u.pn;
        const bool samp = (u.pm == 64);
#pragma unroll
        for (int ai = 0; ai < 2; ++ai)
#pragma unroll
            for (int m = 0; m < 4; ++m) {
                const int row = u.pm * 256 + ai * 128 + wr * 64 + m * 16 + fr;
                const int pb = row >> 12, pt = row & 4095;
                const int sr = row - NPR, sb = sr >> 3, st = sr & 7;
#pragma unroll
                for (int bj = 0; bj < 2; ++bj) {
                    const int cb = bj * 128 + wc * 32 + 8 * fq;
                    const pg8::f32x4 v0 = acc[ai][bj][m][0], v1 = acc[ai][bj][m][1];
                    if (pn < 4) {
                        pg8::u32x4 w; w.x = pg8::cvt_pk_bf16(v0[0] * C2, v0[1] * C2); w.y = pg8::cvt_pk_bf16(v0[2] * C2, v0[3] * C2); w.z = pg8::cvt_pk_bf16(v1[0] * C2, v1[1] * C2); w.w = pg8::cvt_pk_bf16(v1[2] * C2, v1[3] * C2);
                        *(pg8::u32x4*)(Q + (size_t)row * DM + pn * 256 + cb) = w;
                    } else if (pn < 10) {
                        const int which = (pn - 4) >> 1, col = ((pn - 4) & 1) * 256 + cb;
                        pg8::u32x4 w; w.x = pg8::cvt_pk_bf16(v0[0], v0[1]); w.y = pg8::cvt_pk_bf16(v0[2], v0[3]); w.z = pg8::cvt_pk_bf16(v1[0], v1[1]); w.w = pg8::cvt_pk_bf16(v1[2], v1[3]);
                        *(pg8::u32x4*)(CKV + (size_t)which * ((WS_SKV - WS_CKV) / 2) + (size_t)row * KVW + col) = w;
                        size_t fo; bool st_ok = true;
                        if (!samp) {
                            if (which < 2) fo = O_PCMP + (size_t)which * (O_PSLC - O_PCMP) + (size_t)row * KVW + col;
                            else { st_ok = (pt >= SEQ - 512); fo = O_PWIN + ((size_t)pb * 512 + (pt - (SEQ - 512))) * KVW + col; }
                        } else {
                            if (which < 2) fo = O_SCMP + (size_t)which * (O_SSLC - O_SCMP) + (size_t)sr * KVW + col;
                            else fo = O_SWIN + ((size_t)sb * 512 + 504 + st) * KVW + col;
                        }
                        if (st_ok) { *(pg8::f32x4*)(out + fo) = v0; *(pg8::f32x4*)(out + fo + 4) = v1; }
                    } else if (pn < 14) {
                        pg8::u32x4 w; w.x = pg8::cvt_pk_bf16(v0[0], v0[1]); w.y = pg8::cvt_pk_bf16(v0[2], v0[3]); w.z = pg8::cvt_pk_bf16(v1[0], v1[1]); w.w = pg8::cvt_pk_bf16(v1[2], v1[3]);
                        *(pg8::u32x4*)(Z + (size_t)row * DM + (pn - 10) * 256 + cb) = w;
                    } else if (pn < 20) {
                        const int col = (pn - 14) * 256 + cb;
                        pg8::u32x4 w; w.x = pg8::cvt_pk_bf16(v0[0], v0[1]); w.y = pg8::cvt_pk_bf16(v0[2], v0[3]); w.z = pg8::cvt_pk_bf16(v1[0], v1[1]); w.w = pg8::cvt_pk_bf16(v1[2], v1[3]);
                        *(pg8::u32x4*)(XBC + (size_t)row * CONVD + col) = w;
                        size_t fo; bool st_ok;
                        if (!samp) { st_ok = (pt >= SEQ - 3); fo = O_PCONV + ((size_t)pb * 3 + (pt - (SEQ - 3))) * CONVD + col; }
                        else { st_ok = (st >= STOK - 3); fo = O_SCONV + ((size_t)sb * 3 + (st - (STOK - 3))) * CONVD + col; }
                        if (st_ok) { *(pg8::f32x4*)(out + fo) = v0; *(pg8::f32x4*)(out + fo + 4) = v1; }
                    } else {
                        if (cb < 48) { float* fo = GATES + (size_t)row * 48 + cb; *(pg8::f32x4*)fo = v0; *(pg8::f32x4*)(fo + 4) = v1; }
                        else if (cb < 64) { float* fo = DT + (size_t)row * 16 + (cb - 48); *(pg8::f32x4*)fo = v0; *(pg8::f32x4*)(fo + 4) = v1; }
                    }
                }
            }
    }
};

template <int MODE> __device__ __forceinline__ int src_col(int n) {
    if (MODE == 0) return ((n >> 7) & 1 ? DFF : 0) + (n >> 8) * 128 + (n & 127);
    if (MODE == 2) {
        if (n < 2560) return n;
        if (n < 3584) return n + 48;
        if (n < 5120) return n + 48;
        if (n < 5168) return n - 2560;
        if (n < 5184) return n;
        return -1;
    }
    return n;
}
template <int MODE> __device__ __forceinline__ void transpose_item(const float* W, int K, int ldw, bf16* WT, const float* g1, const float* g2, LAS float* scr, int item, int nblk, int lane) {
    const int kb = item / nblk, nb = item % nblk, k0 = 64 * kb, n0 = 32 * nb;
    const int sc = src_col<MODE>(n0 + (lane & 31));
#pragma unroll 8
    for (int i = 0; i < 32; ++i) { const int kk = 2 * i + (lane >> 5); float v = sc >= 0 ? W[(size_t)(k0 + kk) * ldw + sc] : 0.f;
        if (MODE == 3) { const int k = k0 + kk; v *= (k < 1024) ? g1[k] : g2[k - 1024]; }
        scr[kk * 33 + (lane & 31)] = v; }
    LDS_WAIT(); asm volatile("" ::: "memory");
    const int c = lane & 7;
#pragma unroll
    for (int j = 0; j < 4; ++j) { const int n = (lane >> 3) + 8 * j; const LAS float* s = scr + (8 * c) * 33 + n;
        v4u o; o.x = pk2(s[0 * 33], s[1 * 33]); o.y = pk2(s[2 * 33], s[3 * 33]); o.z = pk2(s[4 * 33], s[5 * 33]); o.w = pk2(s[6 * 33], s[7 * 33]);
        *(GAS v4u*)(WT + (size_t)(n0 + n) * K + k0 + 8 * c) = o; }
    LDS_WAIT(); asm volatile("" ::: "memory");
}
__device__ __forceinline__ void rms_row_to_bf16(const float* xrow, const float* g, bf16* orow, int lane) {
    const GAS f32x4* xr = (const GAS f32x4*)xrow + lane; const GAS f32x4* gr = (const GAS f32x4*)g + lane;
    f32x4 v[4]; float s = 0.f;
#pragma unroll
    for (int j = 0; j < 4; ++j) { v[j] = xr[64 * j]; s += (v[j].x * v[j].x + v[j].y * v[j].y) + (v[j].z * v[j].z + v[j].w * v[j].w); }
    const float rs = 1.0f / sqrtf(wave_sum(s) * (1.f / DM) + EPS);
    GAS unsigned long long* o8 = (GAS unsigned long long*)orow + lane;
#pragma unroll
    for (int j = 0; j < 4; ++j) { const f32x4 gg = gr[64 * j];
        o8[64 * j] = (unsigned long long)pk2(v[j].x * rs * gg.x, v[j].y * rs * gg.y) | ((unsigned long long)pk2(v[j].z * rs * gg.z, v[j].w * rs * gg.w) << 32); }
}
__device__ __forceinline__ void row_post(const float* xin, const float* orow, const float* gpost, float coef, float* x1row, const float* gpre, bf16* xnrow, int lane) {
    const GAS f32x4* xr = (const GAS f32x4*)xin + lane; const GAS f32x4* orr = (const GAS f32x4*)orow + lane; const GAS f32x4* gp = (const GAS f32x4*)gpost + lane;
    f32x4 x[4], o[4]; float s = 0.f;
#pragma unroll
    for (int j = 0; j < 4; ++j) { o[j] = orr[64 * j]; x[j] = xr[64 * j]; s += (o[j].x * o[j].x + o[j].y * o[j].y) + (o[j].z * o[j].z + o[j].w * o[j].w); }
    const float rs = coef / sqrtf(wave_sum(s) * (1.f / DM) + EPS);
    float s2 = 0.f;
    GAS f32x4* xo = (GAS f32x4*)x1row + lane;
#pragma unroll
    for (int j = 0; j < 4; ++j) { const f32x4 gg = gp[64 * j];
        x[j].x += o[j].x * rs * gg.x; x[j].y += o[j].y * rs * gg.y; x[j].z += o[j].z * rs * gg.z; x[j].w += o[j].w * rs * gg.w;
        xo[64 * j] = x[j];
        s2 += (x[j].x * x[j].x + x[j].y * x[j].y) + (x[j].z * x[j].z + x[j].w * x[j].w); }
    if (gpre) {
        const float rs2 = 1.0f / sqrtf(wave_sum(s2) * (1.f / DM) + EPS);
        const GAS f32x4* gq = (const GAS f32x4*)gpre + lane;
        GAS unsigned long long* o8 = (GAS unsigned long long*)xnrow + lane;
#pragma unroll
        for (int j = 0; j < 4; ++j) { const f32x4 gg = gq[64 * j];
            o8[64 * j] = (unsigned long long)pk2(x[j].x * rs2 * gg.x, x[j].y * rs2 * gg.y) | ((unsigned long long)pk2(x[j].z * rs2 * gg.z, x[j].w * rs2 * gg.w) << 32); }
    }
}

typedef float f32x16 __attribute__((ext_vector_type(16)));
#define MFMA32(a, b, c) __builtin_amdgcn_mfma_f32_32x32x16_bf16((a), (b), (c), 0, 0, 0)
__device__ __forceinline__ int crow(int r, int hi) { return (r & 3) + 8 * (r >> 2) + 4 * hi; }
constexpr int SSTR = 272;
__device__ __forceinline__ float softplus_f(float x) { return x > 20.f ? x : log1pf(__expf(x)); }
__device__ __forceinline__ void wg_sync() { __syncthreads(); }

__device__ __forceinline__ void ssd_chunk_scalars(const float* DTR, const float* dt_bias, const float* a_log, int m0, int h, LAS float* dts, LAS float* css, int wave, int lane) {
    if (wave == 0) {
        const float bias = dt_bias[h], a = -__expf(a_log[h]);
        const float d0 = softplus_f(DTR[(size_t)(m0 + 2 * lane) * 16 + h] + bias), d1 = softplus_f(DTR[(size_t)(m0 + 2 * lane + 1) * 16 + h] + bias);
        const float l0 = d0 * a, l1 = d1 * a;
        float s = l0 + l1;
#pragma unroll
        for (int o = 1; o < 64; o <<= 1) { const float t = __shfl_up(s, o); if (lane >= o) s += t; }
        dts[2 * lane] = d0; dts[2 * lane + 1] = d1; css[2 * lane] = s - l1; css[2 * lane + 1] = s;
    }
}
template <int NCP, bool TR> __device__ __forceinline__ void conv_tile(const bf16* XBC, int m0, bool has_hist, int ch0, const float* conv_w, const float* conv_b,
                                                                     LAS unsigned char* dst, const LAS float* rowscale, int tid) {
    for (int task = tid; task < NCP * 16; task += NWAVES * 64) {
        const int cp = task % NCP, seg = task / NCP, ch = ch0 + 2 * cp, l0 = 8 * seg;
        float w0[4], w1[4];
#pragma unroll
        for (int k = 0; k < 4; ++k) { w0[k] = conv_w[k * CONVD + ch]; w1[k] = conv_w[k * CONVD + ch + 1]; }
        const float b0 = conv_b[ch], b1 = conv_b[ch + 1];
        float xa[11], xb[11];
#pragma unroll
        for (int r = 0; r < 11; ++r) {
            const int l = l0 - 3 + r;
            unsigned v = 0u;
            if (l >= 0 || has_hist) v = *(const unsigned*)(XBC + (size_t)(m0 + l) * CONVD + ch);
            xa[r] = __uint_as_float(v << 16); xb[r] = __uint_as_float(v & 0xffff0000u);
        }
        float ya[8], yb[8];
#pragma unroll
        for (int i = 0; i < 8; ++i) {
            float s0 = b0, s1 = b1;
#pragma unroll
            for (int k = 0; k < 4; ++k) { s0 += w0[k] * xa[i + k]; s1 += w1[k] * xb[i + k]; }
            ya[i] = silu_f(s0); yb[i] = silu_f(s1);
        }
        if (TR) {
            if (rowscale) {
#pragma unroll
                for (int i = 0; i < 8; ++i) { const float sc = rowscale[l0 + i]; ya[i] *= sc; yb[i] *= sc; }
            }
            v4u o; o.x = pk2(ya[0], ya[1]); o.y = pk2(ya[2], ya[3]); o.z = pk2(ya[4], ya[5]); o.w = pk2(ya[6], ya[7]);
            *(LAS v4u*)(dst + (2 * cp) * SSTR + l0 * 2) = o;
            o.x = pk2(yb[0], yb[1]); o.y = pk2(yb[2], yb[3]); o.z = pk2(yb[4], yb[5]); o.w = pk2(yb[6], yb[7]);
            *(LAS v4u*)(dst + (2 * cp + 1) * SSTR + l0 * 2) = o;
        } else {
#pragma unroll
            for (int i = 0; i < 8; ++i) *(LAS unsigned*)(dst + (l0 + i) * SSTR + (2 * cp) * 2) = pk2(ya[i], yb[i]);
        }
    }
}

__device__ __forceinline__ void ssd_a_unit(int unit, const bf16* XBC, const float* DTR, const float* dt_bias, const float* a_log, const float* conv_w, const float* conv_b,
                                           float* STB, float* DC, LAS unsigned char* lds, int tid, int wave, int lane) {
    asm volatile("; MARK_ssd_a_unit_BEGIN" ::: "memory");
    const int h = unit & 15, c = (unit >> 4) & 31, b = unit >> 9, m0 = b * SEQ + c * 128, g = h >> 3;
    LAS unsigned char* XT = lds;
    LAS unsigned char* BT = lds + 64 * SSTR;
    LAS float* dts = (LAS float*)(lds + 192 * SSTR);
    LAS float* css = dts + 128;
    LAS float* wsc = css + 128;
    ssd_chunk_scalars(DTR, dt_bias, a_log, m0, h, dts, css, wave, lane);
    wg_sync();
    if (tid < 128) wsc[tid] = dts[tid] * __expf(css[127] - css[tid]);
    if (tid == 0) DC[unit] = __expf(css[127]);
    wg_sync();
    conv_tile<32, true>(XBC, m0, c > 0, h * 64, conv_w, conv_b, XT, wsc, tid);
    conv_tile<64, true>(XBC, m0, c > 0, 1024 + g * 128, conv_w, conv_b, BT, nullptr, tid);
    wg_sync();
    const int pt = wave >> 2, nt = wave & 3, r32 = lane & 31, h2 = lane >> 5;
    f32x16 acc;
#pragma unroll
    for (int i = 0; i < 16; ++i) acc[i] = 0.f;
#pragma unroll
    for (int ks = 0; ks < 8; ++ks) {
        const bf16x8 a = *(const LAS bf16x8*)(XT + (32 * pt + r32) * SSTR + (16 * ks + 8 * h2) * 2);
        const bf16x8 bb = *(const LAS bf16x8*)(BT + (32 * nt + r32) * SSTR + (16 * ks + 8 * h2) * 2);
        acc = MFMA32(a, bb, acc);
    }
    float* dstp = STB + (size_t)unit * 8192 + 32 * nt + r32;
#pragma unroll
    for (int i = 0; i < 16; ++i) dstp[(32 * pt + crow(i, h2)) * 128] = acc[i];
    wg_sync();
}

__device__ __forceinline__ void ssd_scan(float* STB, const float* DC, float* pssm, int gthread, int nthreads) {
    asm volatile("; MARK_ssd_scan_BEGIN" ::: "memory");
    for (int e4 = gthread; e4 < NB * 16 * 2048; e4 += nthreads) {
        const int bh = e4 >> 11, w4 = e4 & 2047, b = bh >> 4, h = bh & 15;
        f32x4 hs = (f32x4){0.f, 0.f, 0.f, 0.f};
        GAS f32x4* p = (GAS f32x4*)(STB + ((size_t)(b * 32) * 16 + h) * 8192) + w4;
#pragma unroll 8
        for (int c = 0; c < 32; ++c) {
            const f32x4 st = p[(size_t)c * 16 * 2048];
            const float dc = DC[(b * 32 + c) * 16 + h];
            p[(size_t)c * 16 * 2048] = hs;
            hs = hs * dc + st;
        }
        *((GAS f32x4*)(pssm + (size_t)bh * 8192) + w4) = hs;
    }
}

__device__ __forceinline__ void ssd_c_unit(int unit, const bf16* XBC, const float* DTR, const float* dt_bias, const float* a_log, const float* conv_w, const float* conv_b,
                                           const float* d_skip, const float* STB, const bf16* ZB, bf16* MIX, float* SSQY, LAS unsigned char* lds, int tid, int wave, int lane) {
    asm volatile("; MARK_ssd_c_unit_BEGIN" ::: "memory");
    const int h = unit & 15, c = (unit >> 4) & 31, b = unit >> 9, m0 = b * SEQ + c * 128, g = h >> 3;
    LAS unsigned char* CL = lds;
    LAS unsigned char* BL = lds + 128 * SSTR;
    LAS unsigned char* XT = lds + 256 * SSTR;
    LAS unsigned char* HL = lds + 320 * SSTR;
    LAS float* dts = (LAS float*)(lds + 384 * SSTR);
    LAS float* css = dts + 128;
    LAS float* ssp = css + 128;
    ssd_chunk_scalars(DTR, dt_bias, a_log, m0, h, dts, css, wave, lane);
    conv_tile<64, false>(XBC, m0, c > 0, 1024 + 256 + g * 128, conv_w, conv_b, CL, nullptr, tid);
    conv_tile<64, false>(XBC, m0, c > 0, 1024 + g * 128, conv_w, conv_b, BL, nullptr, tid);
    conv_tile<32, true>(XBC, m0, c > 0, h * 64, conv_w, conv_b, XT, nullptr, tid);
    {
        const GAS f32x4* src = (const GAS f32x4*)(STB + (size_t)unit * 8192);
#pragma unroll
        for (int j = 0; j < 4; ++j) { const int e4 = tid + 512 * j, p = e4 >> 5, n = (e4 & 31) * 4; const f32x4 v = src[e4];
            *(LAS unsigned long long*)(HL + p * SSTR + n * 2) = (unsigned long long)pk2(v.x, v.y) | ((unsigned long long)pk2(v.z, v.w) << 32); }
    }
    wg_sync();
    const int pt = wave >> 2, ls = wave & 3, r32 = lane & 31, h2 = lane >> 5;
    const int l = 32 * ls + r32;
    const float csl = css[l];
    bf16x8 cf[8];
#pragma unroll
    for (int ks = 0; ks < 8; ++ks) cf[ks] = *(const LAS bf16x8*)(CL + l * SSTR + (16 * ks + 8 * h2) * 2);
    f32x16 acc;
#pragma unroll
    for (int i = 0; i < 16; ++i) acc[i] = 0.f;
#pragma unroll
    for (int ks = 0; ks < 8; ++ks) {
        const bf16x8 a = *(const LAS bf16x8*)(HL + (32 * pt + r32) * SSTR + (16 * ks + 8 * h2) * 2);
        acc = MFMA32(a, cf[ks], acc);
    }
    { const float el = __expf(csl);
#pragma unroll
      for (int i = 0; i < 16; ++i) acc[i] *= el; }
    for (int st = 0; st <= ls; ++st) {
        f32x16 mt;
#pragma unroll
        for (int i = 0; i < 16; ++i) mt[i] = 0.f;
#pragma unroll
        for (int ks = 0; ks < 8; ++ks) {
            const bf16x8 a = *(const LAS bf16x8*)(BL + (32 * st + r32) * SSTR + (16 * ks + 8 * h2) * 2);
            mt = MFMA32(a, cf[ks], mt);
        }
        unsigned pk[8];
#pragma unroll
        for (int i = 0; i < 16; i += 2) {
            const int s0 = 32 * st + crow(i, h2), s1 = s0 + 1;
            const float v0 = (l >= s0) ? mt[i] * __expf(csl - css[s0]) * dts[s0] : 0.f;
            const float v1 = (l >= s1) ? mt[i + 1] * __expf(csl - css[s1]) * dts[s1] : 0.f;
            pk[i >> 1] = pk2(v0, v1);
        }
#pragma unroll
        for (int k2 = 0; k2 < 2; ++k2) {
            v4u bw; bw.x = pk[4 * k2]; bw.y = pk[4 * k2 + 1]; bw.z = pk[4 * k2 + 2]; bw.w = pk[4 * k2 + 3];
            const bf16x8 bfrag = __builtin_bit_cast(bf16x8, bw);
            const LAS unsigned char* xp = XT + (32 * pt + r32) * SSTR + (32 * st + 16 * k2 + 4 * h2) * 2;
            const unsigned long long a_lo = *(const LAS unsigned long long*)xp, a_hi = *(const LAS unsigned long long*)(xp + 16);
            typedef unsigned long long u64x2 __attribute__((ext_vector_type(2)));
            u64x2 aw; aw.x = a_lo; aw.y = a_hi;
            acc = MFMA32(__builtin_bit_cast(bf16x8, aw), bfrag, acc);
        }
    }
    const float Dh = d_skip[h];
    const int m = m0 + l;
    float ssq = 0.f;
#pragma unroll
    for (int gq = 0; gq < 4; ++gq) {
        const int p0 = 32 * pt + 8 * gq + 4 * h2;
        const unsigned long long zz = *(const unsigned long long*)(ZB + (size_t)m * DM + h * 64 + p0);
        float y[4];
#pragma unroll
        for (int j = 0; j < 4; ++j) {
            const float xv = bf2f(*(const LAS unsigned short*)(XT + (p0 + j) * SSTR + l * 2));
            const float zv = bf2f((unsigned short)(zz >> (16 * j)));
            y[j] = (acc[4 * gq + j] + Dh * xv) * silu_f(zv);
            ssq += y[j] * y[j];
        }
        *(unsigned long long*)(MIX + (size_t)m * DMIX + 1024 + h * 64 + p0) = (unsigned long long)pk2(y[0], y[1]) | ((unsigned long long)pk2(y[2], y[3]) << 32);
    }
    ssq += __shfl_xor(ssq, 32);
    if (h2 == 0) ssp[pt * 128 + l] = ssq;
    wg_sync();
    if (tid < 128) SSQY[(size_t)(m0 + tid) * 16 + h] = ssp[tid] + ssp[128 + tid];
    wg_sync();
}

__device__ __forceinline__ void ssd_sample_unit(int unit, const bf16* XBC, const float* DTR, const float* dt_bias, const float* a_log, const float* conv_w, const float* conv_b,
                                                const float* d_skip, const float* state_ssm, const float* state_conv, const bf16* ZB, bf16* MIX, float* SSQY, float* sssm,
                                                LAS unsigned char* lds, int tid) {
    asm volatile("; MARK_ssd_sample_unit_BEGIN" ::: "memory");
    const int h = unit & 15, b = unit >> 4, g = h >> 3, m0 = NPR + b * 8;
    LAS float* xs = (LAS float*)lds;
    LAS float* Bs = xs + 512;
    LAS float* Cs = Bs + 1024;
    LAS float* cbd = Cs + 1024;
    LAS float* ysq = cbd + 64;
    LAS float* yo = ysq + 512;
    LAS float* dtl = yo + 512;
    LAS float* csl = dtl + 8;
    if (tid == 0) { const float bias = dt_bias[h], a = -__expf(a_log[h]); float run = 0.f;
        for (int t = 0; t < 8; ++t) { const float d = softplus_f(DTR[(size_t)(m0 + t) * 16 + h] + bias); run += d * a; dtl[t] = d; csl[t] = run; } }
    for (int task = tid; task < 320 * 8; task += NWAVES * 64) {
        const int t = task / 320, cc = task % 320;
        const int ch = cc < 64 ? h * 64 + cc : (cc < 192 ? 1024 + g * 128 + (cc - 64) : 1280 + g * 128 + (cc - 192));
        float s = conv_b[ch];
#pragma unroll
        for (int k = 0; k < 4; ++k) { const int r = t + k;
            const float xv = r < 3 ? state_conv[((size_t)b * 3 + r) * CONVD + ch] : bf2f(XBC[(size_t)(m0 + r - 3) * CONVD + ch]);
            s += conv_w[k * CONVD + ch] * xv; }
        s = silu_f(s);
        if (cc < 64) xs[t * 64 + cc] = s; else if (cc < 192) Bs[t * 128 + cc - 64] = s; else Cs[t * 128 + cc - 192] = s;
    }
    wg_sync();
    if (tid < 64) { const int l = tid >> 3, s = tid & 7; float d = 0.f;
        for (int n = 0; n < 128; ++n) d += Cs[l * 128 + n] * Bs[s * 128 + n];
        cbd[l * 8 + s] = (s <= l) ? d * __expf(csl[l] - csl[s]) * dtl[s] : 0.f; }
    const int p = tid >> 3, nq = tid & 7;
    const GAS f32x4* hp = (const GAS f32x4*)(state_ssm + ((size_t)(b * 16 + h) * 64 + p) * 128 + nq * 16);
    GAS f32x4* ho = (GAS f32x4*)(sssm + ((size_t)(b * 16 + h) * 64 + p) * 128 + nq * 16);
    f32x4 hv[4];
#pragma unroll
    for (int j = 0; j < 4; ++j) hv[j] = hp[j];
#pragma unroll
    for (int l = 0; l < 8; ++l) { float s = 0.f;
#pragma unroll
        for (int j = 0; j < 4; ++j) { const LAS float* cp = Cs + l * 128 + nq * 16 + 4 * j; s += (hv[j].x * cp[0] + hv[j].y * cp[1]) + (hv[j].z * cp[2] + hv[j].w * cp[3]); }
        s += __shfl_xor(s, 1); s += __shfl_xor(s, 2); s += __shfl_xor(s, 4);
        if (nq == 0) yo[l * 64 + p] = s; }
    { const float c7 = csl[7], e7 = __expf(c7);
#pragma unroll
      for (int j = 0; j < 4; ++j) hv[j] = hv[j] * e7;
      for (int l = 0; l < 8; ++l) { const float wl = dtl[l] * __expf(c7 - csl[l]) * xs[l * 64 + p];
#pragma unroll
          for (int j = 0; j < 4; ++j) { const LAS float* bp = Bs + l * 128 + nq * 16 + 4 * j; hv[j].x += wl * bp[0]; hv[j].y += wl * bp[1]; hv[j].z += wl * bp[2]; hv[j].w += wl * bp[3]; } }
#pragma unroll
      for (int j = 0; j < 4; ++j) ho[j] = hv[j]; }
    wg_sync();
    {
        const int l = nq;
        float y = __expf(csl[l]) * yo[l * 64 + p] + d_skip[h] * xs[l * 64 + p];
        for (int s = 0; s < 8; ++s) y += cbd[l * 8 + s] * xs[s * 64 + p];
        const float zv = bf2f(ZB[(size_t)(m0 + l) * DM + h * 64 + p]);
        y *= silu_f(zv);
        MIX[(size_t)(m0 + l) * DMIX + 1024 + h * 64 + p] = (bf16)f2bf(y);
        ysq[l * 64 + p] = y * y;
    }
    wg_sync();
    if (tid < 8) { float s = 0.f; for (int q = 0; q < 64; ++q) s += ysq[tid * 64 + q]; SSQY[(size_t)(m0 + tid) * 16 + h] = s; }
    wg_sync();
}

__device__ const unsigned char BKT[129] = {0, 1, 2, 3, 4, 5, 6, 7, 8, 9, 10, 11, 12, 13, 14, 15, 16, 16, 16, 17, 17, 18, 18, 18, 19, 19, 19, 20, 20, 20, 20, 21, 21, 21, 21, 22, 22, 22, 22, 22, 23, 23, 23, 23, 23, 23, 24, 24, 24, 24, 24, 24, 25, 25, 25, 25, 25, 25, 25, 26, 26, 26, 26, 26, 26, 26, 26, 27, 27, 27, 27, 27, 27, 27, 27, 27, 27, 28, 28, 28, 28, 28, 28, 28, 28, 28, 28, 29, 29, 29, 29, 29, 29, 29, 29, 29, 29, 29, 29, 30, 30, 30, 30, 30, 30, 30, 30, 30, 30, 30, 30, 30, 30, 31, 31, 31, 31, 31, 31, 31, 31, 31, 31, 31, 31, 31, 31, 31, 31};
constexpr int KSTR = 144, VSTR = 136;
constexpr int TILE_K_BYTES = 64 * KSTR, TILE_BYTES = 64 * KSTR + 64 * VSTR;
constexpr float NEG_BIG = -1.0e30f;
constexpr int LUT_STRIDE = 132;
typedef unsigned long long u64;

struct StageRegs { v4u k; u64 v0, v1; };
__device__ __forceinline__ void stage_issue_bf16(const bf16* base, long row0, int nvalid, int kvh, int tid, StageRegs& r) {
    const int key = tid >> 3, ch = tid & 7, kp = tid >> 4, dq = tid & 15;
    r.k = (v4u){0u, 0u, 0u, 0u}; r.v0 = 0ull; r.v1 = 0ull;
    if (key < nvalid) r.k = *(const GAS v4u*)(base + (size_t)(row0 + key) * KVW + kvh * 128 + ch * 8);
    if (2 * kp < nvalid) r.v0 = *(const GAS u64*)(base + (size_t)(row0 + 2 * kp) * KVW + kvh * 128 + 64 + dq * 4);
    if (2 * kp + 1 < nvalid) r.v1 = *(const GAS u64*)(base + (size_t)(row0 + 2 * kp + 1) * KVW + kvh * 128 + 64 + dq * 4);
}
__device__ __forceinline__ void stage_commit(const StageRegs& r, LAS unsigned char* tb, int tid) {
    const int key = tid >> 3, ch = tid & 7, kp = tid >> 4, dq = tid & 15;
    *(LAS v4u*)(tb + key * KSTR + ch * 16) = r.k;
    const unsigned a0 = (unsigned)r.v0, a1 = (unsigned)(r.v0 >> 32), b0 = (unsigned)r.v1, b1 = (unsigned)(r.v1 >> 32);
    LAS unsigned char* vt = tb + TILE_K_BYTES + (4 * dq) * VSTR + kp * 4;
    *(LAS unsigned*)(vt) = (a0 & 0xffffu) | (b0 << 16);
    *(LAS unsigned*)(vt + VSTR) = (a0 >> 16) | (b0 & 0xffff0000u);
    *(LAS unsigned*)(vt + 2 * VSTR) = (a1 & 0xffffu) | (b1 << 16);
    *(LAS unsigned*)(vt + 3 * VSTR) = (a1 >> 16) | (b1 & 0xffff0000u);
}
__device__ __forceinline__ void stage_tile_bf16(const bf16* base, long row0, int nvalid, int kvh, LAS unsigned char* tb, int tid) {
    StageRegs r; stage_issue_bf16(base, row0, nvalid, kvh, tid, r); stage_commit(r, tb, tid);
}
__device__ __forceinline__ void stage_tile_f32(const float* base, long row0, int kvh, LAS unsigned char* tb, int tid) {
    const int key = tid >> 3, ch = tid & 7, kp = tid >> 4, dq = tid & 15;
    const GAS f32x4* kpx = (const GAS f32x4*)(base + (size_t)(row0 + key) * KVW + kvh * 128 + ch * 8);
    const f32x4 k0 = kpx[0], k1 = kpx[1];
    const f32x4 va = *(const GAS f32x4*)(base + (size_t)(row0 + 2 * kp) * KVW + kvh * 128 + 64 + dq * 4);
    const f32x4 vb = *(const GAS f32x4*)(base + (size_t)(row0 + 2 * kp + 1) * KVW + kvh * 128 + 64 + dq * 4);
    v4u o; o.x = pk2(k0.x, k0.y); o.y = pk2(k0.z, k0.w); o.z = pk2(k1.x, k1.y); o.w = pk2(k1.z, k1.w);
    *(LAS v4u*)(tb + key * KSTR + ch * 16) = o;
    LAS unsigned char* vt = tb + TILE_K_BYTES + (4 * dq) * VSTR + kp * 4;
    *(LAS unsigned*)(vt) = pk2(va.x, vb.x); *(LAS unsigned*)(vt + VSTR) = pk2(va.y, vb.y); *(LAS unsigned*)(vt + 2 * VSTR) = pk2(va.z, vb.z); *(LAS unsigned*)(vt + 3 * VSTR) = pk2(va.w, vb.w);
}

template <int MODE  >
__device__ __forceinline__ void attn_tile(const LAS unsigned char* tb, const bf16x8 (&qf)[4], float cinit, int qpos, int kpos0, bool sel,
                                          const LAS float* lut, float& m_run, float& l_run, f32x16& o0, f32x16& o1, f32x16& p0, f32x16& p1, int lane) {
    constexpr bool NEAR = MODE != 0;
    constexpr int KS = MODE == 3 ? 64 : 1;
    const int r32 = lane & 31, h2 = lane >> 5;
    const float c0 = NEAR ? 0.f : cinit;
#pragma unroll
    for (int i = 0; i < 16; ++i) { p0[i] = c0; p1[i] = c0; }
#pragma unroll
    for (int ks = 0; ks < 4; ++ks) {
        const bf16x8 ka = *(const LAS bf16x8*)(tb + r32 * KSTR + (16 * ks + 8 * h2) * 2);
        const bf16x8 kb = *(const LAS bf16x8*)(tb + (32 + r32) * KSTR + (16 * ks + 8 * h2) * 2);
        p0 = MFMA32(ka, qf[ks], p0); p1 = MFMA32(kb, qf[ks], p1);
    }
    if (NEAR) {
        int base = sel ? qpos - kpos0 - KS * 4 * h2 : -0x20000000;
        asm volatile("" : "+v"(base));
#pragma unroll
        for (int i = 0; i < 16; ++i) {
            const int d0 = base - KS * ((i & 3) + 8 * (i >> 2)), d1 = d0 - 32 * KS;
            const bool ok0 = MODE == 2 ? ((unsigned)d0 < 512u) : (d0 >= 0), ok1 = MODE == 2 ? ((unsigned)d1 < 512u) : (d1 >= 0);
            const float b0 = lut[min(max(d0, 0), 128)], b1 = lut[min(max(d1, 0), 128)];
            p0[i] = ok0 ? p0[i] + b0 : -INFINITY; p1[i] = ok1 ? p1[i] + b1 : -INFINITY;
        }
    }
    float mx = fmaxf(p0[0], p1[0]);
#pragma unroll
    for (int i = 1; i < 16; ++i) mx = fmaxf(mx, fmaxf(p0[i], p1[i]));
    mx = fmaxf(mx, __shfl_xor(mx, 32));
    const float m_new = fmaxf(m_run, mx), alpha = fast_exp2(m_run - m_new);
    m_run = m_new;
    float rs = 0.f;
#pragma unroll
    for (int i = 0; i < 16; ++i) { p0[i] = fast_exp2(p0[i] - m_new); p1[i] = fast_exp2(p1[i] - m_new); rs += p0[i] + p1[i]; }
    l_run = l_run * alpha + rs;
#pragma unroll
    for (int i = 0; i < 16; ++i) { o0[i] *= alpha; o1[i] *= alpha; }
#pragma unroll
    for (int kt = 0; kt < 2; ++kt)
#pragma unroll
        for (int k2 = 0; k2 < 2; ++k2) {
            v4u bw;
            if (kt == 0) { bw.x = pg8::cvt_pk_bf16(p0[8 * k2], p0[8 * k2 + 1]); bw.y = pg8::cvt_pk_bf16(p0[8 * k2 + 2], p0[8 * k2 + 3]); bw.z = pg8::cvt_pk_bf16(p0[8 * k2 + 4], p0[8 * k2 + 5]); bw.w = pg8::cvt_pk_bf16(p0[8 * k2 + 6], p0[8 * k2 + 7]); }
            else         { bw.x = pg8::cvt_pk_bf16(p1[8 * k2], p1[8 * k2 + 1]); bw.y = pg8::cvt_pk_bf16(p1[8 * k2 + 2], p1[8 * k2 + 3]); bw.z = pg8::cvt_pk_bf16(p1[8 * k2 + 4], p1[8 * k2 + 5]); bw.w = pg8::cvt_pk_bf16(p1[8 * k2 + 6], p1[8 * k2 + 7]); }
            const bf16x8 pb = __builtin_bit_cast(bf16x8, bw);
            typedef u64 u64x2 __attribute__((ext_vector_type(2)));
            const LAS unsigned char* vp = tb + TILE_K_BYTES + r32 * VSTR + (32 * kt + 16 * k2 + 4 * h2) * 2;
            u64x2 a0; a0.x = *(const LAS u64*)vp; a0.y = *(const LAS u64*)(vp + 16);
            u64x2 a1; a1.x = *(const LAS u64*)(vp + 32 * VSTR); a1.y = *(const LAS u64*)(vp + 32 * VSTR + 16);
            o0 = MFMA32(__builtin_bit_cast(bf16x8, a0), pb, o0);
            o1 = MFMA32(__builtin_bit_cast(bf16x8, a1), pb, o1);
        }
}

template <bool F32SRC>
__device__ __forceinline__ void compress_unit(const void* src, const int* pt, long token0, int blk0, const bf16* WCF, const float* PEB, bf16* dst  ,
                                              LAS unsigned char* lds, int tid, int wave, int lane) {
    asm volatile("; MARK_compress_unit_BEGIN" ::: "memory");
    const int r32 = lane & 31, h2 = lane >> 5;
    LAS float* red = (LAS float*)lds;
    for (int c = 0; c < 2; ++c) {
        f32x16 acc[2][2];
#pragma unroll
        for (int a = 0; a < 2; ++a)
#pragma unroll
            for (int e = 0; e < 2; ++e)
#pragma unroll
                for (int i = 0; i < 16; ++i) acc[a][e][i] = 0.f;
        for (int li = 0; li < 8; ++li) {
            const int lp = 8 * wave + li;
#pragma unroll
            for (int rt = 0; rt < 2; ++rt) {
                const int nl = 8 * rt + (r32 >> 2), kvh = r32 & 3, blk = blk0 + nl;
                bf16x8 af[4];
                if (F32SRC) {
                    const int page = pt[blk >> 1];
                    const GAS f32x4* p = (const GAS f32x4*)((const float*)src + (((size_t)page * 128 + (blk & 1) * 64 + lp) * 4 + kvh) * 128 + c * 64 + 16 * h2);
#pragma unroll
                    for (int uu = 0; uu < 2; ++uu) { const f32x4 x0 = p[8 * uu], x1 = p[8 * uu + 1], x2 = p[8 * uu + 2], x3 = p[8 * uu + 3];
                        v4u w0; w0.x = pk2(x0.x, x0.y); w0.y = pk2(x0.z, x0.w); w0.z = pk2(x1.x, x1.y); w0.w = pk2(x1.z, x1.w);
                        v4u w1; w1.x = pk2(x2.x, x2.y); w1.y = pk2(x2.z, x2.w); w1.z = pk2(x3.x, x3.y); w1.w = pk2(x3.z, x3.w);
                        af[2 * uu] = __builtin_bit_cast(bf16x8, w0); af[2 * uu + 1] = __builtin_bit_cast(bf16x8, w1); }
                } else {
                    const GAS v4u* p = (const GAS v4u*)((const bf16*)src + ((size_t)(token0 + (size_t)blk * 64 + lp) * 4 + kvh) * 128 + c * 64 + 16 * h2);
#pragma unroll
                    for (int uu = 0; uu < 2; ++uu) { af[2 * uu] = __builtin_bit_cast(bf16x8, p[4 * uu]); af[2 * uu + 1] = __builtin_bit_cast(bf16x8, p[4 * uu + 1]); }
                }
#pragma unroll
                for (int kk = 0; kk < 4; ++kk) {
                    const int ks = lp * 4 + kk;
                    const GAS v4u* wp = (const GAS v4u*)(WCF + ((((size_t)c * 256 + ks) * 2) * 64 + lane) * 8);
                    const bf16x8 w0 = __builtin_bit_cast(bf16x8, wp[0]), w1 = __builtin_bit_cast(bf16x8, wp[64]);
                    acc[rt][0] = MFMA32(af[kk], w0, acc[rt][0]); acc[rt][1] = MFMA32(af[kk], w1, acc[rt][1]);
                }
            }
        }
        wg_sync();
        LAS float* my = red + (wave & 3) * 4096;
        if (wave < 4) {
#pragma unroll
            for (int rt = 0; rt < 2; ++rt)
#pragma unroll
                for (int e = 0; e < 2; ++e)
#pragma unroll
                    for (int i = 0; i < 16; ++i) my[(32 * rt + crow(i, h2)) * 64 + 32 * e + r32] = acc[rt][e][i];
        }
        wg_sync();
        if (wave >= 4) {
#pragma unroll
            for (int rt = 0; rt < 2; ++rt)
#pragma unroll
                for (int e = 0; e < 2; ++e)
#pragma unroll
                    for (int i = 0; i < 16; ++i) my[(32 * rt + crow(i, h2)) * 64 + 32 * e + r32] += acc[rt][e][i];
        }
        wg_sync();
        for (int idx = tid; idx < 4096; idx += NWAVES * 64) {
            const int row = idx >> 6, e = idx & 63, nl = row >> 2, kvh = row & 3;
            const float v = (red[idx] + red[4096 + idx]) + (red[8192 + idx] + red[12288 + idx]) + PEB[c * 64 + e];
            dst[(((size_t)nl * 4 + kvh) * 2 + c) * 64 + e] = (bf16)f2bf(v);
        }
    }
    wg_sync();
}

constexpr int AP_TB0 = 0, AP_TB1 = TILE_BYTES, AP_IMP = 2 * TILE_BYTES, AP_LUT = AP_IMP + 4 * 64 * 64 * 4, AP_SEL = AP_LUT + 4 * LUT_STRIDE * 4, AP_TL = AP_SEL + 64 * 8, AP_END = AP_TL + 80 * 4;
__device__ __forceinline__ void attn_prompt_unit(int b, int kvh, int qb, const bf16* QB, const bf16* KCP, const bf16* SKV, const bf16* WKV, const float* GATES, const float* rel_table,
                                                 bf16* MIX, float* SSQA, LAS unsigned char* lds, int tid, int wave, int lane) {
    asm volatile("; MARK_attn_prompt_unit_BEGIN" ::: "memory");
    const int g = wave >> 1, th = wave & 1, r32 = lane & 31, h2 = lane >> 5;
    const int tl = 32 * th + r32, t = 64 * qb + tl, m = b * SEQ + t, hh = kvh * 4 + g;
    LAS unsigned char* TB0 = lds + AP_TB0; LAS unsigned char* TB1 = lds + AP_TB1;
    LAS float* IMP = (LAS float*)(lds + AP_IMP); LAS float* LUT = (LAS float*)(lds + AP_LUT); LAS u64* SEL = (LAS u64*)(lds + AP_SEL); LAS int* TL = (LAS int*)(lds + AP_TL);
    bf16x8 qf[4];
#pragma unroll
    for (int ks = 0; ks < 4; ++ks) qf[ks] = __builtin_bit_cast(bf16x8, *(const GAS v4u*)(QB + (size_t)m * DM + hh * 64 + 16 * ks + 8 * h2));
    for (int idx = tid; idx < 4 * 129; idx += NWAVES * 64) { const int gg = idx / 129, d = idx % 129; LUT[gg * LUT_STRIDE + d] = rel_table[BKT[d] * 16 + kvh * 4 + gg] * LOG2E; }
    const float gate_c = sigmoid_f(GATES[(size_t)m * 48 + hh * 3 + 0]), gate_s = sigmoid_f(GATES[(size_t)m * 48 + hh * 3 + 1]), gate_w = sigmoid_f(GATES[(size_t)m * 48 + hh * 3 + 2]);
    const float bias_far = rel_table[31 * 16 + hh] * LOG2E;
    const LAS float* lut = LUT + g * LUT_STRIDE;
    stage_tile_bf16(KCP, (long)b * 64, 64, kvh, TB0, tid);
    wg_sync();
    f32x16 ot0, ot1, o0, o1, p0, p1;
    float m_run = NEG_BIG, l_run = 0.f;
#pragma unroll
    for (int i = 0; i < 16; ++i) { o0[i] = 0.f; o1[i] = 0.f; }
    attn_tile<3>(TB0, qf, 0.f, t, 63, true, lut, m_run, l_run, o0, o1, p0, p1, lane);
    {
        const float lt = l_run + __shfl_xor(l_run, 32), inv = lt > 0.f ? 1.0f / lt : 0.f, sc = gate_c * inv;
#pragma unroll
        for (int i = 0; i < 16; ++i) { ot0[i] = o0[i] * sc; ot1[i] = o1[i] * sc; }
        LAS float* slab = IMP + (g * 64 + tl) * 64;
#pragma unroll
        for (int i = 0; i < 16; ++i) { slab[crow(i, h2)] = p0[i] * inv; slab[32 + crow(i, h2)] = p1[i] * inv; }
    }
    wg_sync();
    if (qb < 16) { if (tid < 64) SEL[tid] = (2ull << qb) - 1ull; }
    else {
        for (int i = 0; i < 8; ++i) {
            const int tk = 8 * wave + i;
            const bool cand = (lane >= 1 && lane <= qb - 2);
            const float v = cand ? (IMP[(0 * 64 + tk) * 64 + lane] + IMP[(1 * 64 + tk) * 64 + lane]) + (IMP[(2 * 64 + tk) * 64 + lane] + IMP[(3 * 64 + tk) * 64 + lane]) : -1.f;
            int rank = 0;
#pragma unroll
            for (int jj = 0; jj < 64; ++jj) { const float vj = __builtin_bit_cast(float, __builtin_amdgcn_readlane(__builtin_bit_cast(int, v), jj)); rank += (vj > v || (vj == v && jj < lane)) ? 1 : 0; }
            const bool selected = (lane == 0 || lane == qb || lane == qb - 1) || (cand && rank < 13);
            const u64 mask = __ballot(selected);
            if (lane == 0) SEL[tk] = mask;
        }
    }
    wg_sync();
    if (tid == 0) { u64 any = 0ull; for (int i = 0; i < 64; ++i) any |= SEL[i]; int n = 0; for (int j = 0; j <= qb; ++j) if ((any >> j) & 1ull) TL[1 + n++] = j; TL[0] = n; }
    wg_sync();
    const u64 mysel = SEL[tl];
    const int ntl = TL[0];
    m_run = NEG_BIG; l_run = 0.f;
#pragma unroll
    for (int i = 0; i < 16; ++i) { o0[i] = 0.f; o1[i] = 0.f; }
    {
        StageRegs sr;
        stage_tile_bf16(SKV, (long)b * SEQ + 64 * TL[1], 64, kvh, TB0, tid);
        wg_sync();
        for (int it = 0; it < ntl; ++it) {
            const int j = TL[1 + it];
            LAS unsigned char* cur = (it & 1) ? TB1 : TB0; LAS unsigned char* nxt = (it & 1) ? TB0 : TB1;
            const bool more = it + 1 < ntl;
            if (more) stage_issue_bf16(SKV, (long)b * SEQ + 64 * TL[2 + it], 64, kvh, tid, sr);
            const bool sel = (mysel >> j) & 1ull;
            if (j <= qb - 3) attn_tile<0>(cur, qf, sel ? bias_far : -INFINITY, 0, 0, true, lut, m_run, l_run, o0, o1, p0, p1, lane);
            else attn_tile<1>(cur, qf, 0.f, t, 64 * j, sel, lut, m_run, l_run, o0, o1, p0, p1, lane);
            if (more) stage_commit(sr, nxt, tid);
            wg_sync();
        }
        const float lt = l_run + __shfl_xor(l_run, 32), sc = gate_s / lt;
#pragma unroll
        for (int i = 0; i < 16; ++i) { ot0[i] += o0[i] * sc; ot1[i] += o1[i] * sc; }
    }
    m_run = NEG_BIG; l_run = 0.f;
#pragma unroll
    for (int i = 0; i < 16; ++i) { o0[i] = 0.f; o1[i] = 0.f; }
    {
        StageRegs sr;
        const int j0 = qb >= 8 ? qb - 8 : 0, nw = qb - j0 + 1;
        stage_tile_bf16(WKV, (long)b * SEQ + 64 * j0, 64, kvh, TB0, tid);
        wg_sync();
        for (int it = 0; it < nw; ++it) {
            const int j = j0 + it;
            LAS unsigned char* cur = (it & 1) ? TB1 : TB0; LAS unsigned char* nxt = (it & 1) ? TB0 : TB1;
            const bool more = it + 1 < nw;
            if (more) stage_issue_bf16(WKV, (long)b * SEQ + 64 * (j + 1), 64, kvh, tid, sr);
            attn_tile<2>(cur, qf, 0.f, t, 64 * j, true, lut, m_run, l_run, o0, o1, p0, p1, lane);
            if (more) stage_commit(sr, nxt, tid);
            wg_sync();
        }
        const float lt = l_run + __shfl_xor(l_run, 32), sc = gate_w / lt;
#pragma unroll
        for (int i = 0; i < 16; ++i) { ot0[i] += o0[i] * sc; ot1[i] += o1[i] * sc; }
    }
    float ssq = 0.f;
#pragma unroll
    for (int i = 0; i < 16; ++i) ssq += ot0[i] * ot0[i] + ot1[i] * ot1[i];
    ssq += __shfl_xor(ssq, 32);
    if (h2 == 0) SSQA[(size_t)m * 16 + hh] = ssq;
    bf16* op = MIX + (size_t)m * DMIX + hh * 64 + 4 * h2;
#pragma unroll
    for (int gq = 0; gq < 4; ++gq) {
        *(u64*)(op + 8 * gq) = (u64)pk2(ot0[4 * gq], ot0[4 * gq + 1]) | ((u64)pk2(ot0[4 * gq + 2], ot0[4 * gq + 3]) << 32);
        *(u64*)(op + 32 + 8 * gq) = (u64)pk2(ot1[4 * gq], ot1[4 * gq + 1]) | ((u64)pk2(ot1[4 * gq + 2], ot1[4 * gq + 3]) << 32);
    }
    wg_sync();
}

constexpr int AS_TB = 0, AS_SIMP = 2 * TILE_BYTES, AS_MO = 65536, AS_ML = 131072, AS_LUT = 8 * TILE_BYTES, AS_SG = AS_LUT + 4 * LUT_STRIDE * 4, AS_SEL = AS_SG + 32 * 4 * 4, AS_TL = AS_SEL + 8 * 16,
              AS_OT = AS_TL + 132 * 4, AS_END = AS_OT + 32 * 64 * 4;
static_assert(AS_END <= MISC_OFF && AS_SIMP + 32 * 128 * 4 <= AS_MO && AS_ML + 8 * 32 * 8 <= AS_LUT, "sample attention LDS map");
__device__ __forceinline__ void as_write_state(LAS unsigned char* lds, int wave, int lane, float m_run, float l_run, const f32x16& o0, const f32x16& o1) {
    const int r32 = lane & 31, h2 = lane >> 5;
    const float lt = l_run + __shfl_xor(l_run, 32);
    LAS float* mo = (LAS float*)(lds + AS_MO) + (wave * 32 + r32) * 64 + 4 * h2;
#pragma unroll
    for (int gq = 0; gq < 4; ++gq) {
        *(LAS f32x4*)(mo + 8 * gq) = (f32x4){o0[4 * gq], o0[4 * gq + 1], o0[4 * gq + 2], o0[4 * gq + 3]};
        *(LAS f32x4*)(mo + 32 + 8 * gq) = (f32x4){o1[4 * gq], o1[4 * gq + 1], o1[4 * gq + 2], o1[4 * gq + 3]};
    }
    if (h2 == 0) { LAS float* ml = (LAS float*)(lds + AS_ML) + (wave * 32 + r32) * 2; ml[0] = m_run; ml[1] = lt; }
}
__device__ __forceinline__ void as_merge(LAS unsigned char* lds, int br, int tid) {
    const int q = tid >> 4, d = (tid & 15) * 4;
    const LAS float* ml = (const LAS float*)(lds + AS_ML); const LAS float* mo = (const LAS float*)(lds + AS_MO);
    float M = NEG_BIG;
#pragma unroll
    for (int w = 0; w < 8; ++w) M = fmaxf(M, ml[(w * 32 + q) * 2]);
    float L = 0.f; f32x4 acc = (f32x4){0.f, 0.f, 0.f, 0.f};
#pragma unroll
    for (int w = 0; w < 8; ++w) { const float f = fast_exp2(ml[(w * 32 + q) * 2] - M); L += ml[(w * 32 + q) * 2 + 1] * f; acc += *(const LAS f32x4*)(mo + (w * 32 + q) * 64 + d) * f; }
    const float sc = ((const LAS float*)(lds + AS_SG))[q * 4 + br] / L;
    LAS f32x4* ot = (LAS f32x4*)((LAS float*)(lds + AS_OT) + q * 64 + d);
    *ot = *ot + acc * sc;
}
__device__ __forceinline__ void attn_sample_unit(int b, int kvh, const bf16* QB, const bf16* KCS, const bf16* SKV, const bf16* WKV, const float* cache_slc, const float* cache_win,
                                                 const int* page_table, const float* GATES, const float* rel_table, bf16* MIX, float* SSQA, LAS unsigned char* lds, int tid, int wave, int lane) {
    asm volatile("; MARK_attn_sample_unit_BEGIN" ::: "memory");
    const int r32 = lane & 31, h2 = lane >> 5, g = r32 >> 3, t = r32 & 7, m = NPR + b * STOK + t, hh = kvh * 4 + g, qpos = PAST + t;
    LAS float* LUT = (LAS float*)(lds + AS_LUT); LAS float* SG = (LAS float*)(lds + AS_SG); LAS u64* SEL = (LAS u64*)(lds + AS_SEL); LAS int* TL = (LAS int*)(lds + AS_TL);
    LAS float* SIMP = (LAS float*)(lds + AS_SIMP);
    const int* pt = page_table + b * NPAGES;
    bf16x8 qf[4];
#pragma unroll
    for (int ks = 0; ks < 4; ++ks) qf[ks] = __builtin_bit_cast(bf16x8, *(const GAS v4u*)(QB + (size_t)m * DM + hh * 64 + 16 * ks + 8 * h2));
    for (int idx = tid; idx < 4 * 129; idx += NWAVES * 64) { const int gg = idx / 129, d = idx % 129; LUT[gg * LUT_STRIDE + d] = rel_table[BKT[d] * 16 + kvh * 4 + gg] * LOG2E; }
    if (tid < 96) { const int q = tid / 3, br = tid % 3; SG[q * 4 + br] = sigmoid_f(GATES[(size_t)(NPR + b * STOK + (q & 7)) * 48 + (kvh * 4 + (q >> 3)) * 3 + br]); }
    for (int idx = tid; idx < 32 * 64; idx += NWAVES * 64) ((LAS float*)(lds + AS_OT))[idx] = 0.f;
    const float bias_far = rel_table[31 * 16 + hh] * LOG2E;
    const LAS float* lut = LUT + g * LUT_STRIDE;
    f32x16 o0, o1, p0, p1; float m_run, l_run;
#define AS_RESET() do { m_run = NEG_BIG; l_run = 0.f; _Pragma("unroll") for (int i = 0; i < 16; ++i) { o0[i] = 0.f; o1[i] = 0.f; } } while (0)
    stage_tile_bf16(KCS, (long)b * 128, 64, kvh, lds + AS_TB, tid);
    stage_tile_bf16(KCS, (long)b * 128 + 64, 64, kvh, lds + AS_TB + TILE_BYTES, tid);
    wg_sync();
    AS_RESET();
    if (wave < 2) {
        attn_tile<3>(lds + AS_TB + wave * TILE_BYTES, qf, 0.f, qpos, 64 * 64 * wave + 63, true, lut, m_run, l_run, o0, o1, p0, p1, lane);
        LAS float* sp = SIMP + r32 * 128 + 64 * wave;
#pragma unroll
        for (int i = 0; i < 16; ++i) { sp[crow(i, h2)] = p0[i]; sp[32 + crow(i, h2)] = p1[i]; }
    }
    as_write_state(lds, wave, lane, m_run, l_run, o0, o1);
    wg_sync();
    as_merge(lds, 0, tid);
    {
        const int tk = wave;
        const LAS float* ml = (const LAS float*)(lds + AS_ML);
        float v0 = 0.f, v1 = 0.f;
#pragma unroll
        for (int gg = 0; gg < 4; ++gg) { const int q = gg * 8 + tk;
            const float m0 = ml[(0 * 32 + q) * 2], l0 = ml[(0 * 32 + q) * 2 + 1], m1 = ml[(1 * 32 + q) * 2], l1 = ml[(1 * 32 + q) * 2 + 1];
            const float M = fmaxf(m0, m1), f0 = fast_exp2(m0 - M), f1 = fast_exp2(m1 - M), inv = 1.0f / (l0 * f0 + l1 * f1);
            v0 += SIMP[q * 128 + lane] * (f0 * inv); v1 += SIMP[q * 128 + 64 + lane] * (f1 * inv); }
        const bool c0 = lane >= 1, c1 = lane <= 62;
        if (!c0) v0 = -1.f; if (!c1) v1 = -1.f;
        int rk0 = 0, rk1 = 0;
#pragma unroll
        for (int jj = 0; jj < 64; ++jj) {
            const float a = __builtin_bit_cast(float, __builtin_amdgcn_readlane(__builtin_bit_cast(int, v0), jj)), bb = __builtin_bit_cast(float, __builtin_amdgcn_readlane(__builtin_bit_cast(int, v1), jj));
            rk0 += (a > v0 || (a == v0 && jj < lane)) ? 1 : 0; rk0 += (bb > v0) ? 1 : 0;
            rk1 += (a > v1 || a == v1) ? 1 : 0; rk1 += (bb > v1 || (bb == v1 && jj < lane)) ? 1 : 0;
        }
        const bool s0 = (lane == 0) || (c0 && rk0 < 13), s1 = (lane == 63) || (c1 && rk1 < 13);
        const u64 mk0 = __ballot(s0), mk1 = __ballot(s1);
        if (lane == 0) { SEL[tk * 2] = mk0; SEL[tk * 2 + 1] = mk1; }
    }
    wg_sync();
    if (tid == 0) { u64 a0 = 0ull, a1 = 0ull; for (int i = 0; i < 8; ++i) { a0 |= SEL[2 * i]; a1 |= SEL[2 * i + 1]; }
        int n = 0; for (int j = 0; j < 64; ++j) if ((a0 >> j) & 1ull) TL[1 + n++] = j; for (int j = 0; j < 64; ++j) if ((a1 >> j) & 1ull) TL[1 + n++] = 64 + j; TL[1 + n++] = 128; TL[0] = n; }
    wg_sync();
    {
        const int ntl = TL[0];
        const u64 ms0 = SEL[t * 2], ms1 = SEL[t * 2 + 1];
        AS_RESET();
        for (int base = 0; base < ntl; base += 8) {
            const int nb = min(8, ntl - base);
            for (int s = 0; s < nb; ++s) { const int j = TL[1 + base + s];
                if (j < 128) stage_tile_f32(cache_slc, (long)pt[j >> 1] * 128 + (j & 1) * 64, kvh, lds + AS_TB + s * TILE_BYTES, tid);
                else stage_tile_bf16(SKV, (long)NPR + b * STOK, STOK, kvh, lds + AS_TB + s * TILE_BYTES, tid); }
            wg_sync();
            if (wave < nb) { const int j = TL[1 + base + wave];
                const bool sel = j >= 128 ? true : (j < 64 ? ((ms0 >> j) & 1ull) : ((ms1 >> (j - 64)) & 1ull));
                if (j <= 125) attn_tile<0>(lds + AS_TB + wave * TILE_BYTES, qf, sel ? bias_far : -INFINITY, 0, 0, true, lut, m_run, l_run, o0, o1, p0, p1, lane);
                else attn_tile<1>(lds + AS_TB + wave * TILE_BYTES, qf, 0.f, qpos, 64 * j, sel, lut, m_run, l_run, o0, o1, p0, p1, lane); }
            wg_sync();
        }
        as_write_state(lds, wave, lane, m_run, l_run, o0, o1);
        wg_sync();
        as_merge(lds, 1, tid);
        wg_sync();
    }
    {
        AS_RESET();
        for (int base = 0; base < 9; base += 8) {
            const int nb = min(8, 9 - base);
            for (int s = 0; s < nb; ++s) { const int wt = base + s;
                if (wt < 8) stage_tile_f32(cache_win, (long)b * 512 + 64 * wt, kvh, lds + AS_TB + s * TILE_BYTES, tid);
                else stage_tile_bf16(WKV, (long)NPR + b * STOK, STOK, kvh, lds + AS_TB + s * TILE_BYTES, tid); }
            wg_sync();
            if (wave < nb) { const int wt = base + wave;
                attn_tile<2>(lds + AS_TB + wave * TILE_BYTES, qf, 0.f, qpos, PAST - 512 + 64 * wt, true, lut, m_run, l_run, o0, o1, p0, p1, lane); }
            wg_sync();
        }
        as_write_state(lds, wave, lane, m_run, l_run, o0, o1);
        wg_sync();
        as_merge(lds, 2, tid);
        wg_sync();
    }
    {
        const int q = tid >> 4, d = (tid & 15) * 4, gq = q >> 3, tq = q & 7, mq = NPR + b * STOK + tq, hq = kvh * 4 + gq;
        const f32x4 v = *(const LAS f32x4*)((const LAS float*)(lds + AS_OT) + q * 64 + d);
        float ssq = (v.x * v.x + v.y * v.y) + (v.z * v.z + v.w * v.w);
        ssq += __shfl_xor(ssq, 1); ssq += __shfl_xor(ssq, 2); ssq += __shfl_xor(ssq, 4); ssq += __shfl_xor(ssq, 8);
        *(u64*)(MIX + (size_t)mq * DMIX + hq * 64 + d) = (u64)pk2(v.x, v.y) | ((u64)pk2(v.z, v.w) << 32);
        if ((tid & 15) == 0) SSQA[(size_t)mq * 16 + hq] = ssq;
    }
    wg_sync();
#undef AS_RESET
}

struct Args { const float* in[30]; float* out; unsigned char* ws; int ph_lo, ph_hi; };
constexpr int N_PHASES = 14;

__global__ void __launch_bounds__(NWAVES * 64, 2) mk_fwd(Args args) {
    extern __shared__ __attribute__((aligned(16))) unsigned char lds_raw[];
    LAS unsigned char* lds = (LAS unsigned char*)lds_raw;
    volatile LAS unsigned* MISC = (volatile LAS unsigned*)(lds + MISC_OFF);
    const int tid = threadIdx.x, lane = tid & 63, wave = __builtin_amdgcn_readfirstlane(tid >> 6);
    const int G = gridDim.x, bx = blockIdx.x;
    const int vcu = (G % 8 == 0) ? (bx % 8) * (G / 8) + bx / 8 : bx;
    const int gw = vcu * NWAVES + wave, NGW = G * NWAVES;
    unsigned char* ws = args.ws;
    gu32* ctl = (gu32*)(ws + WS_CTL);
    float* out = args.out;
    const float* x_prompt = args.in[0]; const float* x_sample = args.in[1];
    const float* cache_cmp = args.in[2]; const float* cache_slc = args.in[3]; const float* cache_win = args.in[4];
    const float* state_ssm = args.in[5]; const float* state_conv = args.in[6]; const int* page_table = (const int*)args.in[7];
    const float* rel_table = args.in[8];
    const float* ffn1_pre = args.in[9]; const float* ffn1_post = args.in[10]; const float* ffn1_w_in = args.in[11]; const float* ffn1_w_out = args.in[12];
    const float* mix_pre = args.in[13]; const float* mix_post = args.in[14]; const float* w_in = args.in[15]; const float* w_out = args.in[16];
    const float* att_out_norm = args.in[17]; const float* cmp_pe = args.in[18]; const float* w_cmp = args.in[19];
    const float* conv_w = args.in[20]; const float* conv_b = args.in[21]; const float* dt_bias = args.in[22]; const float* a_log = args.in[23];
    const float* d_skip = args.in[24]; const float* ssd_norm = args.in[25];
    const float* ffn2_pre = args.in[26]; const float* ffn2_post = args.in[27]; const float* ffn2_w_in = args.in[28]; const float* ffn2_w_out = args.in[29];
    bf16* W1A = (bf16*)(ws + WS_W1A); bf16* W1B = (bf16*)(ws + WS_W1B); bf16* WIN = (bf16*)(ws + WS_WIN); bf16* WOUT = (bf16*)(ws + WS_WOUT);
    bf16* W2A = (bf16*)(ws + WS_W2A); bf16* W2B = (bf16*)(ws + WS_W2B); bf16* WCF = (bf16*)(ws + WS_WCF); float* PEB = (float*)(ws + WS_PEB);
    float* GATES = (float*)(ws + WS_GATES); float* DTR = (float*)(ws + WS_DT); float* SSQA = (float*)(ws + WS_SSQA); float* SSQY = (float*)(ws + WS_SSQY);
    float* DC = (float*)(ws + WS_DC); bf16* KCP = (bf16*)(ws + WS_KCP); bf16* KCS = (bf16*)(ws + WS_KCS);
    bf16* XN = (bf16*)(ws + WS_XN); bf16* QB = (bf16*)(ws + WS_Q); bf16* CKV = (bf16*)(ws + WS_CKV); bf16* SKV = (bf16*)(ws + WS_SKV); bf16* WKV = (bf16*)(ws + WS_WKV);
    bf16* ZB = (bf16*)(ws + WS_Z); bf16* XBC = (bf16*)(ws + WS_XBC); bf16* ACT = (bf16*)(ws + WS_ACT); float* O32 = (float*)(ws + WS_O32); float* X1 = (float*)(ws + WS_X1);
    bf16* MIX = (bf16*)(ws + WS_MIX); float* STB = (float*)(ws + WS_ST);

    for (int u = tid; u < 64; u += NWAVES * 64) ((LAS unsigned*)(lds + MISC_OFF))[u] = 0u;
    __syncthreads();
    XcdBarrier bar = xcd_barrier_post((unsigned*)(ctl + CW_BAR), MISC + 8);
    const int lo = args.ph_lo, hi = args.ph_hi;
#define IN(k) (lo <= (k) && (k) < hi)
#define SEAM(k) do { if (IN(k) && IN((k) + 1)) xcd_barrier(bar); } while (0)

    if (IN(0)) {
        LAS float* scr = (LAS float*)(lds + wave * 16384);
        constexpr int I_A = 16 * (2 * DFF / 32), I_B = (DFF / 64) * (DM / 32), I_IN = 16 * (DINP / 32), I_OUT = (DMIX / 64) * (DM / 32);
        constexpr int NITEMS = 2 * I_A + 2 * I_B + I_IN + I_OUT;
        for (int it = gw; it < NITEMS; it += NGW) {
            int r = it;
            if (r < I_A) { transpose_item<0>(ffn1_w_in, DM, 2 * DFF, W1A, nullptr, nullptr, scr, r, 2 * DFF / 32, lane); continue; } r -= I_A;
            if (r < I_A) { transpose_item<0>(ffn2_w_in, DM, 2 * DFF, W2A, nullptr, nullptr, scr, r, 2 * DFF / 32, lane); continue; } r -= I_A;
            if (r < I_B) { transpose_item<1>(ffn1_w_out, DFF, DM, W1B, nullptr, nullptr, scr, r, DM / 32, lane); continue; } r -= I_B;
            if (r < I_B) { transpose_item<1>(ffn2_w_out, DFF, DM, W2B, nullptr, nullptr, scr, r, DM / 32, lane); continue; } r -= I_B;
            if (r < I_IN) { transpose_item<2>(w_in, DM, DIN, WIN, nullptr, nullptr, scr, r, DINP / 32, lane); continue; } r -= I_IN;
            transpose_item<3>(w_out, DMIX, DM, WOUT, att_out_norm, ssd_norm, scr, r, DM / 32, lane);
        }
        for (int m = gw; m < MT; m += NGW) {
            const float* xr = m < NPR ? x_prompt + (size_t)m * DM : x_sample + (size_t)(m - NPR) * DM;
            rms_row_to_bf16(xr, ffn1_pre, XN + (size_t)m * DM, lane);
        }
        for (int r = gw; r < SBAT * 504; r += NGW) {
            const int b = r / 504, j = r % 504;
            const GAS f32x4* s = (const GAS f32x4*)(cache_win + ((size_t)b * 512 + j + 8) * KVW) + lane;
            GAS f32x4* d = (GAS f32x4*)(out + O_SWIN + ((size_t)b * 512 + j) * KVW) + lane;
            d[0] = s[0]; d[64] = s[64];
        }
        for (int f = bx * (NWAVES * 64) + tid; f < 2 * 256 * 2 * 64; f += G * NWAVES * 64) {
            const int ln = f & 63, et = (f >> 6) & 1, ks = (f >> 7) & 255, c = f >> 15;
            const int l = ks >> 2, d0 = 32 * ((ks & 3) >> 1) + 16 * (ln >> 5) + 8 * (ks & 1), e = 32 * et + (ln & 31);
            const float* src = w_cmp + (((size_t)l * 2 + c) * 64 + d0) * 64 + e;
            v4u o; o.x = pk2(src[0], src[64]); o.y = pk2(src[128], src[192]); o.z = pk2(src[256], src[320]); o.w = pk2(src[384], src[448]);
            *(GAS v4u*)(WCF + (size_t)f * 8) = o;
        }
        if (bx == G - 1) {
            LAS float* red = (LAS float*)(lds + 8 * 16384);
            const int part = tid >> 7, ce = tid & 127, c = ce >> 6, e = ce & 63;
            float s = 0.f;
            for (int l = part * 16; l < part * 16 + 16; ++l)
                for (int d = 0; d < 64; ++d) s += cmp_pe[(l * 2 + c) * 64 + d] * w_cmp[(((size_t)l * 2 + c) * 64 + d) * 64 + e];
            red[tid] = s;
            __syncthreads();
            if (tid < 128) PEB[tid] = (red[tid] + red[tid + 128]) + (red[tid + 256] + red[tid + 384]);
        }
    }
    SEAM(0);

    if (IN(1)) {
        pg8::Gemm g{XN, W1A, MT, 2 * DFF, DM}; pg8::StaticOrder S; S.init(MT, 2 * DFF, G, bx);
        EpiSwiglu E{ACT};
        pg8::gemm_phase<EpiSwiglu, pg8::StaticOrder, true, true>(lds, g, S, E);
    }
    SEAM(1);
    if (IN(2)) {
        pg8::Gemm g{ACT, W1B, MT, DM, DFF}; pg8::StaticOrder S; S.init(MT, DM, G, bx);
        EpiF32 E{O32};
        pg8::gemm_phase<EpiF32, pg8::StaticOrder, true, true>(lds, g, S, E);
    }
    SEAM(2);
    if (IN(3)) {
        for (int m = gw; m < MT; m += NGW) {
            const float* xr = m < NPR ? x_prompt + (size_t)m * DM : x_sample + (size_t)(m - NPR) * DM;
            row_post(xr, O32 + (size_t)m * DM, ffn1_post, 0.5f, X1 + (size_t)m * DM, mix_pre, XN + (size_t)m * DM, lane);
        }
    }
    SEAM(3);
    if (IN(4)) {
        pg8::Gemm g{XN, WIN, MT, DINP, DM}; pg8::StaticOrder S; S.init(MT, DINP, G, bx);
        EpiInProj E{QB, CKV, ZB, XBC, GATES, DTR, out};
        pg8::gemm_phase<EpiInProj, pg8::StaticOrder, true, true>(lds, g, S, E);
    }
    SEAM(4);

    if (IN(5)) {
        for (int u = vcu; u < SBAT * 8; u += G) { const int b = u >> 3, uq = u & 7;
            compress_unit<true>(cache_cmp, page_table + b * NPAGES, 0, 16 * uq, WCF, PEB, KCS + ((size_t)b * 128 + 16 * uq) * KVW, lds, tid, wave, lane); }
        for (int u = G - 1 - vcu; u < NB * 4; u += G) { const int b = u >> 2, uq = u & 3;
            compress_unit<false>(CKV, nullptr, (long)b * SEQ, 16 * uq, WCF, PEB, KCP + ((size_t)b * 64 + 16 * uq) * KVW, lds, tid, wave, lane); }
        for (int u = vcu; u < NB * 32 * 16; u += G) ssd_a_unit(u, XBC, DTR, dt_bias, a_log, conv_w, conv_b, STB, DC, lds, tid, wave, lane);
    }
    SEAM(5);
    if (IN(6)) {
        ssd_scan(STB, DC, out + O_PSSM, vcu * (NWAVES * 64) + tid, G * NWAVES * 64);
        for (int u = vcu; u < 1024; u += G) {
            const int slot = u >> 8, w = u & 255, bk = w >> 4, jj = w & 15;
            const int qb = slot == 0 ? jj : (slot == 1 ? 31 - jj : (slot == 2 ? 32 + jj : 63 - jj));
            attn_prompt_unit(bk >> 2, bk & 3, qb, QB, KCP, SKV, WKV, GATES, rel_table, MIX, SSQA, lds, tid, wave, lane);
        }
    }
    SEAM(6);
    if (IN(7)) {
        for (int u = vcu; u < SBAT * 4; u += G) attn_sample_unit(u >> 2, u & 3, QB, KCS, SKV, WKV, cache_slc, cache_win, page_table, GATES, rel_table, MIX, SSQA, lds, tid, wave, lane);
        for (int u = vcu; u < NB * 32 * 16; u += G) ssd_c_unit(u, XBC, DTR, dt_bias, a_log, conv_w, conv_b, d_skip, STB, ZB, MIX, SSQY, lds, tid, wave, lane);
        for (int u = vcu; u < SBAT * 16; u += G) ssd_sample_unit(u, XBC, DTR, dt_bias, a_log, conv_w, conv_b, d_skip, state_ssm, state_conv, ZB, MIX, SSQY, out + O_SSSM, lds, tid);
    }
    SEAM(7);
    if (IN(8)) {
        for (int m = gw; m < MT; m += NGW) {
            float sa = lane < 16 ? SSQA[(size_t)m * 16 + lane] : 0.f;
            float sy = lane < 16 ? SSQY[(size_t)m * 16 + lane] : 0.f;
            float sy0 = lane < 8 ? sy : 0.f, sy1 = (lane >= 8 && lane < 16) ? sy : 0.f;
            sa = wave_sum(sa); sy0 = wave_sum(sy0); sy1 = wave_sum(sy1);
            const float ra = 1.0f / sqrtf(sa * (1.f / 1024.f) + EPS), r0 = 1.0f / sqrtf(sy0 * (1.f / 512.f) + EPS), r1 = 1.0f / sqrtf(sy1 * (1.f / 512.f) + EPS);
            const float rs = lane < 32 ? ra : (lane < 48 ? r0 : r1);
            GAS v4u* p = (GAS v4u*)(MIX + (size_t)m * DMIX) + lane * 4;
#pragma unroll
            for (int j = 0; j < 4; ++j) { v4u v = p[j];
                v.x = pk2(__uint_as_float(v.x << 16) * rs, __uint_as_float(v.x & 0xffff0000u) * rs); v.y = pk2(__uint_as_float(v.y << 16) * rs, __uint_as_float(v.y & 0xffff0000u) * rs);
                v.z = pk2(__uint_as_float(v.z << 16) * rs, __uint_as_float(v.z & 0xffff0000u) * rs); v.w = pk2(__uint_as_float(v.w << 16) * rs, __uint_as_float(v.w & 0xffff0000u) * rs);
                p[j] = v; }
        }
    }
    SEAM(8);
    if (IN(9)) {
        pg8::Gemm g{MIX, WOUT, MT, DM, DMIX}; pg8::StaticOrder S; S.init(MT, DM, G, bx);
        EpiF32 E{O32};
        pg8::gemm_phase<EpiF32, pg8::StaticOrder, true, true>(lds, g, S, E);
    }
    SEAM(9);
    if (IN(10)) {
        for (int m = gw; m < MT; m += NGW) row_post(X1 + (size_t)m * DM, O32 + (size_t)m * DM, mix_post, 1.0f, X1 + (size_t)m * DM, ffn2_pre, XN + (size_t)m * DM, lane);
    }
    SEAM(10);
    if (IN(11)) {
        pg8::Gemm g{XN, W2A, MT, 2 * DFF, DM}; pg8::StaticOrder S; S.init(MT, 2 * DFF, G, bx);
        EpiSwiglu E{ACT};
        pg8::gemm_phase<EpiSwiglu, pg8::StaticOrder, true, true>(lds, g, S, E);
    }
    SEAM(11);
    if (IN(12)) {
        pg8::Gemm g{ACT, W2B, MT, DM, DFF}; pg8::StaticOrder S; S.init(MT, DM, G, bx);
        EpiF32 E{O32};
        pg8::gemm_phase<EpiF32, pg8::StaticOrder, true, true>(lds, g, S, E);
    }
    SEAM(12);
    if (IN(13)) {
        for (int m = gw; m < MT; m += NGW) row_post(X1 + (size_t)m * DM, O32 + (size_t)m * DM, ffn2_post, 0.5f, out + (size_t)m * DM, nullptr, nullptr, lane);
    }

#undef IN
#undef SEAM
}

extern "C" void kernel_launch(void* const* d_in, const int* in_sizes, int n_in, void* d_out, int out_size, void* d_ws, size_t ws_size, hipStream_t stream) {
    static int grid = 0;
    if (grid == 0) {
        if (n_in != 30 || out_size != (int)O_END || ws_size < WS_END) { fprintf(stderr, "kernel_launch: unexpected shapes n_in %d out %d ws %zu\n", n_in, out_size, ws_size); grid = -1; return; }
        int dev = 0, cus = 0, per_cu = 0;
        if (hipGetDevice(&dev) != hipSuccess || hipDeviceGetAttribute(&cus, hipDeviceAttributeMultiprocessorCount, dev) != hipSuccess) { grid = -1; return; }
        if (hipFuncSetAttribute((const void*)mk_fwd, hipFuncAttributeMaxDynamicSharedMemorySize, LDS_BYTES) != hipSuccess) { fprintf(stderr, "kernel_launch: hipFuncSetAttribute failed\n"); grid = -1; return; }
        if (hipOccupancyMaxActiveBlocksPerMultiprocessor(&per_cu, (const void*)mk_fwd, NWAVES * 64, LDS_BYTES) != hipSuccess || per_cu < 1) { fprintf(stderr, "kernel_launch: occupancy query says %d\n", per_cu); }
        (void)hipGetLastError();
        grid = cus;
    }
    if (grid < 0) return;
    if (hipMemsetAsync((char*)d_ws + WS_CTL, 0, CTL_ZERO_BYTES, stream) != hipSuccess) return;
    Args a{};
    for (int i = 0; i < 30; ++i) a.in[i] = (const float*)d_in[i];
    a.out = (float*)d_out; a.ws = (unsigned char*)d_ws; a.ph_lo = 0; a.ph_hi = N_PHASES;
    hipLaunchKernelGGL(mk_fwd, dim3(grid), dim3(NWAVES * 64), LDS_BYTES, stream, a);
}
```

```cpp
#include <hip/hip_runtime.h>
#include <cstdio>
#include <cstdint>
namespace pg8 {
#define PG8_LAS __attribute__((address_space(3)))
typedef unsigned short bf16_t;
typedef short bf16x8 __attribute__((ext_vector_type(8)));
typedef float f32x4 __attribute__((ext_vector_type(4)));
typedef unsigned u32x4 __attribute__((ext_vector_type(4)));
constexpr int BM = 256, BK = 64, HALF = 128, HTB = HALF * BK * 2  , STAGE_BYTES = 8 * HTB, NXCD = 8, WGM = 8;

__host__ __device__ __forceinline__ int lds_byte(int r, int c) { const int st = (r >> 4) * 2 + (c >> 5), rr = r & 15, cc = c & 31, ob = rr * 64 + cc * 2; return st * 1024 + (ob ^ (((ob >> 9) & 1) << 5)); }
__host__ __device__ __forceinline__ void stage_rc(int b, int& R, int& C) { const int st = b / 1024, sb = b % 1024, swz = sb ^ (((sb >> 9) & 1) << 5); R = (st >> 1) * 16 + swz / 64; C = (st & 1) * 32 + (swz % 64) / 2; }
__host__ __device__ __forceinline__ int perm32(int rho) { const int n = rho >> 4, i = rho & 15; return 8 * (i >> 2) + 4 * n + (i & 3); }

struct Unit { int pm, pn, ko, kl; };
struct Gemm { const bf16_t* A; const bf16_t* Bt; int M, N, K; };

struct StaticOrder {
    int nM, nN, nwg, G, c, kfull;
    __host__ __device__ void init(int M, int N, int G_, int c_, int K_) { nM = M / BM; nN = N / BM; nwg = nM * nN; G = G_; c = c_; kfull = K_; }
    __host__ __device__ __forceinline__ bool next(int i, Unit& u) const {
        const long L = (long)i * G + c; if (L >= nwg) return false;
        int wgid = (int)L; { const int q = nwg / NXCD, r = nwg % NXCD, xcd = wgid % NXCD, off = wgid / NXCD; wgid = (xcd < r ? xcd * (q + 1) : r * (q + 1) + (xcd - r) * q) + off; }
        const int nig = WGM * nN, gid = wgid / nig, fm = gid * WGM, gsz = (nM - fm) < WGM ? (nM - fm) : WGM;
        u.pm = fm + ((wgid % nig) % gsz); u.pn = (wgid % nig) / gsz; u.ko = 0; u.kl = kfull; return true;
    }
    __device__ __forceinline__ void a_ready(const Unit&) const {}
    __device__ __forceinline__ void done(const Unit&) const {}
};

__device__ __forceinline__ unsigned cvt_pk_bf16(float lo, float hi) { unsigned r; asm volatile("v_cvt_pk_bf16_f32 %0, %1, %2" : "=v"(r) : "v"(lo), "v"(hi)); return r; }
template <class Epi, class Sched, bool ALIGN_EPI = false, bool SP2 = false>
__device__ __forceinline__ void gemm_phase(PG8_LAS unsigned char* lds, const Gemm g, const Sched& S, const Epi& E) {
    int tid_ = threadIdx.x; asm volatile("" : "+v"(tid_));
    const int tid = tid_, wid = __builtin_amdgcn_readfirstlane(tid >> 6), lane = tid & 63, wr = wid >> 2, wc = wid & 3, fr = lane & 15, fq = lane >> 4;
    const int K = g.K; int nt;
    unsigned voffA[2], voffB[2];
#pragma unroll
    for (int i = 0; i < 2; ++i) { int R, C; stage_rc(tid * 16 + i * 8192, R, C); const int Rb = Epi::PERM ? ((R & ~31) + perm32(R & 31)) : R;
        voffA[i] = (unsigned)(R * K + C) * 2u; voffB[i] = (unsigned)(Rb * K + C) * 2u; }
    const size_t kstep = (size_t)(BK * 2);
    const size_t hstep = (size_t)HALF * K * 2;
    const size_t tstep = 2 * hstep;
    const unsigned ldsw = (unsigned)wid * 1024u;
    const int aoff = lds_byte(wr * 64 + fr, fq * 8), boff = lds_byte(wc * 32 + fr, fq * 8);
#define PG8_SA(b, h) (((b) * 2 + (h)) * HTB)
#define PG8_SB(b, h) ((4 + (b) * 2 + (h)) * HTB)
#define PG8_STAGE(bufoff, gbase, voff) do { _Pragma("unroll") for (int _i = 0; _i < 2; ++_i) \
        __builtin_amdgcn_global_load_lds((const unsigned*)((const char*)(gbase) + (voff)[_i]), (PG8_LAS unsigned*)(lds + (bufoff) + ldsw + _i * 8192), 16, 0, 0); } while (0)
#define PG8_LDA(dst, b, h) do { _Pragma("unroll") for (int m = 0; m < 4; ++m) _Pragma("unroll") for (int k = 0; k < 2; ++k) dst[m][k] = *(const PG8_LAS bf16x8*)(lds + PG8_SA(b, h) + aoff + m * 2048 + k * 1024); } while (0)
#define PG8_LDB(dst, b, h) do { _Pragma("unroll") for (int n = 0; n < 2; ++n) _Pragma("unroll") for (int k = 0; k < 2; ++k) dst[n][k] = *(const PG8_LAS bf16x8*)(lds + PG8_SB(b, h) + boff + n * 2048 + k * 1024); } while (0)
#define PG8_MMA(ai, bj, At, Bt) do { __builtin_amdgcn_s_setprio(1); _Pragma("unroll") for (int m = 0; m < 4; ++m) _Pragma("unroll") for (int n = 0; n < 2; ++n) _Pragma("unroll") for (int k = 0; k < 2; ++k) \
        acc[ai][bj][m][n] = __builtin_amdgcn_mfma_f32_16x16x32_bf16(Bt[n][k], At[m][k], acc[ai][bj][m][n], 0, 0, 0); __builtin_amdgcn_s_setprio(0); } while (0)
#define PG8_WAIT_V(n) asm volatile("s_waitcnt vmcnt(" #n ")" ::: "memory")
#define PG8_WAIT_L(n) asm volatile("s_waitcnt lgkmcnt(" #n ")" ::: "memory")
#define PG8_BAR __builtin_amdgcn_s_barrier()
#define PG8_SCHED __builtin_amdgcn_sched_barrier(0)
    Unit cur, nxt; int ui = 0;
    if (!S.next(0, cur)) return;
    nt = cur.kl / BK;
    f32x4 acc[2][2][4][2];
#pragma unroll
    for (int a = 0; a < 2; ++a)
#pragma unroll
        for (int b = 0; b < 2; ++b)
#pragma unroll
            for (int m = 0; m < 4; ++m)
#pragma unroll
                for (int n = 0; n < 2; ++n) acc[a][b][m][n] = (f32x4){0.f, 0.f, 0.f, 0.f};
    bf16x8 At[4][2], B0[2][2], B1[2][2];
    const char* cA = (const char*)g.A + (size_t)cur.pm * tstep + (size_t)cur.ko * 2; const char* cB = (const char*)g.Bt + (size_t)cur.pn * tstep + (size_t)cur.ko * 2;
    S.a_ready(cur);
    if constexpr (SP2) {
        PG8_STAGE(PG8_SB(0, 0), cB, voffB); PG8_STAGE(PG8_SB(0, 1), cB + hstep, voffB); PG8_STAGE(PG8_SA(0, 0), cA, voffA); PG8_STAGE(PG8_SA(0, 1), cA + hstep, voffA);
        if (wr == 1) PG8_BAR;
        PG8_WAIT_V(2); PG8_BAR;
        PG8_STAGE(PG8_SB(1, 0), cB + kstep, voffB); PG8_STAGE(PG8_SA(1, 0), cA + kstep, voffA); PG8_STAGE(PG8_SB(1, 1), cB + hstep + kstep, voffB);
        PG8_WAIT_V(6); PG8_BAR;
    } else {
        PG8_STAGE(PG8_SB(0, 0), cB, voffB); PG8_STAGE(PG8_SA(0, 0), cA, voffA); PG8_STAGE(PG8_SB(0, 1), cB + hstep, voffB); PG8_STAGE(PG8_SA(0, 1), cA + hstep, voffA);
        if (wr == 1) PG8_BAR;
        PG8_WAIT_V(4); PG8_BAR;
        PG8_STAGE(PG8_SB(1, 0), cB + kstep, voffB); PG8_STAGE(PG8_SA(1, 0), cA + kstep, voffA); PG8_STAGE(PG8_SB(1, 1), cB + hstep + kstep, voffB);
        PG8_WAIT_V(6); PG8_BAR;
    }
    for (;;) {
        const bool has_next = S.next(ui + 1, nxt);
        const char* nA = has_next ? (const char*)g.A + (size_t)nxt.pm * tstep + (size_t)nxt.ko * 2 : cA; const char* nB = has_next ? (const char*)g.Bt + (size_t)nxt.pn * tstep + (size_t)nxt.ko * 2 : cB;
        for (int t = 0; t < nt; t += 2) {
            if constexpr (Epi::KHOOK) { if ((t == 16 || t == 24) && cur.pm != 64) E.khook(t, acc, wr, fr); }
            const bool last = (t == nt - 2);
            const char* a1 = cA + (size_t)(t + 1) * kstep;
            const char* a2 = last ? nA : cA + (size_t)(t + 2) * kstep; const char* b2 = last ? nB : cB + (size_t)(t + 2) * kstep;
            const char* a3 = a2 + kstep; const char* b3 = b2 + kstep;
            if (last && has_next) S.a_ready(nxt);
            if constexpr (SP2) {
            PG8_LDB(B0, 0, 0); PG8_LDB(B1, 0, 1); PG8_SCHED; PG8_LDA(At, 0, 0); PG8_STAGE(PG8_SA(1, 1), a1 + hstep, voffA);
            PG8_WAIT_V(8); PG8_WAIT_L(0); PG8_BAR; PG8_MMA(0, 0, At, B0); PG8_MMA(0, 1, At, B1); PG8_BAR; PG8_SCHED;
            PG8_LDA(At, 0, 1); PG8_STAGE(PG8_SB(0, 0), b2, voffB); PG8_STAGE(PG8_SB(0, 1), b2 + hstep, voffB); PG8_STAGE(PG8_SA(0, 0), a2, voffA);
            PG8_WAIT_V(8); PG8_WAIT_L(0); PG8_BAR; PG8_MMA(1, 0, At, B0); PG8_MMA(1, 1, At, B1); PG8_BAR; PG8_SCHED;
            PG8_LDB(B0, 1, 0); PG8_LDB(B1, 1, 1); PG8_SCHED; PG8_LDA(At, 1, 0); PG8_STAGE(PG8_SA(0, 1), a2 + hstep, voffA);
            PG8_WAIT_V(8); PG8_WAIT_L(0); PG8_BAR; PG8_MMA(0, 0, At, B0); PG8_MMA(0, 1, At, B1); PG8_BAR; PG8_SCHED;
            PG8_LDA(At, 1, 1); PG8_STAGE(PG8_SB(1, 0), b3, voffB); PG8_STAGE(PG8_SB(1, 1), b3 + hstep, voffB); PG8_STAGE(PG8_SA(1, 0), a3, voffA);
            PG8_WAIT_V(8); PG8_WAIT_L(0); PG8_BAR; PG8_MMA(1, 0, At, B0); PG8_MMA(1, 1, At, B1); PG8_BAR; PG8_SCHED;
            } else {
            PG8_LDB(B0, 0, 0); PG8_SCHED; PG8_LDA(At, 0, 0); PG8_STAGE(PG8_SA(1, 1), a1 + hstep, voffA);
            PG8_WAIT_L(8); PG8_BAR; PG8_WAIT_L(0); PG8_MMA(0, 0, At, B0); PG8_BAR; PG8_SCHED;
            PG8_LDB(B1, 0, 1); PG8_STAGE(PG8_SB(0, 0), b2, voffB);
            PG8_BAR; PG8_WAIT_L(0); PG8_MMA(0, 1, At, B1); PG8_BAR;
            PG8_LDA(At, 0, 1); PG8_STAGE(PG8_SA(0, 0), a2, voffA);
            PG8_BAR; PG8_WAIT_L(0); PG8_MMA(1, 0, At, B0); PG8_BAR; PG8_SCHED;
            PG8_STAGE(PG8_SB(0, 1), b2 + hstep, voffB);
            PG8_WAIT_V(6); PG8_BAR; PG8_MMA(1, 1, At, B1); PG8_BAR;
            PG8_LDB(B0, 1, 0); PG8_SCHED; PG8_LDA(At, 1, 0); PG8_STAGE(PG8_SA(0, 1), a2 + hstep, voffA);
            PG8_WAIT_L(8); PG8_BAR; PG8_WAIT_L(0); PG8_MMA(0, 0, At, B0); PG8_BAR; PG8_SCHED;
            PG8_LDB(B1, 1, 1); PG8_STAGE(PG8_SB(1, 0), b3, voffB);
            PG8_BAR; PG8_WAIT_L(0); PG8_MMA(0, 1, At, B1); PG8_BAR;
            PG8_LDA(At, 1, 1); PG8_STAGE(PG8_SA(1, 0), a3, voffA);
            PG8_BAR; PG8_WAIT_L(0); PG8_MMA(1, 0, At, B0); PG8_BAR; PG8_SCHED;
            PG8_STAGE(PG8_SB(1, 1), b3 + hstep, voffB);
            PG8_WAIT_V(6); PG8_BAR; PG8_MMA(1, 1, At, B1); PG8_BAR;
            }
        }
        if constexpr (ALIGN_EPI) { if (wr == 0) PG8_BAR; }
        if constexpr (!Epi::AFTER_DRAIN) { E(acc, cur, wr, wc, fr, fq); S.done(cur); }
        if (!has_next) break;
#pragma unroll
        for (int a = 0; a < 2; ++a)
#pragma unroll
            for (int b = 0; b < 2; ++b)
#pragma unroll
                for (int m = 0; m < 4; ++m)
#pragma unroll
                    for (int n = 0; n < 2; ++n) acc[a][b][m][n] = (f32x4){0.f, 0.f, 0.f, 0.f};
        cur = nxt; cA = nA; cB = nB; ++ui; nt = cur.kl / BK;
        if constexpr (ALIGN_EPI) { if (wr == 1) PG8_BAR; }
    }
    PG8_WAIT_V(0);
    if constexpr (!ALIGN_EPI) { if (wr == 0) PG8_BAR; }
    PG8_BAR;
    if constexpr (Epi::AFTER_DRAIN) { E.fused(acc, cur, wr, wc, fr, fq, lds, wid, lane); S.done(cur); }
#undef PG8_SA
#undef PG8_SB
#undef PG8_STAGE
#undef PG8_LDA
#undef PG8_LDB
#undef PG8_MMA
#undef PG8_WAIT_V
#undef PG8_WAIT_L
#undef PG8_BAR
#undef PG8_SCHED
}
}
#define GAS __attribute__((address_space(1)))
#define LAS __attribute__((address_space(3)))
typedef unsigned short bf16;
typedef unsigned v4u __attribute__((ext_vector_type(4)));
typedef float f32x4 __attribute__((ext_vector_type(4)));
typedef short bf16x8 __attribute__((ext_vector_type(8)));
typedef GAS unsigned gu32;
typedef GAS unsigned long long gu64;
#define RLX_AGENT __ATOMIC_RELAXED, __HIP_MEMORY_SCOPE_AGENT
#define LDS_WAIT() asm volatile("s_waitcnt lgkmcnt(0)" ::: "memory")
#define VM_WAIT() asm volatile("s_waitcnt vmcnt(0)" ::: "memory")
__device__ __forceinline__ unsigned long long rt() { return __builtin_amdgcn_s_memrealtime(); }
__device__ __forceinline__ unsigned f2bf(float f) { unsigned u = __builtin_bit_cast(unsigned, f); return (u + 0x7fffu + ((u >> 16) & 1u)) >> 16; }
typedef float pk2_f32x2_t __attribute__((ext_vector_type(2))); typedef __bf16 pk2_bf16x2_t __attribute__((ext_vector_type(2)));
__device__ __forceinline__ unsigned pk2(float lo, float hi) { pk2_f32x2_t v = {lo, hi}; pk2_bf16x2_t b = __builtin_convertvector(v, pk2_bf16x2_t); return __builtin_bit_cast(unsigned, b); }
#define XB_TMO      128
#define XB_XCNT(j)  (256  + 64 * (j))
#define XB_XSUB(j)  (1280 + 64 * (j))
#define XB_XGEN(j)  (2304 + 64 * (j))
#define XB_TOP      3328
#define XB_TOPGEN   3392
#define XCD_BAR_WORDS 3456
#define XB_SPIN_CAP (1u << 18)

__device__ __forceinline__ unsigned xb_ld(unsigned* p)              { return __hip_atomic_load(p, __ATOMIC_RELAXED, __HIP_MEMORY_SCOPE_AGENT); }
__device__ __forceinline__ unsigned xb_add(unsigned* p, unsigned v) { return __hip_atomic_fetch_add(p, v, __ATOMIC_RELAXED, __HIP_MEMORY_SCOPE_AGENT); }
__device__ __forceinline__ unsigned xb_xcc_id() { return (unsigned)__builtin_amdgcn_s_getreg((3 << 11) | 20) & 0xFu; }
#define XB_SPIN(cond, bar) do { unsigned _sp = 0; while (cond) { __builtin_amdgcn_s_sleep(1); \
    if ((++_sp & 255u) == 0u) { if (xb_ld(&(bar)[XB_TMO])) break; if (_sp > XB_SPIN_CAP) { atomicAdd(&(bar)[XB_TMO], 1u); break; } } } } while (0)

struct XcdBarrier {
    unsigned* bar; unsigned x;
    volatile LAS unsigned* st;
};

__device__ __forceinline__ XcdBarrier xcd_barrier_post(unsigned* bar, volatile LAS unsigned* st) {
    XcdBarrier b; b.bar = bar; b.x = xb_xcc_id(); b.st = st;
    if (threadIdx.x == 0) (void)xb_add(&bar[XB_XCNT(b.x)], 1u);
    return b;
}
__device__ __forceinline__ void xcd_barrier_complete(unsigned* bar, unsigned x, unsigned& nloc, unsigned& nx) {
    const unsigned G = gridDim.x * gridDim.y * gridDim.z;
    unsigned sum, cnt, mine, sp = 0u;
    for (;;) {
        sum = 0u; cnt = 0u; mine = 0u;
#pragma unroll
        for (unsigned j = 0; j < 16; ++j) { const unsigned c = xb_ld(&bar[XB_XCNT(j)]); sum += c; cnt += (c > 0u) ? 1u : 0u; mine = (j == x) ? c : mine; }
        if (sum == G) break;
        __builtin_amdgcn_s_sleep(1);
        if ((++sp & 255u) == 0u) { if (xb_ld(&bar[XB_TMO])) break; if (sp > XB_SPIN_CAP) { atomicAdd(&bar[XB_TMO], 1u); break; } }
    }
    nloc = mine > 0u ? mine : 1u; nx = cnt > 0u ? cnt : 1u;
}

__device__ __forceinline__ void xcd_barrier(const XcdBarrier& b) {
    asm volatile("s_waitcnt vmcnt(0)" ::: "memory");
    __syncthreads();
    if (threadIdx.x == 0) {
        unsigned* bar = b.bar;
        __builtin_amdgcn_s_waitcnt(0);
        unsigned nloc = b.st[0], nx = b.st[1];
        if (nloc == 0u) { xcd_barrier_complete(bar, b.x, nloc, nx); b.st[0] = nloc; b.st[1] = nx; }
        const unsigned old = xb_add(&bar[XB_XSUB(b.x)], 1u);
        const unsigned gen = old / nloc;
        if (old + 1u == (gen + 1u) * nloc) {
            __builtin_amdgcn_fence(__ATOMIC_RELEASE, "agent");
            asm volatile("s_waitcnt vmcnt(0)" ::: "memory");
            const unsigned og = xb_add(&bar[XB_TOP], 1u);
            const unsigned tg = og / nx;
            if (og + 1u == (tg + 1u) * nx) xb_add(&bar[XB_TOPGEN], 1u);
            else XB_SPIN(xb_ld(&bar[XB_TOPGEN]) == tg, bar);
            __builtin_amdgcn_fence(__ATOMIC_ACQUIRE, "agent");
            xb_add(&bar[XB_XGEN(b.x)], 1u);
            asm volatile("s_waitcnt vmcnt(0)" ::: "memory");
        } else {
            XB_SPIN(xb_ld(&bar[XB_XGEN(b.x)]) == gen, bar);
            __builtin_amdgcn_fence(__ATOMIC_ACQUIRE, "agent");
            asm volatile("s_waitcnt vmcnt(0)" ::: "memory");
        }
    }
    __syncthreads();
}

constexpr int NWAVES = 8;
constexpr int DM = 1024, NB = 4, SEQ = 4096, NPR = NB * SEQ, SBAT = 32, STOK = 8, NSA = SBAT * STOK, MT = NPR + NSA;
constexpr int DFF = 2816, DIN = 5184, DINP = 5376, DMIX = 2048, KVW = 512, CONVD = 1536;
constexpr int PAST = 8192, NPAGES = 64, NPB = 128;
constexpr float EPS = 1e-6f;
constexpr float C2 = 0.125f * 1.4426950408889634f;
constexpr float LOG2E = 1.4426950408889634f;

constexpr size_t O_YP = 0, O_YS = 16777216, O_PCMP = 17039360, O_PSLC = 25427968, O_PWIN = 33816576, O_PSSM = 34865152, O_PCONV = 35389440,
                 O_SCMP = 35407872, O_SSLC = 35538944, O_SWIN = 35670016, O_SSSM = 44058624, O_SCONV = 48252928, O_END = 48400384;

constexpr size_t MiB = 1u << 20;
constexpr size_t WS_CTL = 0, CTL_ZERO_BYTES = 1 * MiB;
constexpr size_t WS_W1A = 2 * MiB, WS_W1B = 13 * MiB, WS_WIN = 19 * MiB, WS_WOUT = 30 * MiB, WS_W2A = 34 * MiB, WS_W2B = 45 * MiB, WS_WCF = 51 * MiB, WS_PEB = 52 * MiB, WS_KMP = 52 * MiB + 655360, WS_WCFL = 52 * MiB + 65536, WS_QS32 = 69 * MiB, WS_KCS32 = 618 * MiB, WS_PART = 624 * MiB;
constexpr size_t WS_GATES = 53 * MiB, WS_DT = 57 * MiB, WS_SSQA = 59 * MiB, WS_SSQY = 61 * MiB, WS_DC = 63 * MiB, WS_KCP = 64 * MiB, WS_KCS = 65 * MiB;
constexpr size_t WS_XN = 70 * MiB, WS_Q = 103 * MiB, WS_CKV = 136 * MiB, WS_SKV = 153 * MiB, WS_WKV = 170 * MiB, WS_Z = 187 * MiB, WS_XBC = 220 * MiB;
constexpr size_t WS_XCV = 269 * MiB, WS_BCV = 301 * MiB, WS_CCV = 309 * MiB, WS_SCV = 317 * MiB;
constexpr size_t WS_ACT = 269 * MiB, WS_O32 = 359 * MiB, WS_X1 = 424 * MiB, WS_MIX = 489 * MiB, WS_ST = 554 * MiB, WS_END = 636 * MiB;
constexpr int CW_BAR = 4096, CW_KMAX = 8192, CW_SCAN = 12288;

constexpr int LDS_BYTES = 163840;
constexpr int MISC_OFF = LDS_BYTES - 256;

__device__ __forceinline__ float wave_sum(float v) {
#pragma unroll
    for (int o = 1; o < 64; o <<= 1) v += __shfl_xor(v, o);
    return v;
}
__device__ __forceinline__ float fast_exp2(float x) { return __builtin_amdgcn_exp2f(x); }
__device__ __forceinline__ float fast_rcp(float x) { return __builtin_amdgcn_rcpf(x); }
__device__ __forceinline__ float silu_f(float x) { return x * fast_rcp(1.0f + fast_exp2(-x * LOG2E)); }
__device__ __forceinline__ float sigmoid_f(float x) { return fast_rcp(1.0f + fast_exp2(-x * LOG2E)); }
typedef float f32x2_t __attribute__((ext_vector_type(2))); typedef __bf16 bf16x2_t __attribute__((ext_vector_type(2)));
__device__ __forceinline__ unsigned cvtpk(float lo, float hi) { f32x2_t v = {lo, hi}; bf16x2_t b = __builtin_convertvector(v, bf16x2_t); return __builtin_bit_cast(unsigned, b); }
__device__ __forceinline__ float bf2f(unsigned short h) { return __uint_as_float(((unsigned)h) << 16); }

struct EpiSwiglu {
    static constexpr bool PERM = true, AFTER_DRAIN = false, KHOOK = false;
    bf16* O;
    __device__ __forceinline__ void operator()(const pg8::f32x4 (&acc)[2][2][4][2], const pg8::Unit& u, int wr, int wc, int fr, int fq) const {
        const int row0 = u.pm * 256 + wr * 64 + fr, col0 = u.pn * 128 + wc * 32 + 8 * fq;
#pragma unroll
        for (int ai = 0; ai < 2; ++ai)
#pragma unroll
            for (int m = 0; m < 4; ++m) {
                bf16* rowp = O + (size_t)(row0 + ai * 128 + m * 16) * DFF + col0;
                const pg8::f32x4 g0 = acc[ai][0][m][0], g1 = acc[ai][0][m][1], u0 = acc[ai][1][m][0], u1 = acc[ai][1][m][1];
                pg8::u32x4 w;
                w.x = cvtpk(silu_f(g0[0]) * u0[0], silu_f(g0[1]) * u0[1]); w.y = cvtpk(silu_f(g0[2]) * u0[2], silu_f(g0[3]) * u0[3]);
                w.z = cvtpk(silu_f(g1[0]) * u1[0], silu_f(g1[1]) * u1[1]); w.w = cvtpk(silu_f(g1[2]) * u1[2], silu_f(g1[3]) * u1[3]);
                *(pg8::u32x4*)rowp = w;
            }
    }
};
struct EpiF32 {
    static constexpr bool PERM = false, AFTER_DRAIN = false, KHOOK = false;
    float* C;
    __device__ __forceinline__ void operator()(const pg8::f32x4 (&acc)[2][2][4][2], const pg8::Unit& u, int wr, int wc, int fr, int fq) const {
        const int row0 = u.pm * 256 + wr * 64 + fr, col0 = u.pn * 256 + wc * 32 + 4 * fq;
#pragma unroll
        for (int ai = 0; ai < 2; ++ai)
#pragma unroll
            for (int m = 0; m < 4; ++m) { float* rowp = C + (size_t)(row0 + ai * 128 + m * 16) * DM + col0;
#pragma unroll
                for (int bj = 0; bj < 2; ++bj)
#pragma unroll
                    for (int n = 0; n < 2; ++n) *(pg8::f32x4*)(rowp + bj * 128 + n * 16) = acc[ai][bj][m][n]; }
    }
};
struct MixedOrder {
    pg8::StaticOrder S; int nks;
    __device__ __forceinline__ bool next(int i, pg8::Unit& u) const {
        if (i * S.G + S.c < S.nwg) return S.next(i, u);
        const int L = i * S.G + S.c - S.nwg; if (L >= 4 * nks) return false;
        u.pm = 64; u.pn = L & 3; u.ko = (L >> 2) * 256; u.kl = 256; return true; }
    __device__ __forceinline__ void a_ready(const pg8::Unit&) const {}
    __device__ __forceinline__ void done(const pg8::Unit&) const {}
};
struct EpiF32Mixed {
    static constexpr bool PERM = true, AFTER_DRAIN = false, KHOOK = false;
    bf16* C; float* P;
    __device__ __forceinline__ void operator()(const pg8::f32x4 (&acc)[2][2][4][2], const pg8::Unit& u, int wr, int wc, int fr, int fq) const {
        const int col0 = u.pn * 256 + wc * 32 + 8 * fq;
        if (u.pm == 64) {
            float* base = P + (size_t)(u.ko >> 8) * (NSA * DM) + (size_t)(wr * 64 + fr) * DM + col0;
#pragma unroll
            for (int ai = 0; ai < 2; ++ai)
#pragma unroll
                for (int m = 0; m < 4; ++m) { float* rowp = base + (size_t)(ai * 128 + m * 16) * DM;
#pragma unroll
                    for (int bj = 0; bj < 2; ++bj) { *(pg8::f32x4*)(rowp + bj * 128) = acc[ai][bj][m][0]; *(pg8::f32x4*)(rowp + bj * 128 + 4) = acc[ai][bj][m][1]; } }
        } else {
            bf16* base = C + (size_t)(u.pm * 256 + wr * 64 + fr) * DM + col0;
#pragma unroll
            for (int ai = 0; ai < 2; ++ai)
#pragma unroll
                for (int m = 0; m < 4; ++m) { bf16* rowp = base + (size_t)(ai * 128 + m * 16) * DM;
#pragma unroll
                    for (int bj = 0; bj < 2; ++bj) { const pg8::f32x4 v0 = acc[ai][bj][m][0], v1 = acc[ai][bj][m][1];
                        pg8::u32x4 w; w.x = cvtpk(v0[0], v0[1]); w.y = cvtpk(v0[2], v0[3]); w.z = cvtpk(v1[0], v1[1]); w.w = cvtpk(v1[2], v1[3]);
                        *(pg8::u32x4*)(rowp + bj * 128) = w; } }
        }
    }
};
__device__ __forceinline__ void rs_fill(LAS float* RS, int pm, const float* SSQA, const float* SSQY, int tid) {
    if (tid < 256) {
        const size_t row = (size_t)pm * 256 + tid; float sa = 0.f, s0 = 0.f, s1 = 0.f;
        const GAS f32x4* a4 = (const GAS f32x4*)(SSQA + row * 16); const GAS f32x4* y4 = (const GAS f32x4*)(SSQY + row * 16);
#pragma unroll
        for (int q = 0; q < 4; ++q) { const f32x4 v = a4[q]; sa += (v.x + v.y) + (v.z + v.w); }
        { const f32x4 v = y4[0], w = y4[1]; s0 = ((v.x + v.y) + (v.z + v.w)) + ((w.x + w.y) + (w.z + w.w)); }
        { const f32x4 v = y4[2], w = y4[3]; s1 = ((v.x + v.y) + (v.z + v.w)) + ((w.x + w.y) + (w.z + w.w)); }
        const float ra = 1.0f / sqrtf(sa * (1.f / 1024.f) + EPS), r0 = 1.0f / sqrtf(s0 * (1.f / 512.f) + EPS), r1 = 1.0f / sqrtf(s1 * (1.f / 512.f) + EPS);
        LAS f32x4* r = (LAS f32x4*)(RS + ((pm == 64 ? 1 : 0) * 256 + tid) * 4);
        *r = (pm == 64) ? (f32x4){ra, r0, r1, 0.f} : (f32x4){ra / r0, r0 / r1, r1, 0.f};
    }
}
struct EpiOutProj {
    static constexpr bool PERM = true, AFTER_DRAIN = false, KHOOK = true;
    bf16* C; float* P; const LAS float* RS;
    __device__ __forceinline__ void khook(int t, pg8::f32x4 (&acc)[2][2][4][2], int wr, int fr) const {
        const LAS float* r0 = RS + (wr * 64 + fr) * 4 + (t == 16 ? 0 : 1);
#pragma unroll
        for (int ai = 0; ai < 2; ++ai)
#pragma unroll
            for (int m = 0; m < 4; ++m) { const float f = r0[(ai * 128 + m * 16) * 4];
#pragma unroll
                for (int bj = 0; bj < 2; ++bj)
#pragma unroll
                    for (int n = 0; n < 2; ++n) acc[ai][bj][m][n] = acc[ai][bj][m][n] * f; }
    }
    __device__ __forceinline__ void operator()(const pg8::f32x4 (&acc)[2][2][4][2], const pg8::Unit& u, int wr, int wc, int fr, int fq) const {
        asm volatile("" : "+v"(fr), "+v"(fq));
        const int col0 = u.pn * 256 + wc * 32 + 8 * fq;
        const int ui = (u.pm == 64) ? 1 : 0, seg = u.ko < 1024 ? 0 : (u.ko < 1536 ? 1 : 2);
#pragma unroll
        for (int ai = 0; ai < 2; ++ai)
#pragma unroll
            for (int m = 0; m < 4; ++m) {
                const int rl = ai * 128 + wr * 64 + m * 16 + fr;
                const LAS float* r = RS + (ui * 256 + rl) * 4;
                if (u.pm == 64) {
                    const float f = r[seg];
                    float* rowp = P + (size_t)(u.ko >> 8) * (NSA * DM) + (size_t)rl * DM + col0;
#pragma unroll
                    for (int bj = 0; bj < 2; ++bj) { *(pg8::f32x4*)(rowp + bj * 128) = acc[ai][bj][m][0] * f; *(pg8::f32x4*)(rowp + bj * 128 + 4) = acc[ai][bj][m][1] * f; }
                } else {
                    const float f = r[2];
                    bf16* rowp = C + (size_t)(u.pm * 256 + rl) * DM + col0;
#pragma unroll
                    for (int bj = 0; bj < 2; ++bj) { const pg8::f32x4 v0 = acc[ai][bj][m][0] * f, v1 = acc[ai][bj][m][1] * f;
                        pg8::u32x4 w; w.x = cvtpk(v0[0], v0[1]); w.y = cvtpk(v0[2], v0[3]); w.z = cvtpk(v1[0], v1[1]); w.w = cvtpk(v1[2], v1[3]);
                        *(pg8::u32x4*)(rowp + bj * 128) = w; }
                }
            }
    }
};
struct EpiInProj {
    static constexpr bool PERM = true, AFTER_DRAIN = false, KHOOK = false;
    bf16 *Q, *CKV, *Z, *XBC; float *GATES, *DT, *out;
    __device__ __forceinline__ void operator()(const pg8::f32x4 (&acc)[2][2][4][2], const pg8::Unit& u, int wr, int wc, int fr, int fq) const {
        const int pn = u.pn;
        const bool samp = (u.pm == 64);
#pragma unroll
        for (int ai = 0; ai < 2; ++ai)
#pragma unroll
            for (int m = 0; m < 4; ++m) {
                const int row = u.pm * 256 + ai * 128 + wr * 64 + m * 16 + fr;
                const int pb = row >> 12, pt = row & 4095;
                const int sr = row - NPR, sb = sr >> 3, st = sr & 7;
#pragma unroll
                for (int bj = 0; bj < 2; ++bj) {
                    const int cb = bj * 128 + wc * 32 + 8 * fq;
                    const pg8::f32x4 v0 = acc[ai][bj][m][0], v1 = acc[ai][bj][m][1];
                    if (pn < 4) {
                        pg8::u32x4 w; w.x = cvtpk(v0[0] * C2, v0[1] * C2); w.y = cvtpk(v0[2] * C2, v0[3] * C2); w.z = cvtpk(v1[0] * C2, v1[1] * C2); w.w = cvtpk(v1[2] * C2, v1[3] * C2);
                        *(pg8::u32x4*)(Q + (size_t)row * DM + pn * 256 + cb) = w;
                    } else if (pn < 10) {
                        const int which = (pn - 4) >> 1, col = ((pn - 4) & 1) * 256 + cb;
                        pg8::u32x4 w; w.x = cvtpk(v0[0], v0[1]); w.y = cvtpk(v0[2], v0[3]); w.z = cvtpk(v1[0], v1[1]); w.w = cvtpk(v1[2], v1[3]);
                        *(pg8::u32x4*)(CKV + (size_t)which * ((WS_SKV - WS_CKV) / 2) + (size_t)row * KVW + col) = w;
                        size_t fo; bool st_ok = true;
                        if (!samp) {
                            if (which < 2) fo = O_PCMP + (size_t)which * (O_PSLC - O_PCMP) + (size_t)row * KVW + col;
                            else { st_ok = (pt >= SEQ - 512); fo = O_PWIN + ((size_t)pb * 512 + (pt - (SEQ - 512))) * KVW + col; }
                        } else {
                            if (which < 2) fo = O_SCMP + (size_t)which * (O_SSLC - O_SCMP) + (size_t)sr * KVW + col;
                            else fo = O_SWIN + ((size_t)sb * 512 + 504 + st) * KVW + col;
                        }
                        if (st_ok) { __builtin_nontemporal_store(v0, (GAS pg8::f32x4*)(out + fo)); __builtin_nontemporal_store(v1, (GAS pg8::f32x4*)(out + fo + 4)); }
                    } else if (pn < 14) {
                        pg8::u32x4 w; w.x = cvtpk(v0[0], v0[1]); w.y = cvtpk(v0[2], v0[3]); w.z = cvtpk(v1[0], v1[1]); w.w = cvtpk(v1[2], v1[3]);
                        *(pg8::u32x4*)(Z + (size_t)row * DM + (pn - 10) * 256 + cb) = w;
                    } else if (pn < 20) {
                        const int col = (pn - 14) * 256 + cb;
                        pg8::u32x4 w; w.x = cvtpk(v0[0], v0[1]); w.y = cvtpk(v0[2], v0[3]); w.z = cvtpk(v1[0], v1[1]); w.w = cvtpk(v1[2], v1[3]);
                        *(pg8::u32x4*)(XBC + (size_t)row * CONVD + col) = w;
                        size_t fo; bool st_ok;
                        if (!samp) { st_ok = (pt >= SEQ - 3); fo = O_PCONV + ((size_t)pb * 3 + (pt - (SEQ - 3))) * CONVD + col; }
                        else { st_ok = (st >= STOK - 3); fo = O_SCONV + ((size_t)sb * 3 + (st - (STOK - 3))) * CONVD + col; }
                        if (st_ok) { __builtin_nontemporal_store(v0, (GAS pg8::f32x4*)(out + fo)); __builtin_nontemporal_store(v1, (GAS pg8::f32x4*)(out + fo + 4)); }
                    } else {
                        if (cb < 48) { float* fo = GATES + (size_t)row * 48 + cb; *(pg8::f32x4*)fo = v0; *(pg8::f32x4*)(fo + 4) = v1; }
                        else if (cb < 64) { float* fo = DT + (size_t)row * 16 + (cb - 48); *(pg8::f32x4*)fo = v0; *(pg8::f32x4*)(fo + 4) = v1; }
                    }
                }
            }
    }
};

template <int MODE> __device__ __forceinline__ int src_col(int n) {
    if (MODE == 0) return ((n >> 7) & 1 ? DFF : 0) + (n >> 8) * 128 + (n & 127);
    if (MODE == 2) {
        if (n < 2560) return n;
        if (n < 3584) return n + 48;
        if (n < 5120) return n + 48;
        if (n < 5168) return n - 2560;
        if (n < 5184) return n;
        return -1;
    }
    return n;
}
template <int MODE> __device__ __forceinline__ void transpose_item64(const float* W, int K, int ldw, bf16* WT, const float* g1, const float* g2, LAS float* scr, int item, int nblk, int lane) {
    const int kb = item / nblk, nb = item % nblk, k0 = 64 * kb, n0 = 64 * nb, kr = lane >> 4, nq = lane & 15;
    const int sc = src_col<MODE>(n0 + 4 * nq);
    f32x4 v[16];
#pragma unroll
    for (int i = 0; i < 16; ++i) v[i] = sc >= 0 ? *(const GAS f32x4*)(W + (size_t)(k0 + 4 * i + kr) * ldw + sc) : (f32x4){0.f, 0.f, 0.f, 0.f};
#pragma unroll
    for (int i = 0; i < 16; ++i) { const int k = 4 * i + kr; f32x4 x = v[i];
        if (MODE == 3) { const int kg = k0 + k; const float gs = (kg < 1024) ? g1[kg] : g2[kg - 1024]; x = x * gs; }
        LAS float* d = scr + k * 65 + 4 * nq; d[0] = x.x; d[1] = x.y; d[2] = x.z; d[3] = x.w; }
    LDS_WAIT(); asm volatile("" ::: "memory");
    const int c = lane & 7;
#pragma unroll
    for (int j = 0; j < 8; ++j) { const int n = (lane >> 3) + 8 * j; const LAS float* s_ = scr + (8 * c) * 65 + n;
        v4u o; o.x = pk2(s_[0 * 65], s_[1 * 65]); o.y = pk2(s_[2 * 65], s_[3 * 65]); o.z = pk2(s_[4 * 65], s_[5 * 65]); o.w = pk2(s_[6 * 65], s_[7 * 65]);
        *(GAS v4u*)(WT + (size_t)(n0 + n) * K + k0 + 8 * c) = o; }
    LDS_WAIT(); asm volatile("" ::: "memory");
}
template <int MODE> __device__ __forceinline__ void transpose_item(const float* W, int K, int ldw, bf16* WT, const float* g1, const float* g2, LAS float* scr, int item, int nblk, int lane) {
    const int kb = item / nblk, nb = item % nblk, k0 = 64 * kb, n0 = 32 * nb;
    const int sc = src_col<MODE>(n0 + (lane & 31));
#pragma unroll 8
    for (int i = 0; i < 32; ++i) { const int kk = 2 * i + (lane >> 5); float v = sc >= 0 ? W[(size_t)(k0 + kk) * ldw + sc] : 0.f;
        if (MODE == 3) { const int k = k0 + kk; v *= (k < 1024) ? g1[k] : g2[k - 1024]; }
        scr[kk * 33 + (lane & 31)] = v; }
    LDS_WAIT(); asm volatile("" ::: "memory");
    const int c = lane & 7;
#pragma unroll
    for (int j = 0; j < 4; ++j) { const int n = (lane >> 3) + 8 * j; const LAS float* s = scr + (8 * c) * 33 + n;
        v4u o; o.x = pk2(s[0 * 33], s[1 * 33]); o.y = pk2(s[2 * 33], s[3 * 33]); o.z = pk2(s[4 * 33], s[5 * 33]); o.w = pk2(s[6 * 33], s[7 * 33]);
        *(GAS v4u*)(WT + (size_t)(n0 + n) * K + k0 + 8 * c) = o; }
    LDS_WAIT(); asm volatile("" ::: "memory");
}
__device__ __forceinline__ void rms_row_to_bf16(const float* xrow, const float* g, bf16* orow, int lane) {
    const GAS f32x4* xr = (const GAS f32x4*)xrow + lane; const GAS f32x4* gr = (const GAS f32x4*)g + lane;
    f32x4 v[4]; float s = 0.f;
#pragma unroll
    for (int j = 0; j < 4; ++j) { v[j] = xr[64 * j]; s += (v[j].x * v[j].x + v[j].y * v[j].y) + (v[j].z * v[j].z + v[j].w * v[j].w); }
    const float rs = 1.0f / sqrtf(wave_sum(s) * (1.f / DM) + EPS);
    GAS unsigned long long* o8 = (GAS unsigned long long*)orow + lane;
#pragma unroll
    for (int j = 0; j < 4; ++j) { const f32x4 gg = gr[64 * j];
        o8[64 * j] = (unsigned long long)pk2(v[j].x * rs * gg.x, v[j].y * rs * gg.y) | ((unsigned long long)pk2(v[j].z * rs * gg.z, v[j].w * rs * gg.w) << 32); }
}
__device__ __forceinline__ void rms_rows4_to_bf16(const float* x0, const float* x1, const float* x2, const float* x3, const float* g, bf16* o0, bf16* o1, bf16* o2, bf16* o3, int lane) {
    const float* xs[4] = {x0, x1, x2, x3}; bf16* os[4] = {o0, o1, o2, o3};
    f32x4 v[4][4];
#pragma unroll
    for (int r = 0; r < 4; ++r) { const GAS f32x4* xr = (const GAS f32x4*)xs[r] + lane;
#pragma unroll
        for (int j = 0; j < 4; ++j) v[r][j] = xr[64 * j]; }
    const GAS f32x4* gr = (const GAS f32x4*)g + lane;
    f32x4 gg[4];
#pragma unroll
    for (int j = 0; j < 4; ++j) gg[j] = gr[64 * j];
#pragma unroll
    for (int r = 0; r < 4; ++r) { float s = 0.f;
#pragma unroll
        for (int j = 0; j < 4; ++j) s += (v[r][j].x * v[r][j].x + v[r][j].y * v[r][j].y) + (v[r][j].z * v[r][j].z + v[r][j].w * v[r][j].w);
        const float rs = 1.0f / sqrtf(wave_sum(s) * (1.f / DM) + EPS);
        GAS unsigned long long* o8 = (GAS unsigned long long*)os[r] + lane;
#pragma unroll
        for (int j = 0; j < 4; ++j)
            o8[64 * j] = (unsigned long long)pk2(v[r][j].x * rs * gg[j].x, v[r][j].y * rs * gg[j].y) | ((unsigned long long)pk2(v[r][j].z * rs * gg[j].z, v[r][j].w * rs * gg[j].w) << 32); }
}
struct RowRegs { f32x4 x[4]; unsigned long long o[4]; };
__device__ __forceinline__ void row_load(RowRegs& r, const float* xin, const bf16* orow, int lane) {
    const GAS f32x4* xr = (const GAS f32x4*)xin + lane; const GAS unsigned long long* ob = (const GAS unsigned long long*)orow + lane;
#pragma unroll
    for (int j = 0; j < 4; ++j) { r.x[j] = xr[64 * j]; r.o[j] = ob[64 * j]; }
}
__device__ __forceinline__ void row_finish(RowRegs& r, const float* gpost, float coef, float* x1row, const float* gpre, bf16* xnrow, int lane, bool wx = true) {
    const GAS f32x4* gp = (const GAS f32x4*)gpost + lane;
    f32x4 o[4]; float s = 0.f;
#pragma unroll
    for (int j = 0; j < 4; ++j) { const unsigned lo = (unsigned)r.o[j], hi = (unsigned)(r.o[j] >> 32);
        o[j] = (f32x4){__uint_as_float(lo << 16), __uint_as_float(lo & 0xffff0000u), __uint_as_float(hi << 16), __uint_as_float(hi & 0xffff0000u)};
        s += (o[j].x * o[j].x + o[j].y * o[j].y) + (o[j].z * o[j].z + o[j].w * o[j].w); }
    const float rs = coef / sqrtf(wave_sum(s) * (1.f / DM) + EPS);
    float s2 = 0.f;
    GAS f32x4* xo = (GAS f32x4*)x1row + lane;
#pragma unroll
    for (int j = 0; j < 4; ++j) { const f32x4 gg = gp[64 * j]; f32x4 x = r.x[j];
        x.x += o[j].x * rs * gg.x; x.y += o[j].y * rs * gg.y; x.z += o[j].z * rs * gg.z; x.w += o[j].w * rs * gg.w;
        if (wx) xo[64 * j] = x;
        r.x[j] = x;
        s2 += (x.x * x.x + x.y * x.y) + (x.z * x.z + x.w * x.w); }
    if (gpre) {
        const float rs2 = 1.0f / sqrtf(wave_sum(s2) * (1.f / DM) + EPS);
        const GAS f32x4* gq = (const GAS f32x4*)gpre + lane;
        GAS unsigned long long* o8 = (GAS unsigned long long*)xnrow + lane;
#pragma unroll
        for (int j = 0; j < 4; ++j) { const f32x4 gg = gq[64 * j]; const f32x4 x = r.x[j];
            o8[64 * j] = (unsigned long long)pk2(x.x * rs2 * gg.x, x.y * rs2 * gg.y) | ((unsigned long long)pk2(x.z * rs2 * gg.z, x.w * rs2 * gg.w) << 32); }
    }
}
struct RowRegs2 { f32x4 x[4]; unsigned long long o1[4], o2[4]; };
__device__ __forceinline__ void row_load2(RowRegs2& r, const float* xin, const bf16* o1row, const bf16* o2row, int lane) {
    const GAS f32x4* xr = (const GAS f32x4*)xin + lane; const GAS unsigned long long* a = (const GAS unsigned long long*)o1row + lane; const GAS unsigned long long* b = (const GAS unsigned long long*)o2row + lane;
#pragma unroll
    for (int j = 0; j < 4; ++j) { r.x[j] = xr[64 * j]; r.o1[j] = a[64 * j]; r.o2[j] = b[64 * j]; }
}
__device__ __forceinline__ void row_finish2(RowRegs2& r, const float* g1, const float* g2, float c2, float* yrow, int lane) {
    f32x4 a[4], b[4]; float s1 = 0.f, s2 = 0.f;
#pragma unroll
    for (int j = 0; j < 4; ++j) { const unsigned l1 = (unsigned)r.o1[j], h1 = (unsigned)(r.o1[j] >> 32), l2 = (unsigned)r.o2[j], h2 = (unsigned)(r.o2[j] >> 32);
        a[j] = (f32x4){__uint_as_float(l1 << 16), __uint_as_float(l1 & 0xffff0000u), __uint_as_float(h1 << 16), __uint_as_float(h1 & 0xffff0000u)};
        b[j] = (f32x4){__uint_as_float(l2 << 16), __uint_as_float(l2 & 0xffff0000u), __uint_as_float(h2 << 16), __uint_as_float(h2 & 0xffff0000u)};
        s1 += (a[j].x * a[j].x + a[j].y * a[j].y) + (a[j].z * a[j].z + a[j].w * a[j].w);
        s2 += (b[j].x * b[j].x + b[j].y * b[j].y) + (b[j].z * b[j].z + b[j].w * b[j].w); }
    const float rs1 = 1.0f / sqrtf(wave_sum(s1) * (1.f / DM) + EPS), rs2 = c2 / sqrtf(wave_sum(s2) * (1.f / DM) + EPS);
    const GAS f32x4* p1 = (const GAS f32x4*)g1 + lane; const GAS f32x4* p2 = (const GAS f32x4*)g2 + lane;
    GAS f32x4* yo = (GAS f32x4*)yrow + lane;
#pragma unroll
    for (int j = 0; j < 4; ++j) { const f32x4 u = p1[64 * j], v = p2[64 * j]; f32x4 x = r.x[j];
        x.x += a[j].x * rs1 * u.x; x.y += a[j].y * rs1 * u.y; x.z += a[j].z * rs1 * u.z; x.w += a[j].w * rs1 * u.w;
        x.x += b[j].x * rs2 * v.x; x.y += b[j].y * rs2 * v.y; x.z += b[j].z * rs2 * v.z; x.w += b[j].w * rs2 * v.w;
        __builtin_nontemporal_store(x, yo + 64 * j); }
}
template <bool OBF> __device__ __forceinline__ void row_post(const float* xin, const void* orow_, int nparts, size_t pstride, const float* gpost, float coef, float* x1row, const float* gpre, bf16* xnrow, int lane) {
    const float* orow = (const float*)orow_;
    const GAS f32x4* xr = (const GAS f32x4*)xin + lane; const GAS f32x4* orr = (const GAS f32x4*)orow + lane; const GAS f32x4* gp = (const GAS f32x4*)gpost + lane;
    f32x4 x[4], o[4]; float s = 0.f;
#pragma unroll
    for (int j = 0; j < 4; ++j) x[j] = xr[64 * j];
    if (OBF) {
        const GAS unsigned long long* ob = (const GAS unsigned long long*)orow_ + lane;
#pragma unroll
        for (int j = 0; j < 4; ++j) { const unsigned long long w = ob[64 * j]; const unsigned lo = (unsigned)w, hi = (unsigned)(w >> 32);
            o[j] = (f32x4){__uint_as_float(lo << 16), __uint_as_float(lo & 0xffff0000u), __uint_as_float(hi << 16), __uint_as_float(hi & 0xffff0000u)}; }
    } else {
#pragma unroll
        for (int j = 0; j < 4; ++j) o[j] = orr[64 * j];
    }
    for (int q = 1; q < nparts; ++q) {
        const GAS f32x4* pr = (const GAS f32x4*)(orow + q * pstride) + lane;
#pragma unroll
        for (int j = 0; j < 4; ++j) o[j] = o[j] + pr[64 * j]; }
#pragma unroll
    for (int j = 0; j < 4; ++j) s += (o[j].x * o[j].x + o[j].y * o[j].y) + (o[j].z * o[j].z + o[j].w * o[j].w);
    const float rs = coef / sqrtf(wave_sum(s) * (1.f / DM) + EPS);
    float s2 = 0.f;
    GAS f32x4* xo = (GAS f32x4*)x1row + lane;
#pragma unroll
    for (int j = 0; j < 4; ++j) { const f32x4 gg = gp[64 * j];
        x[j].x += o[j].x * rs * gg.x; x[j].y += o[j].y * rs * gg.y; x[j].z += o[j].z * rs * gg.z; x[j].w += o[j].w * rs * gg.w;
        xo[64 * j] = x[j];
        s2 += (x[j].x * x[j].x + x[j].y * x[j].y) + (x[j].z * x[j].z + x[j].w * x[j].w); }
    if (gpre) {
        const float rs2 = 1.0f / sqrtf(wave_sum(s2) * (1.f / DM) + EPS);
        const GAS f32x4* gq = (const GAS f32x4*)gpre + lane;
        GAS unsigned long long* o8 = (GAS unsigned long long*)xnrow + lane;
#pragma unroll
        for (int j = 0; j < 4; ++j) { const f32x4 gg = gq[64 * j];
            o8[64 * j] = (unsigned long long)pk2(x[j].x * rs2 * gg.x, x[j].y * rs2 * gg.y) | ((unsigned long long)pk2(x[j].z * rs2 * gg.z, x[j].w * rs2 * gg.w) << 32); }
    }
}

typedef float f32x16 __attribute__((ext_vector_type(16)));
#define MFMA32(a, b, c) __builtin_amdgcn_mfma_f32_32x32x16_bf16((a), (b), (c), 0, 0, 0)
__device__ __forceinline__ int crow(int r, int hi) { return (r & 3) + 8 * (r >> 2) + 4 * hi; }
constexpr int SSTR = 272;
__device__ __forceinline__ float softplus_f(float x) { return x > 20.f ? x : log1pf(__expf(x)); }
__device__ __forceinline__ void wg_sync() { __syncthreads(); }

__device__ __forceinline__ void ssd_chunk_scalars(const float* DTR, const float* dt_bias, const float* a_log, int m0, int h, LAS float* dts, LAS float* css, int wave, int lane) {
    if (wave == 0) {
        const float bias = dt_bias[h], a = -__expf(a_log[h]);
        const float d0 = softplus_f(DTR[(size_t)(m0 + 2 * lane) * 16 + h] + bias), d1 = softplus_f(DTR[(size_t)(m0 + 2 * lane + 1) * 16 + h] + bias);
        const float l0 = d0 * a, l1 = d1 * a;
        float s = l0 + l1;
#pragma unroll
        for (int o = 1; o < 64; o <<= 1) { const float t = __shfl_up(s, o); if (lane >= o) s += t; }
        dts[2 * lane] = d0; dts[2 * lane + 1] = d1; css[2 * lane] = s - l1; css[2 * lane + 1] = s;
    }
}
template <int NCP, bool TR> __device__ __forceinline__ void conv_tile(const bf16* XBC, int m0, bool has_hist, int ch0, const float* conv_w, const float* conv_b,
                                                                     LAS unsigned char* dst, const LAS float* rowscale, int tid_, int toff = 0) {
    const int tid = (tid_ - toff) & (NWAVES * 64 - 1);
    constexpr int NG = NCP / 4;
    for (int task = tid; task < NG * 16; task += NWAVES * 64) {
        const int cg = task % NG, seg = task / NG, ch = ch0 + 8 * cg, l0 = 8 * seg;
        v4u xr[11];
#pragma unroll
        for (int r = 0; r < 11; ++r) {
            const int l = l0 - 3 + r;
            xr[r] = (v4u){0u, 0u, 0u, 0u};
            if (l >= 0 || has_hist) xr[r] = *(const GAS v4u*)(XBC + (size_t)(m0 + l) * CONVD + ch);
        }
        f32x4 w[4][2], bia[2];
#pragma unroll
        for (int k = 0; k < 4; ++k) { w[k][0] = *(const GAS f32x4*)(conv_w + k * CONVD + ch); w[k][1] = *(const GAS f32x4*)(conv_w + k * CONVD + ch + 4); }
        bia[0] = *(const GAS f32x4*)(conv_b + ch); bia[1] = *(const GAS f32x4*)(conv_b + ch + 4);
#define CONV_X(r, c) (((c) & 1) ? __uint_as_float(xr[r][(c) >> 1] & 0xffff0000u) : __uint_as_float(xr[r][(c) >> 1] << 16))
#define CONV_W(k, c) (w[k][(c) >> 2][(c) & 3])
        if (TR) {
#pragma unroll
            for (int c = 0; c < 8; ++c) {
                float y[8];
#pragma unroll
                for (int i = 0; i < 8; ++i) { float s0 = bia[c >> 2][c & 3];
#pragma unroll
                    for (int k = 0; k < 4; ++k) s0 += CONV_W(k, c) * CONV_X(i + k, c);
                    y[i] = silu_f(s0); if (rowscale) y[i] *= rowscale[l0 + i]; }
                v4u o; o.x = pk2(y[0], y[1]); o.y = pk2(y[2], y[3]); o.z = pk2(y[4], y[5]); o.w = pk2(y[6], y[7]);
                *(LAS v4u*)(dst + (8 * cg + c) * SSTR + l0 * 2) = o;
            }
        } else {
#pragma unroll
            for (int i = 0; i < 8; ++i) {
                float y[8];
#pragma unroll
                for (int c = 0; c < 8; ++c) { float s0 = bia[c >> 2][c & 3];
#pragma unroll
                    for (int k = 0; k < 4; ++k) s0 += CONV_W(k, c) * CONV_X(i + k, c);
                    y[c] = silu_f(s0); }
                v4u o; o.x = pk2(y[0], y[1]); o.y = pk2(y[2], y[3]); o.z = pk2(y[4], y[5]); o.w = pk2(y[6], y[7]);
                *(LAS v4u*)(dst + (l0 + i) * SSTR + (8 * cg) * 2) = o;
            }
        }
#undef CONV_X
#undef CONV_W
    }
}

template <int NCP, bool LT, bool GN>
__device__ __forceinline__ void conv_multi(const bf16* XBC, int m0, bool has_hist, int ch0, const float* conv_w, const float* conv_b,
                                           LAS unsigned char* lt, const LAS float* rowscale, unsigned char* gt, unsigned char* gn, int tid_, int toff) {
    const int tid = (tid_ - toff) & (NWAVES * 64 - 1);
    constexpr int NG = NCP / 4;
    for (int task = tid; task < NG * 16; task += NWAVES * 64) {
        const int cg = task % NG, seg = task / NG, ch = ch0 + 8 * cg, l0 = 8 * seg;
        v4u xr[11];
#pragma unroll
        for (int r = 0; r < 11; ++r) {
            const int l = l0 - 3 + r;
            xr[r] = (v4u){0u, 0u, 0u, 0u};
            if (l >= 0 || has_hist) xr[r] = *(const GAS v4u*)(XBC + (size_t)(m0 + l) * CONVD + ch);
        }
        f32x4 w[4][2], bia[2];
#pragma unroll
        for (int k = 0; k < 4; ++k) { w[k][0] = *(const GAS f32x4*)(conv_w + k * CONVD + ch); w[k][1] = *(const GAS f32x4*)(conv_w + k * CONVD + ch + 4); }
        bia[0] = *(const GAS f32x4*)(conv_b + ch); bia[1] = *(const GAS f32x4*)(conv_b + ch + 4);
#define CONV_X(r, c) (((c) & 1) ? __uint_as_float(xr[r][(c) >> 1] & 0xffff0000u) : __uint_as_float(xr[r][(c) >> 1] << 16))
#define CONV_W(k, c) (w[k][(c) >> 2][(c) & 3])
#define CONV_Y(i, c) silu_f(bia[(c) >> 2][(c) & 3] + CONV_W(0, c) * CONV_X((i), c) + CONV_W(1, c) * CONV_X((i) + 1, c) + CONV_W(2, c) * CONV_X((i) + 2, c) + CONV_W(3, c) * CONV_X((i) + 3, c))
        if (!GN) {
#pragma unroll
            for (int c = 0; c < 8; ++c) {
                float y[8];
#pragma unroll
                for (int i = 0; i < 8; ++i) y[i] = CONV_Y(i, c);
                if (gt) { v4u o; o.x = cvtpk(y[0], y[1]); o.y = cvtpk(y[2], y[3]); o.z = cvtpk(y[4], y[5]); o.w = cvtpk(y[6], y[7]);
                    *(GAS v4u*)(gt + (8 * cg + c) * 256 + l0 * 2) = o; }
                if (LT) {
                    if (rowscale) { const LAS float* rsp = rowscale + (cg >> 3) * 128 + l0;
#pragma unroll
                        for (int i = 0; i < 8; ++i) y[i] *= rsp[i]; }
                    v4u o; o.x = cvtpk(y[0], y[1]); o.y = cvtpk(y[2], y[3]); o.z = cvtpk(y[4], y[5]); o.w = cvtpk(y[6], y[7]);
                    *(LAS v4u*)(lt + (8 * cg + c) * SSTR + l0 * 2) = o; }
            }
        } else if (LT) {
            float y[8][8];
#pragma unroll
            for (int c = 0; c < 8; ++c) {
#pragma unroll
                for (int i = 0; i < 8; ++i) y[c][i] = CONV_Y(i, c);
                v4u o; o.x = cvtpk(y[c][0], y[c][1]); o.y = cvtpk(y[c][2], y[c][3]); o.z = cvtpk(y[c][4], y[c][5]); o.w = cvtpk(y[c][6], y[c][7]);
                *(LAS v4u*)(lt + (8 * cg + c) * SSTR + l0 * 2) = o;
            }
            if (gn) {
#pragma unroll
                for (int i = 0; i < 8; ++i) { v4u o; o.x = cvtpk(y[0][i], y[1][i]); o.y = cvtpk(y[2][i], y[3][i]); o.z = cvtpk(y[4][i], y[5][i]); o.w = cvtpk(y[6][i], y[7][i]);
                    *(GAS v4u*)(gn + (l0 + i) * (NCP * 4) + cg * 16) = o; }
            }
        } else {
#pragma unroll
            for (int i = 0; i < 8; ++i) {
                float y[8];
#pragma unroll
                for (int c = 0; c < 8; ++c) y[c] = CONV_Y(i, c);
                v4u o; o.x = cvtpk(y[0], y[1]); o.y = cvtpk(y[2], y[3]); o.z = cvtpk(y[4], y[5]); o.w = cvtpk(y[6], y[7]);
                *(GAS v4u*)(gn + (l0 + i) * (NCP * 4) + cg * 16) = o;
            }
        }
#undef CONV_X
#undef CONV_W
#undef CONV_Y
    }
}

template <int NH>
__device__ __forceinline__ void ssd_a_item(int unit0, const bf16* XBC, const float* DTR, const float* dt_bias, const float* a_log, const float* conv_w, const float* conv_b,
                                           bf16* STB, float* DC, unsigned char* XCV, unsigned char* BCV, unsigned char* CCV, float* SCV, LAS unsigned char* lds, int tid_, int wave, int lane_) {
    asm volatile("; MARK_ssd_a_item_BEGIN" ::: "memory");
    int tid = tid_, lane = lane_; asm volatile("" : "+v"(tid), "+v"(lane));
    const int hf = unit0 & 15, c = (unit0 >> 4) & 31, b = unit0 >> 9, m0 = b * SEQ + c * 128, g = hf >> 3;
    const bool ex = (hf & 7) == 0;
    LAS unsigned char* BT = lds;
    LAS unsigned char* XT = lds + 128 * SSTR;
    LAS float* wsc = (LAS float*)(lds + 384 * SSTR);
    if (wave < NH) {
        const int h = hf + wave;
        const float bias = dt_bias[h], a = -__expf(a_log[h]);
        const float d0 = softplus_f(DTR[(size_t)(m0 + 2 * lane) * 16 + h] + bias), d1 = softplus_f(DTR[(size_t)(m0 + 2 * lane + 1) * 16 + h] + bias);
        const float l0 = d0 * a, l1 = d1 * a;
        float s = l0 + l1;
#pragma unroll
        for (int o = 1; o < 64; o <<= 1) { const float t = __shfl_up(s, o); if (lane >= o) s += t; }
        const float tot = __shfl(s, 63);
        wsc[wave * 128 + 2 * lane] = d0 * __expf(tot - (s - l1)); wsc[wave * 128 + 2 * lane + 1] = d1 * __expf(tot - s);
        float* sc = SCV + (size_t)(unit0 + wave) * 256;
        sc[2 * lane] = d0; sc[2 * lane + 1] = d1; sc[128 + 2 * lane] = s - l1; sc[128 + 2 * lane + 1] = s;
        if (lane == 63) DC[unit0 + wave] = __expf(s);
    }
    wg_sync();
    const size_t grp = (size_t)((b * 32 + c) * 2 + g);
    conv_multi<64, true, true>(XBC, m0, c > 0, 1024 + g * 128, conv_w, conv_b, BT, nullptr, nullptr, ex ? BCV + grp * 32768 : nullptr, tid, 0);
    if (ex) conv_multi<64, false, true>(XBC, m0, c > 0, 1280 + g * 128, conv_w, conv_b, nullptr, nullptr, nullptr, CCV + grp * 32768, tid, 256);
    constexpr int NR = NH < 4 ? NH : 4;
    const int pt = wave >> 2, nt = wave & 3, r32 = lane & 31, h2 = lane >> 5;
#pragma unroll 1
    for (int r = 0; r < (NH + 3) / 4; ++r) {
        if (r) wg_sync();
        conv_multi<32 * NR, true, false>(XBC, m0, c > 0, (hf + 4 * r) * 64, conv_w, conv_b, XT, wsc + 4 * r * 128, XCV + (size_t)(unit0 + 4 * r) * 16384, nullptr, tid, NH == 8 ? 0 : 256);
        wg_sync();
        bf16x8 bfr[8];
#pragma unroll
        for (int ks = 0; ks < 8; ++ks) bfr[ks] = *(const LAS bf16x8*)(BT + (32 * nt + r32) * SSTR + (16 * ks + 8 * h2) * 2);
#pragma unroll
        for (int k = 0; k < NR; ++k) {
            f32x16 acc;
#pragma unroll
            for (int i = 0; i < 16; ++i) acc[i] = 0.f;
#pragma unroll
            for (int ks = 0; ks < 8; ++ks) {
                const bf16x8 a = *(const LAS bf16x8*)(XT + (64 * k + 32 * pt + r32) * SSTR + (16 * ks + 8 * h2) * 2);
                acc = MFMA32(a, bfr[ks], acc);
            }
            bf16* dstp = STB + (size_t)(unit0 + 4 * r + k) * 8192 + 32 * nt + r32;
#pragma unroll
            for (int i = 0; i < 16; ++i) dstp[(32 * pt + crow(i, h2)) * 128] = (bf16)f2bf(acc[i]);
        }
    }
    wg_sync();
}

__device__ __forceinline__ void ssd_a_unit(int unit, const bf16* XBC, const float* DTR, const float* dt_bias, const float* a_log, const float* conv_w, const float* conv_b,
                                           bf16* STB, float* DC, LAS unsigned char* lds, int tid, int wave, int lane) {
    asm volatile("; MARK_ssd_a_unit_BEGIN" ::: "memory");
    const int h = unit & 15, c = (unit >> 4) & 31, b = unit >> 9, m0 = b * SEQ + c * 128, g = h >> 3;
    LAS unsigned char* XT = lds;
    LAS unsigned char* BT = lds + 64 * SSTR;
    LAS float* dts = (LAS float*)(lds + 192 * SSTR);
    LAS float* css = dts + 128;
    LAS float* wsc = css + 128;
    ssd_chunk_scalars(DTR, dt_bias, a_log, m0, h, dts, css, wave, lane);
    wg_sync();
    if (tid < 128) wsc[tid] = dts[tid] * __expf(css[127] - css[tid]);
    if (tid == 0) DC[unit] = __expf(css[127]);
    wg_sync();
    conv_tile<32, true>(XBC, m0, c > 0, h * 64, conv_w, conv_b, XT, wsc, tid, 256);
    conv_tile<64, true>(XBC, m0, c > 0, 1024 + g * 128, conv_w, conv_b, BT, nullptr, tid);
    wg_sync();
    const int pt = wave >> 2, nt = wave & 3, r32 = lane & 31, h2 = lane >> 5;
    f32x16 acc;
#pragma unroll
    for (int i = 0; i < 16; ++i) acc[i] = 0.f;
#pragma unroll
    for (int ks = 0; ks < 8; ++ks) {
        const bf16x8 a = *(const LAS bf16x8*)(XT + (32 * pt + r32) * SSTR + (16 * ks + 8 * h2) * 2);
        const bf16x8 bb = *(const LAS bf16x8*)(BT + (32 * nt + r32) * SSTR + (16 * ks + 8 * h2) * 2);
        acc = MFMA32(a, bb, acc);
    }
    bf16* dstp = STB + (size_t)unit * 8192 + 32 * nt + r32;
#pragma unroll
    for (int i = 0; i < 16; ++i) dstp[(32 * pt + crow(i, h2)) * 128] = (bf16)f2bf(acc[i]);
    wg_sync();
}

__device__ __forceinline__ void ssd_scan(bf16* STB, const float* DC, float* pssm, int gthread, int nthreads) {
    asm volatile("; MARK_ssd_scan_BEGIN" ::: "memory");
    typedef unsigned long long u64s;
    for (int e4 = gthread; e4 < NB * 16 * 2048; e4 += nthreads) {
        const int bh = e4 >> 11, w4 = e4 & 2047, b = bh >> 4, h = bh & 15;
        float hs[4] = {0.f, 0.f, 0.f, 0.f};
        GAS u64s* p = (GAS u64s*)(STB + ((size_t)(b * 32) * 16 + h) * 8192) + w4;
#pragma unroll 16
        for (int c = 0; c < 32; ++c) {
            const u64s st = p[(size_t)c * 16 * 2048];
            const float dc = DC[(b * 32 + c) * 16 + h];
            p[(size_t)c * 16 * 2048] = (u64s)pk2(hs[0], hs[1]) | ((u64s)pk2(hs[2], hs[3]) << 32);
            const unsigned lo = (unsigned)st, hi = (unsigned)(st >> 32);
            hs[0] = hs[0] * dc + __uint_as_float(lo << 16); hs[1] = hs[1] * dc + __uint_as_float(lo & 0xffff0000u);
            hs[2] = hs[2] * dc + __uint_as_float(hi << 16); hs[3] = hs[3] * dc + __uint_as_float(hi & 0xffff0000u);
        }
        *((GAS f32x4*)(pssm + (size_t)bh * 8192) + w4) = (f32x4){hs[0], hs[1], hs[2], hs[3]};
    }
}

__device__ __forceinline__ void ssd_c_unit(int unit, const bf16* XBC, const float* DTR, const float* dt_bias, const float* a_log, const float* conv_w, const float* conv_b,
                                           const float* d_skip, const bf16* STB, const bf16* ZB, bf16* MIX, float* SSQY, LAS unsigned char* lds, int tid, int wave, int lane) {
    asm volatile("; MARK_ssd_c_unit_BEGIN" ::: "memory");
    const int h = unit & 15, c = (unit >> 4) & 31, b = unit >> 9, m0 = b * SEQ + c * 128, g = h >> 3;
    LAS unsigned char* CL = lds;
    LAS unsigned char* BL = lds + 128 * SSTR;
    LAS unsigned char* XT = lds + 256 * SSTR;
    LAS unsigned char* HL = lds + 320 * SSTR;
    LAS float* dts = (LAS float*)(lds + 384 * SSTR);
    LAS float* css = dts + 128;
    LAS float* ssp = css + 128;
    ssd_chunk_scalars(DTR, dt_bias, a_log, m0, h, dts, css, wave, lane);
    conv_tile<64, false>(XBC, m0, c > 0, 1024 + 256 + g * 128, conv_w, conv_b, CL, nullptr, tid);
    conv_tile<64, false>(XBC, m0, c > 0, 1024 + g * 128, conv_w, conv_b, BL, nullptr, tid);
    conv_tile<32, true>(XBC, m0, c > 0, h * 64, conv_w, conv_b, XT, nullptr, tid);
    {
        const GAS v4u* src = (const GAS v4u*)(STB + (size_t)unit * 8192);
#pragma unroll
        for (int j = 0; j < 2; ++j) { const int e8 = tid + 512 * j, p = e8 >> 4, n = (e8 & 15) * 8; *(LAS v4u*)(HL + p * SSTR + n * 2) = src[e8]; }
    }
    wg_sync();
    const int pt = wave >> 2, ls = wave & 3, r32 = lane & 31, h2 = lane >> 5;
    const int l = 32 * ls + r32;
    const float csl = css[l];
    bf16x8 cf[8];
#pragma unroll
    for (int ks = 0; ks < 8; ++ks) cf[ks] = *(const LAS bf16x8*)(CL + l * SSTR + (16 * ks + 8 * h2) * 2);
    f32x16 acc;
#pragma unroll
    for (int i = 0; i < 16; ++i) acc[i] = 0.f;
#pragma unroll
    for (int ks = 0; ks < 8; ++ks) {
        const bf16x8 a = *(const LAS bf16x8*)(HL + (32 * pt + r32) * SSTR + (16 * ks + 8 * h2) * 2);
        acc = MFMA32(a, cf[ks], acc);
    }
    { const float el = __expf(csl);
#pragma unroll
      for (int i = 0; i < 16; ++i) acc[i] *= el; }
    for (int st = 0; st <= ls; ++st) {
        f32x16 mt;
#pragma unroll
        for (int i = 0; i < 16; ++i) mt[i] = 0.f;
#pragma unroll
        for (int ks = 0; ks < 8; ++ks) {
            const bf16x8 a = *(const LAS bf16x8*)(BL + (32 * st + r32) * SSTR + (16 * ks + 8 * h2) * 2);
            mt = MFMA32(a, cf[ks], mt);
        }
        unsigned pk[8];
#pragma unroll
        for (int i = 0; i < 16; i += 2) {
            const int s0 = 32 * st + crow(i, h2), s1 = s0 + 1;
            const float v0 = (l >= s0) ? mt[i] * __expf(csl - css[s0]) * dts[s0] : 0.f;
            const float v1 = (l >= s1) ? mt[i + 1] * __expf(csl - css[s1]) * dts[s1] : 0.f;
            pk[i >> 1] = pk2(v0, v1);
        }
#pragma unroll
        for (int k2 = 0; k2 < 2; ++k2) {
            v4u bw; bw.x = pk[4 * k2]; bw.y = pk[4 * k2 + 1]; bw.z = pk[4 * k2 + 2]; bw.w = pk[4 * k2 + 3];
            const bf16x8 bfrag = __builtin_bit_cast(bf16x8, bw);
            const LAS unsigned char* xp = XT + (32 * pt + r32) * SSTR + (32 * st + 16 * k2 + 4 * h2) * 2;
            const unsigned long long a_lo = *(const LAS unsigned long long*)xp, a_hi = *(const LAS unsigned long long*)(xp + 16);
            typedef unsigned long long u64x2 __attribute__((ext_vector_type(2)));
            u64x2 aw; aw.x = a_lo; aw.y = a_hi;
            acc = MFMA32(__builtin_bit_cast(bf16x8, aw), bfrag, acc);
        }
    }
    const float Dh = d_skip[h];
    const int m = m0 + l;
    float ssq = 0.f;
#pragma unroll
    for (int gq = 0; gq < 4; ++gq) {
        const int p0 = 32 * pt + 8 * gq + 4 * h2;
        const unsigned long long zz = *(const unsigned long long*)(ZB + (size_t)m * DM + h * 64 + p0);
        float y[4];
#pragma unroll
        for (int j = 0; j < 4; ++j) {
            const float xv = bf2f(*(const LAS unsigned short*)(XT + (p0 + j) * SSTR + l * 2));
            const float zv = bf2f((unsigned short)(zz >> (16 * j)));
            y[j] = (acc[4 * gq + j] + Dh * xv) * silu_f(zv);
            ssq += y[j] * y[j];
        }
        *(unsigned long long*)(MIX + (size_t)m * DMIX + 1024 + h * 64 + p0) = (unsigned long long)pk2(y[0], y[1]) | ((unsigned long long)pk2(y[2], y[3]) << 32);
    }
    ssq += __shfl_xor(ssq, 32);
    if (h2 == 0) ssp[pt * 128 + l] = ssq;
    wg_sync();
    if (tid < 128) SSQY[(size_t)(m0 + tid) * 16 + h] = ssp[tid] + ssp[128 + tid];
    wg_sync();
}

#ifdef PROBE_SSDCOARSE
#define PROBE_MASK 0xfffe
#else
#define PROBE_MASK 0xffff
#endif
__device__ __forceinline__ void ssd_sample_unit(int unit, const bf16* XBC, const float* DTR, const float* dt_bias, const float* a_log, const float* conv_w, const float* conv_b,
                                                const float* d_skip, const float* state_ssm, const float* state_conv, const bf16* ZB, bf16* MIX, float* SSQY, float* sssm,
                                                LAS unsigned char* lds, int tid_) {
    asm volatile("; MARK_ssd_sample_unit_BEGIN" ::: "memory");
    int tid = tid_; asm volatile("" : "+v"(tid));
    const int h = unit & 15, b = unit >> 4, g = h >> 3, m0 = NPR + b * 8;
    LAS float* xs = (LAS float*)lds;
    LAS float* Bs = xs + 512;
    LAS float* Cs = Bs + 1024;
    LAS float* cbd = Cs + 1024;
    LAS float* ysq = cbd + 64;
    LAS float* yo = ysq + 512;
    LAS float* dtl = yo + 512;
    LAS float* csl = dtl + 8;
    const int p = tid >> 3, nq = tid & 7;
    const GAS f32x4* hp = (const GAS f32x4*)(state_ssm + ((size_t)(b * 16 + h) * 64 + p) * 128 + nq * 16);
    GAS f32x4* ho = (GAS f32x4*)(sssm + ((size_t)(b * 16 + h) * 64 + p) * 128 + nq * 16);
    f32x4 hv[4];
#pragma unroll
    for (int j = 0; j < 4; ++j) hv[j] = hp[j];
    const unsigned short zraw = ZB[(size_t)(m0 + nq) * DM + h * 64 + p];
    if (tid >= 448 && tid < 456) {
        const int t = tid - 448;
        const float d = softplus_f(DTR[(size_t)(m0 + t) * 16 + h] + dt_bias[h]), a = -__expf(a_log[h]);
        float run = d * a;
#pragma unroll
        for (int o = 1; o < 8; o <<= 1) { const float tmp = __shfl_up(run, o); if (t >= o) run += tmp; }
        dtl[t] = d; csl[t] = run;
    }
    if (tid < 320) {
        const int cc = tid;
        const int ch = cc < 64 ? h * 64 + cc : (cc < 192 ? 1024 + g * 128 + (cc - 64) : 1280 + g * 128 + (cc - 192));
        float xv[11], w[4];
#pragma unroll
        for (int r = 0; r < 3; ++r) xv[r] = state_conv[((size_t)b * 3 + r) * CONVD + ch];
#pragma unroll
        for (int r = 3; r < 11; ++r) xv[r] = bf2f(XBC[(size_t)(m0 + r - 3) * CONVD + ch]);
#pragma unroll
        for (int k = 0; k < 4; ++k) w[k] = conv_w[k * CONVD + ch];
        const float cb = conv_b[ch];
        LAS float* dst = cc < 64 ? xs + cc : (cc < 192 ? Bs + (cc - 64) : Cs + (cc - 192));
        const int dstr = cc < 64 ? 64 : 128;
#pragma unroll
        for (int t = 0; t < 8; ++t) { float s = cb;
#pragma unroll
            for (int k = 0; k < 4; ++k) s += w[k] * xv[t + k];
            dst[t * dstr] = silu_f(s); }
    }
    wg_sync();
    {
        const int pr = tid >> 3, l = pr >> 3, s = pr & 7, part = tid & 7;
        float d = 0.f;
#pragma unroll
        for (int n = 0; n < 16; ++n) d += Cs[l * 128 + part * 16 + n] * Bs[s * 128 + part * 16 + n];
        d += __shfl_xor(d, 1); d += __shfl_xor(d, 2); d += __shfl_xor(d, 4);
        if (part == 0) cbd[l * 8 + s] = (s <= l) ? d * __expf(csl[l] - csl[s]) * dtl[s] : 0.f;
    }
#pragma unroll
    for (int l = 0; l < 8; ++l) { float s = 0.f;
#pragma unroll
        for (int j = 0; j < 4; ++j) { const LAS float* cp = Cs + l * 128 + nq * 16 + 4 * j; s += (hv[j].x * cp[0] + hv[j].y * cp[1]) + (hv[j].z * cp[2] + hv[j].w * cp[3]); }
        s += __shfl_xor(s, 1); s += __shfl_xor(s, 2); s += __shfl_xor(s, 4);
        if (nq == 0) yo[l * 64 + p] = s; }
    { const float c7 = csl[7], e7 = __expf(c7);
#pragma unroll
      for (int j = 0; j < 4; ++j) hv[j] = hv[j] * e7;
#pragma unroll
      for (int l = 0; l < 8; ++l) { const float wl = dtl[l] * __expf(c7 - csl[l]) * xs[l * 64 + p];
#pragma unroll
          for (int j = 0; j < 4; ++j) { const LAS float* bp = Bs + l * 128 + nq * 16 + 4 * j; hv[j].x += wl * bp[0]; hv[j].y += wl * bp[1]; hv[j].z += wl * bp[2]; hv[j].w += wl * bp[3]; } }
#pragma unroll
      for (int j = 0; j < 4; ++j) ho[j] = hv[j]; }
    wg_sync();
    {
        const int l = nq;
        float y = __expf(csl[l]) * yo[l * 64 + p] + d_skip[h] * xs[l * 64 + p];
#pragma unroll
        for (int s = 0; s < 8; ++s) y += cbd[l * 8 + s] * xs[s * 64 + p];
        y *= silu_f(bf2f(zraw));
        MIX[(size_t)(m0 + l) * DMIX + 1024 + h * 64 + p] = (bf16)f2bf(y);
        ysq[l * 64 + p] = y * y;
    }
    wg_sync();
    { const int l = tid >> 6; const float v = wave_sum(ysq[l * 64 + (tid & 63)]); if ((tid & 63) == 0) SSQY[(size_t)(m0 + l) * 16 + h] = v; }
    wg_sync();
}

struct PairRegs { v4u rc[4], rb[4], rx[4], rh[4]; float sv; };
__device__ __forceinline__ void pair_issue(int pu, bool full  , const unsigned char* XCV, const unsigned char* BCV, const unsigned char* CCV, const float* SCV, const bf16* STB, int tid, PairRegs& R) {
    const int hp = pu & 3, g = (pu >> 2) & 1, c = (pu >> 3) & 31, b = pu >> 8, h0 = g * 8 + 2 * hp;
    const size_t grp = (size_t)((b * 32 + c) * 2 + g), unit0 = (size_t)(b * 32 + c) * 16 + h0;
    const GAS v4u* sC = (const GAS v4u*)(CCV + grp * 32768); const GAS v4u* sB = (const GAS v4u*)(BCV + grp * 32768);
    const GAS v4u* sX = (const GAS v4u*)(XCV + unit0 * 16384); const GAS v4u* sH = (const GAS v4u*)(STB + unit0 * 8192);
#pragma unroll
    for (int j = 0; j < 4; ++j) { R.rx[j] = sX[tid + 512 * j]; R.rh[j] = sH[tid + 512 * j]; }
    if (full) {
#pragma unroll
        for (int j = 0; j < 4; ++j) { R.rc[j] = sC[tid + 512 * j]; R.rb[j] = sB[tid + 512 * j]; }
    }
    R.sv = SCV[(unit0 + (tid >> 8)) * 256 + (tid & 255)];
}
__device__ __forceinline__ void ssd_c_pair_run(int pu0, int n, const unsigned char* XCV, const unsigned char* BCV, const unsigned char* CCV, const float* SCV,
                                               const float* d_skip, const bf16* STB, const bf16* ZB, bf16* MIX, float* SSQY, LAS unsigned char* lds, int tid_, int wave, int lane_) {
    asm volatile("; MARK_ssd_c_pair_BEGIN" ::: "memory");
    int tid = tid_, lane = lane_; asm volatile("" : "+v"(tid), "+v"(lane));
    LAS unsigned char* CL = lds;
    LAS unsigned char* BL = lds + 128 * SSTR;
    LAS unsigned char* XT = lds + 256 * SSTR;
    LAS unsigned char* HL = lds + 384 * SSTR;
    LAS float* dts = (LAS float*)(lds + 512 * SSTR);
    LAS float* css = dts + 256;
    LAS float* ssp = css + 256;
    PairRegs R;
    if (n > 0) pair_issue(pu0, true, XCV, BCV, CCV, SCV, STB, tid, R);
#pragma unroll 1
    for (int k = 0; k < n; ++k) {
    const int pu = pu0 + k;
    const int hp = pu & 3, g = (pu >> 2) & 1, c = (pu >> 3) & 31, b = pu >> 8, m0 = b * SEQ + c * 128, h0 = g * 8 + 2 * hp;
    const int hsel = wave >> 2, h = h0 + hsel;
    {
#pragma unroll
        for (int j = 0; j < 4; ++j) { const int e8 = tid + 512 * j, off = (e8 >> 4) * SSTR + (e8 & 15) * 16;
            *(LAS v4u*)(XT + off) = R.rx[j]; *(LAS v4u*)(HL + off) = R.rh[j]; }
        if (k == 0 || hp == 0) {
#pragma unroll
            for (int j = 0; j < 4; ++j) { const int e8 = tid + 512 * j, off = (e8 >> 4) * SSTR + (e8 & 15) * 16;
                *(LAS v4u*)(CL + off) = R.rc[j]; *(LAS v4u*)(BL + off) = R.rb[j]; }
        }
        if ((tid & 255) < 128) dts[(tid >> 8) * 128 + (tid & 127)] = R.sv; else css[(tid >> 8) * 128 + (tid & 127)] = R.sv;
    }
    if (k + 1 < n) pair_issue(pu + 1, ((pu + 1) & 3) == 0, XCV, BCV, CCV, SCV, STB, tid, R);
    wg_sync();
    const int ls = wave & 3, r32 = lane & 31, h2 = lane >> 5;
    const int l = 32 * ls + r32;
    const LAS float* csh = css + hsel * 128; const LAS float* dth = dts + hsel * 128;
    const LAS unsigned char* XTh = XT + hsel * 64 * SSTR; const LAS unsigned char* HLh = HL + hsel * 64 * SSTR;
    const float csl = csh[l];
    bf16x8 cf[8];
#pragma unroll
    for (int ks = 0; ks < 8; ++ks) cf[ks] = *(const LAS bf16x8*)(CL + l * SSTR + (16 * ks + 8 * h2) * 2);
    f32x16 acc0, acc1;
#pragma unroll
    for (int i = 0; i < 16; ++i) { acc0[i] = 0.f; acc1[i] = 0.f; }
#pragma unroll
    for (int ks = 0; ks < 8; ++ks) {
        const bf16x8 a0 = *(const LAS bf16x8*)(HLh + r32 * SSTR + (16 * ks + 8 * h2) * 2);
        const bf16x8 a1 = *(const LAS bf16x8*)(HLh + (32 + r32) * SSTR + (16 * ks + 8 * h2) * 2);
        acc0 = MFMA32(a0, cf[ks], acc0); acc1 = MFMA32(a1, cf[ks], acc1);
    }
    { const float el = __expf(csl);
#pragma unroll
      for (int i = 0; i < 16; ++i) { acc0[i] *= el; acc1[i] *= el; } }
    for (int st = 0; st <= ls; ++st) {
        f32x16 mt;
#pragma unroll
        for (int i = 0; i < 16; ++i) mt[i] = 0.f;
#pragma unroll
        for (int ks = 0; ks < 8; ++ks) {
            const bf16x8 a = *(const LAS bf16x8*)(BL + (32 * st + r32) * SSTR + (16 * ks + 8 * h2) * 2);
            mt = MFMA32(a, cf[ks], mt);
        }
        unsigned pk[8];
#pragma unroll
        for (int i = 0; i < 16; i += 2) {
            const int s0 = 32 * st + crow(i, h2), s1 = s0 + 1;
            const float v0 = (l >= s0) ? mt[i] * __expf(csl - csh[s0]) * dth[s0] : 0.f;
            const float v1 = (l >= s1) ? mt[i + 1] * __expf(csl - csh[s1]) * dth[s1] : 0.f;
            pk[i >> 1] = pk2(v0, v1);
        }
#pragma unroll
        for (int k2 = 0; k2 < 2; ++k2) {
            v4u bw; bw.x = pk[4 * k2]; bw.y = pk[4 * k2 + 1]; bw.z = pk[4 * k2 + 2]; bw.w = pk[4 * k2 + 3];
            const bf16x8 bfrag = __builtin_bit_cast(bf16x8, bw);
            typedef unsigned long long u64x2 __attribute__((ext_vector_type(2)));
            const LAS unsigned char* xp = XTh + r32 * SSTR + (32 * st + 16 * k2 + 4 * h2) * 2;
            u64x2 aw0; aw0.x = *(const LAS unsigned long long*)xp; aw0.y = *(const LAS unsigned long long*)(xp + 16);
            u64x2 aw1; aw1.x = *(const LAS unsigned long long*)(xp + 32 * SSTR); aw1.y = *(const LAS unsigned long long*)(xp + 32 * SSTR + 16);
            acc0 = MFMA32(__builtin_bit_cast(bf16x8, aw0), bfrag, acc0);
            acc1 = MFMA32(__builtin_bit_cast(bf16x8, aw1), bfrag, acc1);
        }
    }
    const float Dh = d_skip[h];
    const int m = m0 + l;
    float ssq = 0.f;
#pragma unroll
    for (int pt = 0; pt < 2; ++pt)
#pragma unroll
        for (int gq = 0; gq < 4; ++gq) {
            const int p0 = 32 * pt + 8 * gq + 4 * h2;
            const unsigned long long zz = *(const unsigned long long*)(ZB + (size_t)m * DM + h * 64 + p0);
            float y[4];
#pragma unroll
            for (int j = 0; j < 4; ++j) {
                const float xv = bf2f(*(const LAS unsigned short*)(XTh + (p0 + j) * SSTR + l * 2));
                const float zv = bf2f((unsigned short)(zz >> (16 * j)));
                const float av = pt == 0 ? acc0[4 * gq + j] : acc1[4 * gq + j];
                y[j] = (av + Dh * xv) * silu_f(zv);
                ssq += y[j] * y[j];
            }
            *(unsigned long long*)(MIX + (size_t)m * DMIX + 1024 + h * 64 + p0) = (unsigned long long)pk2(y[0], y[1]) | ((unsigned long long)pk2(y[2], y[3]) << 32);
        }
    ssq += __shfl_xor(ssq, 32);
    if (h2 == 0) ssp[hsel * 128 + l] = ssq;
    wg_sync();
    if (tid < 256) SSQY[(size_t)(m0 + (tid & 127)) * 16 + h0 + (tid >> 7)] = ssp[tid];
    wg_sync();
    }
}

__device__ const unsigned char BKT[129] = {0, 1, 2, 3, 4, 5, 6, 7, 8, 9, 10, 11, 12, 13, 14, 15, 16, 16, 16, 17, 17, 18, 18, 18, 19, 19, 19, 20, 20, 20, 20, 21, 21, 21, 21, 22, 22, 22, 22, 22, 23, 23, 23, 23, 23, 23, 24, 24, 24, 24, 24, 24, 25, 25, 25, 25, 25, 25, 25, 26, 26, 26, 26, 26, 26, 26, 26, 27, 27, 27, 27, 27, 27, 27, 27, 27, 27, 28, 28, 28, 28, 28, 28, 28, 28, 28, 28, 29, 29, 29, 29, 29, 29, 29, 29, 29, 29, 29, 29, 30, 30, 30, 30, 30, 30, 30, 30, 30, 30, 30, 30, 30, 30, 31, 31, 31, 31, 31, 31, 31, 31, 31, 31, 31, 31, 31, 31, 31, 31};
#define PROBE_KN 1
#ifndef SPLIT_RANK
#define SPLIT_RANK 0
#endif
constexpr int KSTR = 144, VSTR = 144;
__device__ __forceinline__ int vpos(int key) { return (key & ~12) | ((key & 8) >> 1) | ((key & 4) << 1); }
constexpr int TILE_K_BYTES = 64 * KSTR, TILE_BYTES = 64 * KSTR + 64 * VSTR;
constexpr float NEG_BIG = -1.0e30f;
constexpr int LUT_STRIDE = 132;
typedef unsigned long long u64;

struct StageRegs { v4u k; u64 v0, v1; };
__device__ __forceinline__ void stage_issue_bf16(const bf16* base, long row0, int nvalid, int kvh, int tid_, StageRegs& r) {
    int tid = tid_; asm volatile("" : "+v"(tid));
    const int key = tid >> 3, ch = tid & 7, kp = tid >> 4, dq = tid & 15;
    r.k = (v4u){0u, 0u, 0u, 0u}; r.v0 = 0ull; r.v1 = 0ull;
    if (key < nvalid) r.k = *(const GAS v4u*)(base + (size_t)(row0 + key) * KVW + kvh * 128 + ch * 8);
    if (2 * kp < nvalid) r.v0 = *(const GAS u64*)(base + (size_t)(row0 + 2 * kp) * KVW + kvh * 128 + 64 + dq * 4);
    if (2 * kp + 1 < nvalid) r.v1 = *(const GAS u64*)(base + (size_t)(row0 + 2 * kp + 1) * KVW + kvh * 128 + 64 + dq * 4);
}
__device__ __forceinline__ void stage_commit(const StageRegs& r, LAS unsigned char* tb, int tid_) {
    int tid = tid_; asm volatile("" : "+v"(tid));
    const int key = tid >> 3, ch = tid & 7, kp = tid >> 4, dq = tid & 15;
    *(LAS v4u*)(tb + key * KSTR + ch * 16) = r.k;
    const unsigned a0 = (unsigned)r.v0, a1 = (unsigned)(r.v0 >> 32), b0 = (unsigned)r.v1, b1 = (unsigned)(r.v1 >> 32);
    LAS unsigned char* vt = tb + TILE_K_BYTES + (4 * dq) * VSTR + vpos(2 * kp) * 2;
    *(LAS unsigned*)(vt) = (a0 & 0xffffu) | (b0 << 16);
    *(LAS unsigned*)(vt + VSTR) = (a0 >> 16) | (b0 & 0xffff0000u);
    *(LAS unsigned*)(vt + 2 * VSTR) = (a1 & 0xffffu) | (b1 << 16);
    *(LAS unsigned*)(vt + 3 * VSTR) = (a1 >> 16) | (b1 & 0xffff0000u);
}
__device__ __forceinline__ void stage_tile_bf16(const bf16* base, long row0, int nvalid, int kvh, LAS unsigned char* tb, int tid) {
    StageRegs r; stage_issue_bf16(base, row0, nvalid, kvh, tid, r); stage_commit(r, tb, tid);
}
__device__ __forceinline__ void stage_issue_full(const bf16* base, int row0  , int kvh, int tid_, StageRegs& r) {
    int tid = tid_; asm volatile("" : "+v"(tid));
    const GAS unsigned char* ub = (const GAS unsigned char*)(base + (size_t)__builtin_amdgcn_readfirstlane(row0) * KVW + kvh * 128);
    const unsigned offk = (unsigned)(tid >> 3) * (KVW * 2) + (unsigned)(tid & 7) * 16, offv = (unsigned)(tid >> 4) * (4 * KVW) + 128 + (unsigned)(tid & 15) * 8;
    r.k = *(const GAS v4u*)(ub + offk); r.v0 = *(const GAS u64*)(ub + offv); r.v1 = *(const GAS u64*)(ub + offv + KVW * 2);
}
__device__ __forceinline__ void stage_tile_full(const bf16* base, int row0, int kvh, LAS unsigned char* tb, int tid) {
    StageRegs r; stage_issue_full(base, row0, kvh, tid, r); stage_commit(r, tb, tid);
}
struct StageOff { unsigned offk, offv, wk, wv; };
__device__ __forceinline__ StageOff stage_off(int tid) {
    StageOff o; const int key = tid >> 3, ch = tid & 7, kp = tid >> 4, dq = tid & 15;
    o.offk = (unsigned)key * (KVW * 2) + (unsigned)ch * 16; o.offv = (unsigned)kp * (4 * KVW) + 128 + (unsigned)dq * 8;
    o.wk = (unsigned)(key * KSTR + ch * 16); o.wv = (unsigned)(TILE_K_BYTES + (4 * dq) * VSTR + vpos(2 * kp) * 2);
    asm volatile("" : "+v"(o.offk), "+v"(o.offv), "+v"(o.wk), "+v"(o.wv));
    return o;
}
__device__ __forceinline__ void stage_issue_off(const bf16* base, int row0  , int kvh, const StageOff& o, StageRegs& r) {
    const GAS unsigned char* ub = (const GAS unsigned char*)(base + (size_t)__builtin_amdgcn_readfirstlane(row0) * KVW + kvh * 128);
    r.k = *(const GAS v4u*)(ub + o.offk); r.v0 = *(const GAS u64*)(ub + o.offv); r.v1 = *(const GAS u64*)(ub + o.offv + KVW * 2);
}
__device__ __forceinline__ void stage_commit_off(const StageRegs& r, LAS unsigned char* tb, const StageOff& o) {
    *(LAS v4u*)(tb + o.wk) = r.k;
    const unsigned a0 = (unsigned)r.v0, a1 = (unsigned)(r.v0 >> 32), b0 = (unsigned)r.v1, b1 = (unsigned)(r.v1 >> 32);
    LAS unsigned char* vt = tb + o.wv;
    *(LAS unsigned*)(vt) = (a0 & 0xffffu) | (b0 << 16);
    *(LAS unsigned*)(vt + VSTR) = (a0 >> 16) | (b0 & 0xffff0000u);
    *(LAS unsigned*)(vt + 2 * VSTR) = (a1 & 0xffffu) | (b1 << 16);
    *(LAS unsigned*)(vt + 3 * VSTR) = (a1 >> 16) | (b1 & 0xffff0000u);
}
__device__ __forceinline__ void stage_tile_f32(const float* base, long row0, int kvh, LAS unsigned char* tb, int tid) {
    const int key = tid >> 3, ch = tid & 7, kp = tid >> 4, dq = tid & 15;
    const GAS f32x4* kpx = (const GAS f32x4*)(base + (size_t)(row0 + key) * KVW + kvh * 128 + ch * 8);
    const f32x4 k0 = kpx[0], k1 = kpx[1];
    const f32x4 va = *(const GAS f32x4*)(base + (size_t)(row0 + 2 * kp) * KVW + kvh * 128 + 64 + dq * 4);
    const f32x4 vb = *(const GAS f32x4*)(base + (size_t)(row0 + 2 * kp + 1) * KVW + kvh * 128 + 64 + dq * 4);
    v4u o; o.x = pk2(k0.x, k0.y); o.y = pk2(k0.z, k0.w); o.z = pk2(k1.x, k1.y); o.w = pk2(k1.z, k1.w);
    *(LAS v4u*)(tb + key * KSTR + ch * 16) = o;
    LAS unsigned char* vt = tb + TILE_K_BYTES + (4 * dq) * VSTR + vpos(2 * kp) * 2;
    *(LAS unsigned*)(vt) = pk2(va.x, vb.x); *(LAS unsigned*)(vt + VSTR) = pk2(va.y, vb.y); *(LAS unsigned*)(vt + 2 * VSTR) = pk2(va.z, vb.z); *(LAS unsigned*)(vt + 3 * VSTR) = pk2(va.w, vb.w);
}


struct StageRegsF { f32x4 k0, k1, va, vb; };
__device__ __forceinline__ void stage_f32_issue(const float* base, long row0, int kvh, int tid_, StageRegsF& r) {
    int tid = tid_; asm volatile("" : "+v"(tid));
    const int key = tid >> 3, ch = tid & 7, kp = tid >> 4, dq = tid & 15;
    const GAS f32x4* kpx = (const GAS f32x4*)(base + (size_t)(row0 + key) * KVW + kvh * 128 + ch * 8);
    r.k0 = kpx[0]; r.k1 = kpx[1];
    r.va = *(const GAS f32x4*)(base + (size_t)(row0 + 2 * kp) * KVW + kvh * 128 + 64 + dq * 4);
    r.vb = *(const GAS f32x4*)(base + (size_t)(row0 + 2 * kp + 1) * KVW + kvh * 128 + 64 + dq * 4);
}
__device__ __forceinline__ void stage_f32_commit(const StageRegsF& r, LAS unsigned char* tb, int tid_) {
    int tid = tid_; asm volatile("" : "+v"(tid));
    const int key = tid >> 3, ch = tid & 7, kp = tid >> 4, dq = tid & 15;
    v4u o; o.x = pk2(r.k0.x, r.k0.y); o.y = pk2(r.k0.z, r.k0.w); o.z = pk2(r.k1.x, r.k1.y); o.w = pk2(r.k1.z, r.k1.w);
    *(LAS v4u*)(tb + key * KSTR + ch * 16) = o;
    LAS unsigned char* vt = tb + TILE_K_BYTES + (4 * dq) * VSTR + vpos(2 * kp) * 2;
    *(LAS unsigned*)(vt) = pk2(r.va.x, r.vb.x); *(LAS unsigned*)(vt + VSTR) = pk2(r.va.y, r.vb.y); *(LAS unsigned*)(vt + 2 * VSTR) = pk2(r.va.z, r.vb.z); *(LAS unsigned*)(vt + 3 * VSTR) = pk2(r.va.w, r.vb.w);
}

struct StageOffF { unsigned offk, offv, wk, wv; };
__device__ __forceinline__ StageOffF stage_off_f32(int tid) {
    StageOffF o; const int key = tid >> 3, ch = tid & 7, kp = tid >> 4, dq = tid & 15;
    o.offk = (unsigned)key * (KVW * 4) + (unsigned)ch * 32; o.offv = (unsigned)kp * (2 * KVW * 4) + 256 + (unsigned)dq * 16;
    o.wk = (unsigned)(key * KSTR + ch * 16); o.wv = (unsigned)(TILE_K_BYTES + (4 * dq) * VSTR + vpos(2 * kp) * 2);
    asm volatile("" : "+v"(o.offk), "+v"(o.offv), "+v"(o.wk), "+v"(o.wv));
    return o;
}
__device__ __forceinline__ void stage_f32_issue_off(const float* base, int row0  , int kvh, const StageOffF& o, StageRegsF& r) {
    const GAS unsigned char* ub = (const GAS unsigned char*)(base + (size_t)__builtin_amdgcn_readfirstlane(row0) * KVW + kvh * 128);
    r.k0 = *(const GAS f32x4*)(ub + o.offk); r.k1 = *(const GAS f32x4*)(ub + o.offk + 16);
    r.va = *(const GAS f32x4*)(ub + o.offv); r.vb = *(const GAS f32x4*)(ub + o.offv + KVW * 4);
}
__device__ __forceinline__ void stage_f32_commit_off(const StageRegsF& r, LAS unsigned char* tb, const StageOffF& o) {
    v4u w; w.x = pk2(r.k0.x, r.k0.y); w.y = pk2(r.k0.z, r.k0.w); w.z = pk2(r.k1.x, r.k1.y); w.w = pk2(r.k1.z, r.k1.w);
    *(LAS v4u*)(tb + o.wk) = w;
    LAS unsigned char* vt = tb + o.wv;
    *(LAS unsigned*)(vt) = pk2(r.va.x, r.vb.x); *(LAS unsigned*)(vt + VSTR) = pk2(r.va.y, r.vb.y); *(LAS unsigned*)(vt + 2 * VSTR) = pk2(r.va.z, r.vb.z); *(LAS unsigned*)(vt + 3 * VSTR) = pk2(r.va.w, r.vb.w);
}

__device__ __forceinline__ void split8(const f32x4 a, const f32x4 b, v4u& hi, v4u& lo) {
    const float x[8] = {a.x, a.y, a.z, a.w, b.x, b.y, b.z, b.w}; unsigned h[8], l[8];
#pragma unroll
    for (int i = 0; i < 8; ++i) { h[i] = f2bf(x[i]); l[i] = f2bf(x[i] - __uint_as_float(h[i] << 16)); }
    hi.x = h[0] | (h[1] << 16); hi.y = h[2] | (h[3] << 16); hi.z = h[4] | (h[5] << 16); hi.w = h[6] | (h[7] << 16);
    lo.x = l[0] | (l[1] << 16); lo.y = l[2] | (l[3] << 16); lo.z = l[4] | (l[5] << 16); lo.w = l[6] | (l[7] << 16);
}
__device__ __forceinline__ void stage_k_hilo(const float* base, long row0, int kvh, LAS unsigned char* tb, LAS unsigned char* tb_lo, int tid) {
    const int key = tid >> 3, ch = tid & 7;
    const GAS f32x4* kp = (const GAS f32x4*)(base + ((size_t)(row0 + key) * 4 + kvh) * 64 + ch * 8);
    v4u hi, lo; split8(kp[0], kp[1], hi, lo);
    *(LAS v4u*)(tb + key * KSTR + ch * 16) = hi; *(LAS v4u*)(tb_lo + key * KSTR + ch * 16) = lo;
}

template <int MODE  , bool SPLIT = false>
__device__ __forceinline__ void attn_tile(const LAS unsigned char* tb, const bf16x8 (&qf)[4], float cinit, int qpos, int kpos0, bool sel,
                                          const LAS float* lut, float& m_run, float& l_run, f32x16& o0, f32x16& o1, f32x16& p0, f32x16& p1, int lane,
                                          const LAS unsigned char* tb_lo = nullptr, const bf16x8* qlo = nullptr) {
    constexpr bool NEAR = MODE != 0;
    constexpr int KS = MODE == 3 ? 64 : 1;
    const int r32 = lane & 31, h2 = lane >> 5;
    const float c0 = NEAR ? 0.f : cinit;
#pragma unroll
    for (int i = 0; i < 16; ++i) { p0[i] = c0; p1[i] = c0; }
#pragma unroll
    for (int ks = 0; ks < 4; ++ks) {
        const bf16x8 ka = *(const LAS bf16x8*)(tb + r32 * KSTR + (16 * ks + 8 * h2) * 2);
        const bf16x8 kb = *(const LAS bf16x8*)(tb + (32 + r32) * KSTR + (16 * ks + 8 * h2) * 2);
        p0 = MFMA32(ka, qf[ks], p0); p1 = MFMA32(kb, qf[ks], p1);
        if (SPLIT) {
            const bf16x8 la = *(const LAS bf16x8*)(tb_lo + r32 * KSTR + (16 * ks + 8 * h2) * 2);
            const bf16x8 lb = *(const LAS bf16x8*)(tb_lo + (32 + r32) * KSTR + (16 * ks + 8 * h2) * 2);
            p0 = MFMA32(ka, qlo[ks], p0); p1 = MFMA32(kb, qlo[ks], p1);
            p0 = MFMA32(la, qf[ks], p0); p1 = MFMA32(lb, qf[ks], p1);
        }
    }
    if (NEAR) {
        int base = sel ? qpos - kpos0 - KS * 4 * h2 : -0x20000000;
        asm volatile("" : "+v"(base));
#pragma unroll
        for (int i = 0; i < 16; ++i) {
            const int d0 = base - KS * ((i & 3) + 8 * (i >> 2)), d1 = d0 - 32 * KS;
            const bool ok0 = MODE == 2 ? ((unsigned)d0 < 512u) : (d0 >= 0), ok1 = MODE == 2 ? ((unsigned)d1 < 512u) : (d1 >= 0);
            const float b0 = lut[min(max(d0, 0), 128)], b1 = lut[min(max(d1, 0), 128)];
            p0[i] = ok0 ? p0[i] + b0 : -INFINITY; p1[i] = ok1 ? p1[i] + b1 : -INFINITY;
        }
    }
    float mx = fmaxf(p0[0], p1[0]);
#pragma unroll
    for (int i = 1; i < 16; ++i) mx = fmaxf(mx, fmaxf(p0[i], p1[i]));
    mx = fmaxf(mx, __shfl_xor(mx, 32));
    const float m_new = fmaxf(m_run, mx), alpha = fast_exp2(m_run - m_new);
    m_run = m_new;
    float rs = 0.f;
#pragma unroll
    for (int i = 0; i < 16; ++i) { p0[i] = fast_exp2(p0[i] - m_new); p1[i] = fast_exp2(p1[i] - m_new); rs += p0[i] + p1[i]; }
    l_run = l_run * alpha + rs;
#pragma unroll
    for (int i = 0; i < 16; ++i) { o0[i] *= alpha; o1[i] *= alpha; }
#pragma unroll
    for (int kt = 0; kt < 2; ++kt)
#pragma unroll
        for (int k2 = 0; k2 < 2; ++k2) {
            v4u bw;
            if (kt == 0) { bw.x = cvtpk(p0[8 * k2], p0[8 * k2 + 1]); bw.y = cvtpk(p0[8 * k2 + 2], p0[8 * k2 + 3]); bw.z = cvtpk(p0[8 * k2 + 4], p0[8 * k2 + 5]); bw.w = cvtpk(p0[8 * k2 + 6], p0[8 * k2 + 7]); }
            else         { bw.x = cvtpk(p1[8 * k2], p1[8 * k2 + 1]); bw.y = cvtpk(p1[8 * k2 + 2], p1[8 * k2 + 3]); bw.z = cvtpk(p1[8 * k2 + 4], p1[8 * k2 + 5]); bw.w = cvtpk(p1[8 * k2 + 6], p1[8 * k2 + 7]); }
            const bf16x8 pb = __builtin_bit_cast(bf16x8, bw);
            typedef u64 u64x2 __attribute__((ext_vector_type(2)));
            const LAS unsigned char* vp = tb + TILE_K_BYTES + r32 * VSTR + (32 * kt + 16 * k2 + 8 * h2) * 2;
            const bf16x8 a0 = *(const LAS bf16x8*)vp, a1 = *(const LAS bf16x8*)(vp + 32 * VSTR);
            o0 = MFMA32(a0, pb, o0);
            o1 = MFMA32(a1, pb, o1);
        }
}

template <int MODE>
__device__ __forceinline__ void attn_tile_fixed(const LAS unsigned char* tb, const bf16x8 (&qf)[4], float cinit, int qpos, int kpos0, bool sel,
                                                const LAS float* lut, float mq, float& l_run, f32x16& o0, f32x16& o1, int lane_, unsigned loff) {
    constexpr bool NEAR = MODE != 0;
    int lane = lane_; asm volatile("" : "+v"(lane));
    const int h2 = lane >> 5;
    const LAS unsigned char* tl = tb + loff;
    const float c0 = NEAR ? -mq : cinit;
    f32x16 p0, p1;
#pragma unroll
    for (int i = 0; i < 16; ++i) { p0[i] = c0; p1[i] = c0; }
    {
        bf16x8 kf[8];
#pragma unroll
        for (int ks = 0; ks < 4; ++ks) { kf[2 * ks] = *(const LAS bf16x8*)(tl + 32 * ks); kf[2 * ks + 1] = *(const LAS bf16x8*)(tl + 32 * KSTR + 32 * ks); }
        asm volatile("s_waitcnt lgkmcnt(0)" ::: "memory");
#pragma unroll
        for (int ks = 0; ks < 4; ++ks) { p0 = MFMA32(kf[2 * ks], qf[ks], p0); p1 = MFMA32(kf[2 * ks + 1], qf[ks], p1); }
    }
    if (NEAR) {
        int base = sel ? qpos - kpos0 - 4 * h2 : -0x20000000;
        asm volatile("" : "+v"(base));
#pragma unroll
        for (int i = 0; i < 16; ++i) {
            const int d0 = base - ((i & 3) + 8 * (i >> 2)), d1 = d0 - 32;
            const bool ok0 = MODE == 2 ? ((unsigned)d0 < 512u) : (d0 >= 0), ok1 = MODE == 2 ? ((unsigned)d1 < 512u) : (d1 >= 0);
            const float b0 = lut[min(max(d0, 0), 128)], b1 = lut[min(max(d1, 0), 128)];
            p0[i] = ok0 ? p0[i] + b0 : -INFINITY; p1[i] = ok1 ? p1[i] + b1 : -INFINITY;
        }
    }
    float rs = 0.f;
#pragma unroll
    for (int i = 0; i < 16; ++i) { p0[i] = fast_exp2(p0[i]); p1[i] = fast_exp2(p1[i]); rs += p0[i] + p1[i]; }
    l_run += rs;
    {
        typedef u64 u64x2 __attribute__((ext_vector_type(2)));
        bf16x8 va[4], vb[4];
#pragma unroll
        for (int q = 0; q < 4; ++q) { const LAS unsigned char* vp = tl + TILE_K_BYTES + 32 * q;
            va[q] = *(const LAS bf16x8*)vp; vb[q] = *(const LAS bf16x8*)(vp + 32 * VSTR); }
        bf16x8 pb[4];
#pragma unroll
        for (int q = 0; q < 4; ++q) { v4u bw;
            if (q < 2) { bw.x = cvtpk(p0[8 * q], p0[8 * q + 1]); bw.y = cvtpk(p0[8 * q + 2], p0[8 * q + 3]); bw.z = cvtpk(p0[8 * q + 4], p0[8 * q + 5]); bw.w = cvtpk(p0[8 * q + 6], p0[8 * q + 7]); }
            else { const int k2 = q - 2; bw.x = cvtpk(p1[8 * k2], p1[8 * k2 + 1]); bw.y = cvtpk(p1[8 * k2 + 2], p1[8 * k2 + 3]); bw.z = cvtpk(p1[8 * k2 + 4], p1[8 * k2 + 5]); bw.w = cvtpk(p1[8 * k2 + 6], p1[8 * k2 + 7]); }
            pb[q] = __builtin_bit_cast(bf16x8, bw); }
        asm volatile("s_waitcnt lgkmcnt(0)" ::: "memory");
#pragma unroll
        for (int q = 0; q < 4; ++q) { o0 = MFMA32(va[q], pb[q], o0); o1 = MFMA32(vb[q], pb[q], o1); }
    }
}

#define APIN(x) asm volatile("" : "+v"(x))
#define ASB() __builtin_amdgcn_sched_barrier(0)
__device__ __forceinline__ void attn_far_first(const LAS unsigned char* buf, const bf16x8 (&qf)[4], f32x16& C0, f32x16& C1, float cin, unsigned loff) {
    const LAS unsigned char* kp = buf + loff;
    f32x16 Zc;
#pragma unroll
    for (int i = 0; i < 16; ++i) Zc[i] = cin;
#pragma unroll
    for (int ks = 0; ks < 4; ++ks) {
        const bf16x8 ka = *(const LAS bf16x8*)(kp + 32 * ks), kb = *(const LAS bf16x8*)(kp + 32 * KSTR + 32 * ks);
        C0 = MFMA32(ka, qf[ks], ks == 0 ? Zc : C0); C1 = MFMA32(kb, qf[ks], ks == 0 ? Zc : C1); }
#pragma unroll
    for (int i = 0; i < 16; ++i) { C0[i] = fast_exp2(C0[i]); C1[i] = fast_exp2(C1[i]); }
}
__device__ __forceinline__ void attn_far_step(const LAS unsigned char* bufK, const LAS unsigned char* bufV, const bf16x8 (&qf)[4],
                                              f32x16& C0, f32x16& C1, f32x16& P0, f32x16& P1, float cin, float& l_run, f32x16& o0, f32x16& o1, unsigned loff) {
    const LAS unsigned char* vp = bufV + TILE_K_BYTES + loff;
    const LAS unsigned char* kp = bufK + loff;
#define KFR_(i) (*(const LAS bf16x8*)(kp + 32 * ((i) >> 1) + ((i) & 1) * 32 * KSTR))
#define VFR_(i) (*(const LAS bf16x8*)(vp + 32 * ((i) >> 1) + ((i) & 1) * 32 * VSTR))
    bf16x8 k0, k1, k2, k3, k4, k5, k6, k7, v0, v1, v2, v3, v4, v5, v6, v7; v4u pw0, pw1, pw2, pw3;
    typedef u64 u64x8 __attribute__((ext_vector_type(8)));
    const u64 c2 = ((u64)__float_as_uint(cin) << 32) | (u64)__float_as_uint(cin);
    const u64x8 z8 = {c2, c2, c2, c2, c2, c2, c2, c2};
    const f32x16 Z = __builtin_bit_cast(f32x16, z8);
    ASB();
    k0 = KFR_(0); k1 = KFR_(1); k2 = KFR_(2); ASB();
    float sacc = P0[0] + P0[1];
#define GAPA_(RD, MF, a0, a1, a2, a3, WA, EA, WB, EB) do { RD; ASB(); MF; sacc += a0; sacc += a1; sacc += a2; sacc += a3; WA = EA; WB = EB; APIN(WA); APIN(WB); APIN(sacc); ASB(); } while (0)
    unsigned w00, w01, w02, w03, w10, w11, w12, w13, w20, w21, w22, w23, w30, w31, w32, w33;
    GAPA_(k3 = KFR_(3), C0 = MFMA32(k0, qf[0], Z),  P0[2], P0[3], P0[4], P0[5],     w00, cvtpk(P0[0], P0[1]),   w01, cvtpk(P0[2], P0[3]));
    GAPA_(k4 = KFR_(4), C1 = MFMA32(k1, qf[0], Z),  P0[6], P0[7], P0[8], P0[9],     w02, cvtpk(P0[4], P0[5]),   w03, cvtpk(P0[6], P0[7]));
    GAPA_(k5 = KFR_(5), C0 = MFMA32(k2, qf[1], C0), P0[10], P0[11], P0[12], P0[13], w10, cvtpk(P0[8], P0[9]),   w11, cvtpk(P0[10], P0[11]));
    GAPA_(k6 = KFR_(6), C1 = MFMA32(k3, qf[1], C1), P0[14], P0[15], P1[0], P1[1],   w12, cvtpk(P0[12], P0[13]), w13, cvtpk(P0[14], P0[15]));
    GAPA_(k7 = KFR_(7), C0 = MFMA32(k4, qf[2], C0), P1[2], P1[3], P1[4], P1[5],     w20, cvtpk(P1[0], P1[1]),   w21, cvtpk(P1[2], P1[3]));
    GAPA_(v0 = VFR_(0), C1 = MFMA32(k5, qf[2], C1), P1[6], P1[7], P1[8], P1[9],     w22, cvtpk(P1[4], P1[5]),   w23, cvtpk(P1[6], P1[7]));
    GAPA_(v1 = VFR_(1), C0 = MFMA32(k6, qf[3], C0), P1[10], P1[11], P1[12], P1[13], w30, cvtpk(P1[8], P1[9]),   w31, cvtpk(P1[10], P1[11]));
    GAPA_(v2 = VFR_(2), C1 = MFMA32(k7, qf[3], C1), P1[14], P1[15], 0.f, 0.f,       w32, cvtpk(P1[12], P1[13]), w33, cvtpk(P1[14], P1[15]));
    l_run += sacc;
    pw0 = (v4u){w00, w01, w02, w03}; pw1 = (v4u){w10, w11, w12, w13}; pw2 = (v4u){w20, w21, w22, w23}; pw3 = (v4u){w30, w31, w32, w33};
    const bf16x8 pb0 = __builtin_bit_cast(bf16x8, pw0), pb1 = __builtin_bit_cast(bf16x8, pw1), pb2 = __builtin_bit_cast(bf16x8, pw2), pb3 = __builtin_bit_cast(bf16x8, pw3);
#define EX_(v) fast_exp2(v)
#define GAPB_(RD, MF, X, i) do { RD; ASB(); MF; X[i] = EX_(X[i]); X[i + 1] = EX_(X[i + 1]); X[i + 2] = EX_(X[i + 2]); X[i + 3] = EX_(X[i + 3]); APIN(X); ASB(); } while (0)
    GAPB_(v3 = VFR_(3), o0 = MFMA32(v0, pb0, o0), C0, 0);
    GAPB_(v4 = VFR_(4), o1 = MFMA32(v1, pb0, o1), C0, 4);
    GAPB_(v5 = VFR_(5), o0 = MFMA32(v2, pb1, o0), C0, 8);
    GAPB_(v6 = VFR_(6), o1 = MFMA32(v3, pb1, o1), C0, 12);
    GAPB_(v7 = VFR_(7), o0 = MFMA32(v4, pb2, o0), C1, 0);
    GAPB_((void)0,      o1 = MFMA32(v5, pb2, o1), C1, 4);
    GAPB_((void)0,      o0 = MFMA32(v6, pb3, o0), C1, 8);
    GAPB_((void)0,      o1 = MFMA32(v7, pb3, o1), C1, 12);
#undef KFR_
#undef VFR_
#undef GAPA_
#undef EX_
#undef GAPB_
}
__device__ __forceinline__ void attn_far_drain(const LAS unsigned char* bufV, const f32x16& P0, const f32x16& P1, float& l_run, f32x16& o0, f32x16& o1, unsigned loff) {
    const LAS unsigned char* vp = bufV + TILE_K_BYTES + loff;
    float sacc = 0.f;
#pragma unroll
    for (int i = 0; i < 16; ++i) sacc += P0[i] + P1[i];
    l_run += sacc;
#pragma unroll
    for (int q = 0; q < 4; ++q) {
        const bf16x8 va = *(const LAS bf16x8*)(vp + 32 * q), vb = *(const LAS bf16x8*)(vp + 32 * VSTR + 32 * q);
        v4u bw;
        if (q < 2) { bw.x = cvtpk(P0[8 * q], P0[8 * q + 1]); bw.y = cvtpk(P0[8 * q + 2], P0[8 * q + 3]); bw.z = cvtpk(P0[8 * q + 4], P0[8 * q + 5]); bw.w = cvtpk(P0[8 * q + 6], P0[8 * q + 7]); }
        else { const int k2 = q - 2; bw.x = cvtpk(P1[8 * k2], P1[8 * k2 + 1]); bw.y = cvtpk(P1[8 * k2 + 2], P1[8 * k2 + 3]); bw.z = cvtpk(P1[8 * k2 + 4], P1[8 * k2 + 5]); bw.w = cvtpk(P1[8 * k2 + 6], P1[8 * k2 + 7]); }
        const bf16x8 pb = __builtin_bit_cast(bf16x8, bw);
        o0 = MFMA32(va, pb, o0); o1 = MFMA32(vb, pb, o1);
    }
}

template <bool F32SRC, int NRT>
__device__ __forceinline__ void compress_unit(const void* src, const int* pt, long token0, int blk0, const bf16* WCF, const bf16* WCFL, const float* PEB, bf16* dst  ,
                                              float* dst32  , LAS unsigned char* lds, int tid_, int wave, int lane_) {
    asm volatile("; MARK_compress_unit_BEGIN" ::: "memory");
    int tid = tid_, lane = lane_; asm volatile("" : "+v"(tid), "+v"(lane));
    const int r32 = lane & 31, h2 = lane >> 5;
    LAS float* red = (LAS float*)lds;
    LAS float* pebs = (LAS float*)(lds + 98304);
    if (tid < 128) { float sp = 0.f;
#pragma unroll
        for (int k = 0; k < 16; ++k) sp += PEB[k * 128 + tid];
        pebs[tid] = sp; }
    for (int c = 0; c < 2; ++c) {
        f32x16 acc[NRT][2];
#pragma unroll
        for (int a = 0; a < NRT; ++a)
#pragma unroll
            for (int e = 0; e < 2; ++e)
#pragma unroll
                for (int i = 0; i < 16; ++i) acc[a][e][i] = 0.f;
#pragma unroll 4
        for (int li = 0; li < 8; ++li) {
            const int lp = 8 * wave + li;
#pragma unroll
            for (int rt = 0; rt < NRT; ++rt) {
                const int nl = 8 * rt + (r32 >> 2), kvh = r32 & 3, blk = blk0 + nl;
                bf16x8 af[4], al[4];
                if (F32SRC) {
                    const int page = pt[blk >> 1];
                    const GAS f32x4* p = (const GAS f32x4*)((const float*)src + (((size_t)page * 128 + (blk & 1) * 64 + lp) * 4 + kvh) * 128 + c * 64 + 16 * h2);
#pragma unroll
                    for (int uu = 0; uu < 2; ++uu) { const f32x4 x0 = p[8 * uu], x1 = p[8 * uu + 1], x2 = p[8 * uu + 2], x3 = p[8 * uu + 3];
                        v4u w0, w1, l0, l1; split8(x0, x1, w0, l0); split8(x2, x3, w1, l1);
                        af[2 * uu] = __builtin_bit_cast(bf16x8, w0); af[2 * uu + 1] = __builtin_bit_cast(bf16x8, w1);
                        al[2 * uu] = __builtin_bit_cast(bf16x8, l0); al[2 * uu + 1] = __builtin_bit_cast(bf16x8, l1); }
                } else {
                    const GAS v4u* p = (const GAS v4u*)((const bf16*)src + ((size_t)(token0 + (size_t)blk * 64 + lp) * 4 + kvh) * 128 + c * 64 + 16 * h2);
#pragma unroll
                    for (int uu = 0; uu < 2; ++uu) { af[2 * uu] = __builtin_bit_cast(bf16x8, p[4 * uu]); af[2 * uu + 1] = __builtin_bit_cast(bf16x8, p[4 * uu + 1]); }
                }
#pragma unroll
                for (int kk = 0; kk < 4; ++kk) {
                    const int ks = lp * 4 + kk;
                    const GAS v4u* wp = (const GAS v4u*)(WCF + ((((size_t)c * 256 + ks) * 2) * 64 + lane) * 8);
                    const bf16x8 w0 = __builtin_bit_cast(bf16x8, wp[0]), w1 = __builtin_bit_cast(bf16x8, wp[64]);
                    acc[rt][0] = MFMA32(af[kk], w0, acc[rt][0]); acc[rt][1] = MFMA32(af[kk], w1, acc[rt][1]);
                    if (SPLIT_RANK && F32SRC && c == 0) {
                        const GAS v4u* wl = (const GAS v4u*)(WCFL + (((size_t)ks * 2) * 64 + lane) * 8);
                        const bf16x8 v0 = __builtin_bit_cast(bf16x8, wl[0]), v1 = __builtin_bit_cast(bf16x8, wl[64]);
                        acc[rt][0] = MFMA32(af[kk], v0, acc[rt][0]); acc[rt][1] = MFMA32(af[kk], v1, acc[rt][1]);
                        acc[rt][0] = MFMA32(al[kk], w0, acc[rt][0]); acc[rt][1] = MFMA32(al[kk], w1, acc[rt][1]);
                    }
                }
            }
        }
        wg_sync();
        LAS float* my = red + (wave & 3) * (NRT * 2048);
        if (wave < 4) {
#pragma unroll
            for (int rt = 0; rt < NRT; ++rt)
#pragma unroll
                for (int e = 0; e < 2; ++e)
#pragma unroll
                    for (int i = 0; i < 16; ++i) my[(32 * rt + crow(i, h2)) * 64 + 32 * e + r32] = acc[rt][e][i];
        }
        wg_sync();
        if (wave >= 4) {
#pragma unroll
            for (int rt = 0; rt < NRT; ++rt)
#pragma unroll
                for (int e = 0; e < 2; ++e)
#pragma unroll
                    for (int i = 0; i < 16; ++i) my[(32 * rt + crow(i, h2)) * 64 + 32 * e + r32] += acc[rt][e][i];
        }
        wg_sync();
        for (int idx = tid; idx < NRT * 2048; idx += NWAVES * 64) {
            const int row = idx >> 6, e = idx & 63, nl = row >> 2, kvh = row & 3;
            const float v = (red[idx] + red[NRT * 2048 + idx]) + (red[2 * NRT * 2048 + idx] + red[3 * NRT * 2048 + idx]) + pebs[c * 64 + e];
            dst[(((size_t)nl * 4 + kvh) * 2 + c) * 64 + e] = (bf16)f2bf(v);
            if (SPLIT_RANK && F32SRC && c == 0) dst32[((size_t)nl * 4 + kvh) * 64 + e] = v;
        }
    }
    wg_sync();
}

template <bool BF>
__device__ __forceinline__ void compress_sample_unit(const void* src_, const int* pt, int blk0, const bf16* WCF, const float* PEB, bf16* dst  ,
                                                     LAS unsigned char* lds, int tid_, int wave, int lane_) {
    const float* src = (const float*)src_;
    asm volatile("; MARK_compress_sample_BEGIN" ::: "memory");
    int tid = tid_, lane = lane_; asm volatile("" : "+v"(tid), "+v"(lane));
    constexpr int RSTR = 272;
    const int r32 = lane & 31, h2 = lane >> 5;
    LAS unsigned char* my = lds + wave * (32 * RSTR);
    LAS float* red = (LAS float*)lds;
    LAS float* pebs = (LAS float*)(lds + 98304);
    if (tid < 128) { float sp = 0.f;
#pragma unroll
        for (int k = 0; k < 16; ++k) sp += PEB[k * 128 + tid];
        pebs[tid] = sp; }
    int pg0 = 0, pg1 = 0, pg2 = 0, pg3 = 0;
    if (!BF) { pg0 = pt[(blk0 >> 1)]; pg1 = pt[(blk0 >> 1) + 1]; pg2 = pt[(blk0 >> 1) + 2]; pg3 = pt[(blk0 >> 1) + 3]; }
    const bf16* sb = (const bf16*)src_ + (size_t)blk0 * (64 * 512) + lane * 8;
    const float* rb0 = src + (size_t)pg0 * (128 * 512) + lane * 4; const float* rb1 = src + (size_t)pg1 * (128 * 512) + lane * 4;
    const float* rb2 = src + (size_t)pg2 * (128 * 512) + lane * 4; const float* rb3 = src + (size_t)pg3 * (128 * 512) + lane * 4;
    f32x16 acc00, acc01, acc10, acc11;
#pragma unroll
    for (int i = 0; i < 16; ++i) { acc00[i] = 0.f; acc01[i] = 0.f; acc10[i] = 0.f; acc11[i] = 0.f; }
    f32x4 st[16];
#define CS_ISSUE(lp) do { if (BF) { _Pragma("unroll") for (int q = 0; q < 8; ++q) st[q] = __builtin_bit_cast(f32x4, *(const GAS v4u*)(sb + (size_t)(q * 64 + (lp)) * 512)); } \
    else { _Pragma("unroll") for (int q = 0; q < 16; ++q) { const int bl = q >> 1; const float* rb = (bl >> 1) == 0 ? rb0 : ((bl >> 1) == 1 ? rb1 : ((bl >> 1) == 2 ? rb2 : rb3)); \
        st[q] = *(const GAS f32x4*)(rb + (size_t)((bl & 1) * 64 + (lp)) * 512 + (q & 1) * 256); } } } while (0)
    CS_ISSUE(8 * wave);
#pragma unroll 1
    for (int i = 0; i < 8; ++i) {
        const int lp = 8 * wave + i;
        v4u wf[16];
#pragma unroll
        for (int c = 0; c < 2; ++c)
#pragma unroll
            for (int kk = 0; kk < 4; ++kk) { const GAS v4u* wp = (const GAS v4u*)(WCF + ((((size_t)c * 256 + lp * 4 + kk) * 2) * 64 + lane) * 8);
                wf[(c * 4 + kk) * 2] = wp[0]; wf[(c * 4 + kk) * 2 + 1] = wp[64]; }
        if (BF) {
#pragma unroll
            for (int q = 0; q < 8; ++q) *(LAS v4u*)(my + (q * 4 + (lane >> 4)) * RSTR + (lane & 15) * 16) = __builtin_bit_cast(v4u, st[q]);
        } else
#pragma unroll
        for (int q = 0; q < 16; ++q) {
            const f32x4 x = st[q];
            typedef unsigned u32x2 __attribute__((ext_vector_type(2)));
            u32x2 o; o.x = cvtpk(x.x, x.y); o.y = cvtpk(x.z, x.w);
            *(LAS u32x2*)(my + ((q >> 1) * 4 + (q & 1) * 2 + h2) * RSTR + r32 * 8) = o;
        }
        if (i < 7) CS_ISSUE(lp + 1);
#pragma unroll
        for (int kk = 0; kk < 4; ++kk) {
            const LAS unsigned char* ap = my + r32 * RSTR + (32 * (kk >> 1) + 16 * h2 + 8 * (kk & 1)) * 2;
            const bf16x8 a0 = *(const LAS bf16x8*)ap, a1 = *(const LAS bf16x8*)(ap + 128);
            acc00 = MFMA32(a0, __builtin_bit_cast(bf16x8, wf[kk * 2]), acc00); acc01 = MFMA32(a0, __builtin_bit_cast(bf16x8, wf[kk * 2 + 1]), acc01);
            acc10 = MFMA32(a1, __builtin_bit_cast(bf16x8, wf[(4 + kk) * 2]), acc10); acc11 = MFMA32(a1, __builtin_bit_cast(bf16x8, wf[(4 + kk) * 2 + 1]), acc11);
        }
    }
#undef CS_ISSUE
#pragma unroll
    for (int c = 0; c < 2; ++c) {
        wg_sync();
        LAS float* mys = red + (wave & 3) * 2048;
        if (wave < 4) {
#pragma unroll
            for (int i = 0; i < 16; ++i) { mys[crow(i, h2) * 64 + r32] = c == 0 ? acc00[i] : acc10[i]; mys[crow(i, h2) * 64 + 32 + r32] = c == 0 ? acc01[i] : acc11[i]; }
        }
        wg_sync();
        if (wave >= 4) {
#pragma unroll
            for (int i = 0; i < 16; ++i) { mys[crow(i, h2) * 64 + r32] += c == 0 ? acc00[i] : acc10[i]; mys[crow(i, h2) * 64 + 32 + r32] += c == 0 ? acc01[i] : acc11[i]; }
        }
        wg_sync();
        for (int idx = tid; idx < 2048; idx += NWAVES * 64) {
            const int row = idx >> 6, e = idx & 63, nl = row >> 2, kvh = row & 3;
            const float v = (red[idx] + red[2048 + idx]) + (red[2 * 2048 + idx] + red[3 * 2048 + idx]) + pebs[c * 64 + e];
            dst[(((size_t)nl * 4 + kvh) * 2 + c) * 64 + e] = (bf16)f2bf(v);
        }
    }
    wg_sync();
}

constexpr int AP_TB0 = 0, AP_TB1 = TILE_BYTES, AP_IMP = 4 * TILE_BYTES, AP_LUT = AP_IMP + 4 * 64 * 64 * 4, AP_SEL = AP_LUT + 4 * LUT_STRIDE * 4, AP_TL = AP_SEL + 64 * 8, AP_CT = AP_TL + 96 * 4, AP_END = AP_CT + TILE_BYTES;
static_assert(AP_END <= MISC_OFF, "prompt attention LDS map");
__device__ __forceinline__ void attn_prompt_unit(bool fresh  , int b, int kvh, int qb, const bf16* QB, const bf16* KCP, const bf16* SKV, const bf16* WKV, const float* GATES, const float* rel_table,
                                                 const float* KMP, bf16* MIX, float* SSQA, LAS unsigned char* lds, int tid_, int wave, int lane_) {
    asm volatile("; MARK_attn_prompt_unit_BEGIN" ::: "memory");
    int tid = tid_, lane = lane_; asm volatile("" : "+v"(tid), "+v"(lane));
    const int g = wave >> 1, th = wave & 1, r32 = lane & 31, h2 = lane >> 5;
    const int tl = 32 * th + r32, t = 64 * qb + tl, m = b * SEQ + t, hh = kvh * 4 + g;
    LAS unsigned char* TB0 = lds + AP_TB0; LAS unsigned char* TB1 = lds + AP_TB1;
    LAS float* IMP = (LAS float*)(lds + AP_IMP); LAS float* LUT = (LAS float*)(lds + AP_LUT); LAS u64* SEL = (LAS u64*)(lds + AP_SEL); LAS int* TL = (LAS int*)(lds + AP_TL);
    bf16x8 qf[4];
#pragma unroll
    for (int ks = 0; ks < 4; ++ks) qf[ks] = __builtin_bit_cast(bf16x8, *(const GAS v4u*)(QB + (size_t)m * DM + hh * 64 + 16 * ks + 8 * h2));
    if (fresh) for (int idx = tid; idx < 4 * 129; idx += NWAVES * 64) { const int gg = idx / 129, d = idx % 129; LUT[gg * LUT_STRIDE + d] = rel_table[BKT[d] * 16 + kvh * 4 + gg] * LOG2E; }
    const float gate_c = sigmoid_f(GATES[(size_t)m * 48 + hh * 3 + 0]), gate_s = sigmoid_f(GATES[(size_t)m * 48 + hh * 3 + 1]), gate_w = sigmoid_f(GATES[(size_t)m * 48 + hh * 3 + 2]);
    const float bias_far = rel_table[31 * 16 + hh] * LOG2E;
    const LAS float* lut = LUT + g * LUT_STRIDE;
    if (fresh) stage_tile_bf16(KCP, (long)b * 64, 64, kvh, lds + AP_CT, tid);
    wg_sync();
    float mq_s, mq_w;
    {
        float qq = 0.f;
#pragma unroll
        for (int ks = 0; ks < 4; ++ks)
#pragma unroll
            for (int e = 0; e < 8; ++e) { const float x = bf2f((unsigned short)qf[ks][e]); qq += x * x; }
        qq += __shfl_xor(qq, 32);
        float lmx = fmaxf(fmaxf(lut[lane], lut[64 + lane]), lut[128]);
#pragma unroll
        for (int o = 1; o < 64; o <<= 1) lmx = fmaxf(lmx, __shfl_xor(lmx, o));
        const float qn = sqrtf(qq) * 1.002f;
        LAS float* kred = (LAS float*)(lds + AP_TL + 70 * 4);
        if (fresh) {
            float ks_ = KMP[((size_t)b * 256 + (tid & 255)) * 4 + kvh], kw_ = KMP[((size_t)(NPR / 16) + b * 256 + (tid & 255)) * 4 + kvh];
#pragma unroll
            for (int o = 1; o < 64; o <<= 1) { ks_ = fmaxf(ks_, __shfl_xor(ks_, o)); kw_ = fmaxf(kw_, __shfl_xor(kw_, o)); }
            if (lane == 0) { kred[wave] = ks_; kred[8 + wave] = kw_; }
        }
        wg_sync();
        float kms = kred[0], kmw = kred[8];
#pragma unroll
        for (int w = 1; w < 8; ++w) { kms = fmaxf(kms, kred[w]); kmw = fmaxf(kmw, kred[8 + w]); }
        mq_s = qn * sqrtf(kms) + lmx;
        mq_w = qn * sqrtf(kmw) + lmx;
#ifdef PROBE_CONSTMQ
        mq_s = 30.f; mq_w = 30.f;
#endif
    }
    f32x16 ot0, ot1, o0, o1, p0, p1;
    float m_run = NEG_BIG, l_run = 0.f;
#pragma unroll
    for (int i = 0; i < 16; ++i) { o0[i] = 0.f; o1[i] = 0.f; }
    attn_tile<3>(lds + AP_CT, qf, 0.f, t, 63, true, lut, m_run, l_run, o0, o1, p0, p1, lane);
    {
        const float lt = l_run + __shfl_xor(l_run, 32), inv = lt > 0.f ? 1.0f / lt : 0.f, sc = gate_c * inv;
#pragma unroll
        for (int i = 0; i < 16; ++i) { ot0[i] = o0[i] * sc; ot1[i] = o1[i] * sc; }
        LAS float* slab = IMP + (g * 64 + tl) * 64;
#pragma unroll
        for (int i = 0; i < 16; ++i) { slab[crow(i, h2)] = p0[i] * inv; slab[32 + crow(i, h2)] = p1[i] * inv; }
    }
    wg_sync();
    if (qb < 16) { if (tid < 64) SEL[tid] = (2ull << qb) - 1ull; }
    else {
        for (int i = 0; i < 8; ++i) {
            const int tk = 8 * wave + i;
            const bool cand = (lane >= 1 && lane <= qb - 2);
            const float v = cand ? (IMP[(0 * 64 + tk) * 64 + lane] + IMP[(1 * 64 + tk) * 64 + lane]) + (IMP[(2 * 64 + tk) * 64 + lane] + IMP[(3 * 64 + tk) * 64 + lane]) : -1.f;
            const u64 key = cand ? ((((u64)__float_as_uint(v)) << 6) | (u64)(unsigned)(63 - lane)) : 0ull;
            u64 T13 = 0ull;
#pragma unroll
            for (int bp = 36; bp >= 0; --bp) { const u64 trial = T13 | (1ull << bp); const u64 bm = __ballot(key >= trial); const int cnt = __builtin_popcount((unsigned)bm) + __builtin_popcount((unsigned)(bm >> 32)); T13 = cnt >= 13 ? trial : T13; }
            const bool selected = (lane == 0 || lane == qb || lane == qb - 1) || (cand && key >= T13);
            const u64 mask = __ballot(selected);
            if (lane == 0) SEL[tk] = mask;
        }
    }
    wg_sync();
    if (wave == 0) {
        const u64 mine = SEL[lane]; unsigned lo = (unsigned)mine, hi = (unsigned)(mine >> 32);
#pragma unroll
        for (int o = 1; o < 64; o <<= 1) { lo |= __shfl_xor(lo, o); hi |= __shfl_xor(hi, o); }
        const u64 any = ((u64)hi << 32) | lo;
        const bool on = ((any >> lane) & 1ull) && lane <= qb;
        const u64 bal = __ballot(on);
        if (on) TL[1 + __popcll(bal & ((1ull << lane) - 1ull))] = lane;
        if (lane == 0) { TL[0] = __popcll(bal); TL[68] = qb >= 3 ? __popcll(bal & ((1ull << (qb - 2)) - 1ull)) : 0; }
    }
    wg_sync();
    const u64 mysel = SEL[tl];
    if (wave >= 4) __builtin_amdgcn_s_setprio(1);
    unsigned loff = (unsigned)((lane & 31) * KSTR + (lane >> 5) * 16); APIN(loff);
    LAS float* park = IMP + tid;
#pragma unroll
    for (int i = 0; i < 16; ++i) { park[i * 512] = ot0[i]; park[(16 + i) * 512] = ot1[i]; }
    const int ntl = TL[0];
    m_run = NEG_BIG; l_run = 0.f;
#pragma unroll
    for (int i = 0; i < 16; ++i) { o0[i] = 0.f; o1[i] = 0.f; }
    {
        StageRegs s1;
        const StageOff so = stage_off(tid);
        int it0 = 0;
        const int nfar = TL[68];
#define FB_(k) (lds + AP_TB0 + ((k) & 3) * TILE_BYTES)
#define SROW_(i) (b * SEQ + 64 * TL[1 + (i)])
#define FCIN_(i) ((((mysel >> TL[1 + (i)]) & 1ull) != 0ull) ? bias_far - mq_s : -INFINITY)
        if (nfar >= 4) {
            stage_tile_full(SKV, SROW_(0), kvh, FB_(0), tid); stage_tile_full(SKV, SROW_(1), kvh, FB_(1), tid); stage_tile_full(SKV, SROW_(2), kvh, FB_(2), tid);
            wg_sync();
            f32x16 A0, A1, B0, B1;
            attn_far_first(FB_(0), qf, A0, A1, FCIN_(0), loff);
            int tt = 1;
            for (; tt + 1 < nfar; tt += 2) {
                if (tt + 2 < nfar) stage_issue_off(SKV, SROW_(tt + 2), kvh, so, s1);
                attn_far_step(FB_(tt), FB_(tt - 1), qf, B0, B1, A0, A1, FCIN_(tt), l_run, o0, o1, loff);
                if (tt + 2 < nfar) stage_commit_off(s1, FB_(tt + 2), so);
                wg_sync();
                if (tt + 3 < nfar) stage_issue_off(SKV, SROW_(tt + 3), kvh, so, s1);
                attn_far_step(FB_(tt + 1), FB_(tt), qf, A0, A1, B0, B1, FCIN_(tt + 1), l_run, o0, o1, loff);
                if (tt + 3 < nfar) stage_commit_off(s1, FB_(tt + 3), so);
                wg_sync();
            }
            if (tt < nfar) {
                attn_far_step(FB_(tt), FB_(tt - 1), qf, B0, B1, A0, A1, FCIN_(tt), l_run, o0, o1, loff);
                attn_far_drain(FB_(tt), B0, B1, l_run, o0, o1, loff);
            } else attn_far_drain(FB_(nfar - 1), A0, A1, l_run, o0, o1, loff);
            wg_sync();
            it0 = nfar;
        }
#undef FB_
#undef SROW_
#undef FCIN_
        if (it0 < ntl) {
            stage_tile_full(SKV, b * SEQ + 64 * TL[1 + it0], kvh, TB0, tid);
            wg_sync();
            for (int it = it0; it < ntl; ++it) {
                const int j = TL[1 + it];
                LAS unsigned char* cur = ((it - it0) & 1) ? TB1 : TB0; LAS unsigned char* nxt = ((it - it0) & 1) ? TB0 : TB1;
                if (it + 1 < ntl) stage_issue_off(SKV, b * SEQ + 64 * TL[2 + it], kvh, so, s1);
                const bool sel = (mysel >> j) & 1ull;
                if (j <= qb - 3) attn_tile_fixed<0>(cur, qf, sel ? bias_far - mq_s : -INFINITY, 0, 0, true, lut, mq_s, l_run, o0, o1, lane, loff);
                else attn_tile_fixed<1>(cur, qf, 0.f, t, 64 * j, sel, lut, mq_s, l_run, o0, o1, lane, loff);
                if (it + 1 < ntl) stage_commit_off(s1, nxt, so);
                wg_sync();
            }
        }
        const float lt = l_run + __shfl_xor(l_run, 32), sc = gate_s / lt;
#pragma unroll
        for (int i = 0; i < 16; ++i) { park[i * 512] += o0[i] * sc; park[(16 + i) * 512] += o1[i] * sc; }
    }
    m_run = NEG_BIG; l_run = 0.f;
#pragma unroll
    for (int i = 0; i < 16; ++i) { o0[i] = 0.f; o1[i] = 0.f; }
    {
        StageRegs s1;
        const StageOff so = stage_off(tid);
        const int j0 = qb >= 8 ? qb - 8 : 0, nw = qb - j0 + 1;
        stage_tile_full(WKV, b * SEQ + 64 * j0, kvh, TB0, tid);
        wg_sync();
        for (int it = 0; it < nw; ++it) {
            const int j = j0 + it;
            LAS unsigned char* cur = (it & 1) ? TB1 : TB0; LAS unsigned char* nxt = (it & 1) ? TB0 : TB1;
            if (it + 1 < nw) stage_issue_off(WKV, b * SEQ + 64 * (j + 1), kvh, so, s1);
            if (j >= qb - 7 && j <= qb - 3) attn_tile_fixed<0>(cur, qf, bias_far - mq_w, 0, 0, true, lut, mq_w, l_run, o0, o1, lane, loff);
            else attn_tile_fixed<2>(cur, qf, 0.f, t, 64 * j, true, lut, mq_w, l_run, o0, o1, lane, loff);
            if (it + 1 < nw) stage_commit_off(s1, nxt, so);
            wg_sync();
        }
        const float lt = l_run + __shfl_xor(l_run, 32), sc = gate_w / lt;
#pragma unroll
        for (int i = 0; i < 16; ++i) { ot0[i] = park[i * 512] + o0[i] * sc; ot1[i] = park[(16 + i) * 512] + o1[i] * sc; }
    }
    __builtin_amdgcn_s_setprio(0);
    float ssq = 0.f;
#pragma unroll
    for (int i = 0; i < 16; ++i) ssq += ot0[i] * ot0[i] + ot1[i] * ot1[i];
    ssq += __shfl_xor(ssq, 32);
    if (h2 == 0) SSQA[(size_t)m * 16 + hh] = ssq;
    bf16* op = MIX + (size_t)m * DMIX + hh * 64 + 4 * h2;
#pragma unroll
    for (int gq = 0; gq < 4; ++gq) {
        *(u64*)(op + 8 * gq) = (u64)pk2(ot0[4 * gq], ot0[4 * gq + 1]) | ((u64)pk2(ot0[4 * gq + 2], ot0[4 * gq + 3]) << 32);
        *(u64*)(op + 32 + 8 * gq) = (u64)pk2(ot1[4 * gq], ot1[4 * gq + 1]) | ((u64)pk2(ot1[4 * gq + 2], ot1[4 * gq + 3]) << 32);
    }
    wg_sync();
}

constexpr int AS_TB = 0, AS_MOC = 4 * TILE_BYTES, AS_SIMP = AS_MOC + 16384, AS_MO = 65536, AS_LUT = 8 * TILE_BYTES, AS_SG = AS_LUT + 4 * LUT_STRIDE * 4, AS_SEL = AS_SG + 32 * 4 * 4, AS_TL = AS_SEL + 8 * 16,
              AS_OT = AS_TL + 132 * 4, AS_ML = AS_OT + 32 * 64 * 4, AS_PT = AS_ML + 8 * 32 * 8, AS_END = AS_PT + 64 * 4;
static_assert(AS_END <= MISC_OFF && AS_SIMP + 32 * 128 * 4 <= AS_LUT && AS_MO + 65536 <= AS_LUT, "sample attention LDS map");
__device__ __forceinline__ void as_write_state(LAS unsigned char* lds, int mo_off, int wave, int lane, float m_run, float l_run, const f32x16& o0, const f32x16& o1) {
    const int r32 = lane & 31, h2 = lane >> 5;
    const float lt = l_run + __shfl_xor(l_run, 32);
    LAS float* mo = (LAS float*)(lds + mo_off) + (wave * 32 + r32) * 64 + 4 * h2;
#pragma unroll
    for (int gq = 0; gq < 4; ++gq) {
        *(LAS f32x4*)(mo + 8 * gq) = (f32x4){o0[4 * gq], o0[4 * gq + 1], o0[4 * gq + 2], o0[4 * gq + 3]};
        *(LAS f32x4*)(mo + 32 + 8 * gq) = (f32x4){o1[4 * gq], o1[4 * gq + 1], o1[4 * gq + 2], o1[4 * gq + 3]};
    }
    if (h2 == 0) { LAS float* ml = (LAS float*)(lds + AS_ML) + (wave * 32 + r32) * 2; ml[0] = m_run; ml[1] = lt; }
}
template <int NW> __device__ __forceinline__ void as_merge(LAS unsigned char* lds, int mo_off, int br, int tid) {
    const int q = tid >> 4, d = (tid & 15) * 4;
    const LAS float* ml = (const LAS float*)(lds + AS_ML); const LAS float* mo = (const LAS float*)(lds + mo_off);
    float M = NEG_BIG;
#pragma unroll
    for (int w = 0; w < NW; ++w) M = fmaxf(M, ml[(w * 32 + q) * 2]);
    float L = 0.f; f32x4 acc = (f32x4){0.f, 0.f, 0.f, 0.f};
#pragma unroll
    for (int w = 0; w < NW; ++w) { const float f = fast_exp2(ml[(w * 32 + q) * 2] - M); L += ml[(w * 32 + q) * 2 + 1] * f; acc += *(const LAS f32x4*)(mo + (w * 32 + q) * 64 + d) * f; }
    const float sc = ((const LAS float*)(lds + AS_SG))[q * 4 + br] / L;
    LAS f32x4* ot = (LAS f32x4*)((LAS float*)(lds + AS_OT) + q * 64 + d);
    *ot = *ot + acc * sc;
}
__device__ __forceinline__ void attn_sample_unit(int b, int kvh, const bf16* QB, const float* QS32, const bf16* KCS, const float* KCS32, const bf16* SKV, const bf16* WKV, const float* cache_slc, const float* cache_win,
                                                 const int* page_table, const float* GATES, const float* rel_table, bf16* MIX, float* SSQA, const float* OUTP, LAS unsigned char* lds, int tid_, int wave, int lane_) {
    asm volatile("; MARK_attn_sample_unit_BEGIN" ::: "memory");
    int tid = tid_, lane = lane_; asm volatile("" : "+v"(tid), "+v"(lane));
    const int r32 = lane & 31, h2 = lane >> 5, g = r32 >> 3, t = r32 & 7, m = NPR + b * STOK + t, hh = kvh * 4 + g, qpos = PAST + t;
    LAS float* LUT = (LAS float*)(lds + AS_LUT); LAS float* SG = (LAS float*)(lds + AS_SG); LAS u64* SEL = (LAS u64*)(lds + AS_SEL); LAS int* TL = (LAS int*)(lds + AS_TL);
    LAS float* SIMP = (LAS float*)(lds + AS_SIMP);
    LAS int* pt = (LAS int*)(lds + AS_PT);
    if (tid < NPAGES) pt[tid] = page_table[b * NPAGES + tid];
    bf16x8 qf[4];
#pragma unroll
    for (int ks = 0; ks < 4; ++ks) qf[ks] = __builtin_bit_cast(bf16x8, *(const GAS v4u*)(QB + (size_t)m * DM + hh * 64 + 16 * ks + 8 * h2));
    for (int idx = tid; idx < 4 * 129; idx += NWAVES * 64) { const int gg = idx / 129, d = idx % 129; LUT[gg * LUT_STRIDE + d] = rel_table[BKT[d] * 16 + kvh * 4 + gg] * LOG2E; }
    if (tid < 96) { const int q = tid / 3, br = tid % 3; SG[q * 4 + br] = sigmoid_f(GATES[(size_t)(NPR + b * STOK + (q & 7)) * 48 + (kvh * 4 + (q >> 3)) * 3 + br]); }
    for (int idx = tid; idx < 32 * 64; idx += NWAVES * 64) ((LAS float*)(lds + AS_OT))[idx] = 0.f;
    const float bias_far = rel_table[31 * 16 + hh] * LOG2E;
    const LAS float* lut = LUT + g * LUT_STRIDE;
    f32x16 o0, o1, p0, p1; float m_run, l_run;
#define AS_RESET() do { m_run = NEG_BIG; l_run = 0.f; _Pragma("unroll") for (int i = 0; i < 16; ++i) { o0[i] = 0.f; o1[i] = 0.f; } } while (0)
    stage_tile_bf16(KCS, (long)b * 128, 64, kvh, lds + AS_TB, tid);
    stage_tile_bf16(KCS, (long)b * 128 + 64, 64, kvh, lds + AS_TB + TILE_BYTES, tid);
    wg_sync();
#if SPLIT_RANK
    stage_k_hilo(KCS32, (long)b * 128, kvh, lds + AS_TB, lds + AS_TB + 2 * TILE_BYTES, tid);
    stage_k_hilo(KCS32, (long)b * 128 + 64, kvh, lds + AS_TB + TILE_BYTES, lds + AS_TB + 3 * TILE_BYTES, tid);
    wg_sync();
#endif
    AS_RESET();
    if (wave < 2) {
#if SPLIT_RANK
        bf16x8 qh[4], ql[4];
#pragma unroll
        for (int ks = 0; ks < 4; ++ks) { const GAS f32x4* qp = (const GAS f32x4*)(QS32 + (size_t)(b * STOK + t) * DM + hh * 64 + 16 * ks + 8 * h2);
            v4u h_, l_; split8(qp[0], qp[1], h_, l_); qh[ks] = __builtin_bit_cast(bf16x8, h_); ql[ks] = __builtin_bit_cast(bf16x8, l_); }
        attn_tile<3, true>(lds + AS_TB + wave * TILE_BYTES, qh, 0.f, qpos, 64 * 64 * wave + 63, true, lut, m_run, l_run, o0, o1, p0, p1, lane, lds + AS_TB + (2 + wave) * TILE_BYTES, ql);
#else
        attn_tile<3>(lds + AS_TB + wave * TILE_BYTES, qf, 0.f, qpos, 64 * 64 * wave + 63, true, lut, m_run, l_run, o0, o1, p0, p1, lane);
#endif
        LAS float* sp = SIMP + r32 * 128 + 64 * wave;
#pragma unroll
        for (int i = 0; i < 16; ++i) { sp[crow(i, h2)] = p0[i]; sp[32 + crow(i, h2)] = p1[i]; }
    }
    if (wave < 2) as_write_state(lds, AS_MOC, wave, lane, m_run, l_run, o0, o1);
    wg_sync();
    as_merge<2>(lds, AS_MOC, 0, tid);
    {
        const int tk = wave;
        const LAS float* ml = (const LAS float*)(lds + AS_ML);
        float v0 = 0.f, v1 = 0.f;
#pragma unroll
        for (int gg = 0; gg < 4; ++gg) { const int q = gg * 8 + tk;
            const float m0 = ml[(0 * 32 + q) * 2], l0 = ml[(0 * 32 + q) * 2 + 1], m1 = ml[(1 * 32 + q) * 2], l1 = ml[(1 * 32 + q) * 2 + 1];
            const float M = fmaxf(m0, m1), f0 = fast_exp2(m0 - M), f1 = fast_exp2(m1 - M), inv = 1.0f / (l0 * f0 + l1 * f1);
            v0 += SIMP[q * 128 + lane] * (f0 * inv); v1 += SIMP[q * 128 + 64 + lane] * (f1 * inv); }
        const bool c0 = lane >= 1, c1 = lane <= 62;
#ifdef PROBE_COARSE
        v0 = __uint_as_float(f2bf(v0) << 16); v1 = __uint_as_float(f2bf(v1) << 16);
#endif
        if (!c0) v0 = -1.f; if (!c1) v1 = -1.f;
        int rk0 = 0, rk1 = 0;
#pragma unroll
        for (int jj = 0; jj < 64; ++jj) {
            const float a = __builtin_bit_cast(float, __builtin_amdgcn_readlane(__builtin_bit_cast(int, v0), jj)), bb = __builtin_bit_cast(float, __builtin_amdgcn_readlane(__builtin_bit_cast(int, v1), jj));
            rk0 += (a > v0 || (a == v0 && jj < lane)) ? 1 : 0; rk0 += (bb > v0) ? 1 : 0;
            rk1 += (a > v1 || a == v1) ? 1 : 0; rk1 += (bb > v1 || (bb == v1 && jj < lane)) ? 1 : 0;
        }
        const bool s0 = (lane == 0) || (c0 && rk0 < 13), s1 = (lane == 63) || (c1 && rk1 < 13);
        const u64 mk0 = __ballot(s0), mk1 = __ballot(s1);
        if (lane == 0) { SEL[tk * 2] = mk0; SEL[tk * 2 + 1] = mk1; }
    }
    wg_sync();
    if (tid == 0) { u64 a0 = 0ull, a1 = 0ull; for (int i = 0; i < 8; ++i) { a0 |= SEL[2 * i]; a1 |= SEL[2 * i + 1]; }
        int n = 0; for (int j = 0; j < 64; ++j) if ((a0 >> j) & 1ull) TL[1 + n++] = j; for (int j = 0; j < 64; ++j) if ((a1 >> j) & 1ull) TL[1 + n++] = 64 + j; TL[1 + n++] = 128; TL[0] = n; }
    wg_sync();
#ifdef SAMPLE_BRUTE
    {
        const int q = tid >> 4, part = tid & 15, gq = q >> 3, tq = q & 7, hq = kvh * 4 + gq, qp = PAST + tq;
        float qv[64];
#pragma unroll
        for (int d = 0; d < 64; ++d) qv[d] = QS32[(size_t)(b * STOK + tq) * DM + hq * 64 + d];
        for (int br = 1; br <= 2; ++br) {
            float mrun = NEG_BIG, lrun = 0.f, ov[64];
#pragma unroll
            for (int d = 0; d < 64; ++d) ov[d] = 0.f;
            int nkeys, jblk = -1;
            if (br == 1) { const u64 a0 = SEL[tq * 2], a1 = SEL[tq * 2 + 1]; int cnt = 0; jblk = 128;
                for (int j = 0; j < 128; ++j) { const bool on = j < 64 ? ((a0 >> j) & 1ull) : ((a1 >> (j - 64)) & 1ull); if (on) { if (cnt == part) jblk = j; ++cnt; } }
                nkeys = 64; }
            else nkeys = 33;
            for (int kk = 0; kk < nkeys; ++kk) {
                int kpos; const float* krow;
                if (br == 1) { kpos = 64 * jblk + kk;
                    if (jblk < 128) krow = cache_slc + (((size_t)pt[jblk >> 1] * 128 + (jblk & 1) * 64 + kk) * 4 + kvh) * 128;
                    else krow = (kk < STOK) ? OUTP + O_SSLC + ((size_t)(b * STOK + kk) * 4 + kvh) * 128 : nullptr; }
                else { const int widx = part + 16 * kk; if (widx >= 520) continue; kpos = PAST - 512 + widx;
                    krow = widx < 512 ? cache_win + (((size_t)b * 512 + widx) * 4 + kvh) * 128 : OUTP + O_SWIN + (((size_t)b * 512 + 504 + (widx - 512)) * 4 + kvh) * 128; }
                const int dist = qp - kpos;
                const bool ok = krow != nullptr && dist >= 0 && (br == 1 || dist < 512);
                if (!ok) continue;
                float sdot = 0.f;
#pragma unroll
                for (int d = 0; d < 64; ++d) sdot += qv[d] * krow[d];
                sdot += rel_table[BKT[min(dist, 128)] * 16 + hq] * LOG2E;
                const float mn = fmaxf(mrun, sdot), al = fast_exp2(mrun - mn), pp = fast_exp2(sdot - mn);
                mrun = mn; lrun = lrun * al + pp;
#pragma unroll
                for (int d = 0; d < 64; ++d) ov[d] = ov[d] * al + pp * krow[64 + d];
            }
            float M = mrun;
#pragma unroll
            for (int o = 1; o < 16; o <<= 1) M = fmaxf(M, __shfl_xor(M, o));
            const float f = fast_exp2(mrun - M);
            float L = lrun * f;
#pragma unroll
            for (int o = 1; o < 16; o <<= 1) L += __shfl_xor(L, o);
            const float sc = SG[q * 4 + br] / L;
#pragma unroll
            for (int d = 0; d < 64; ++d) { float v = ov[d] * f;
#pragma unroll
                for (int o = 1; o < 16; o <<= 1) v += __shfl_xor(v, o);
                if (part == (d & 15)) ((LAS float*)(lds + AS_OT))[q * 64 + d] += v * sc; }
        }
    }
    wg_sync();
#else
    {
        const int ntl = TL[0];
        const u64 ms0 = SEL[t * 2], ms1 = SEL[t * 2 + 1];
        AS_RESET();
        const int nh = (ntl + 3) >> 2;
        StageRegsF rf[4];
        const StageOffF sof = stage_off_f32(tid);
#define SEL_ISSUE(h_) do { _Pragma("unroll") for (int s4 = 0; s4 < 4; ++s4) { const int idx = 4 * (h_) + s4; if (idx < ntl) { const int j = TL[1 + idx]; \
            if (j < 128) stage_f32_issue_off(cache_slc, pt[j >> 1] * 128 + (j & 1) * 64, kvh, sof, rf[s4]); \
            else stage_tile_bf16(SKV, (long)NPR + b * STOK, STOK, kvh, lds + AS_TB + ((((h_) & 1) << 2) + s4) * TILE_BYTES, tid); } } } while (0)
#define SEL_COMMIT(h_) do { _Pragma("unroll") for (int s4 = 0; s4 < 4; ++s4) { const int idx = 4 * (h_) + s4; \
            if (idx < ntl && TL[1 + idx] < 128) stage_f32_commit_off(rf[s4], lds + AS_TB + ((((h_) & 1) << 2) + s4) * TILE_BYTES, sof); } } while (0)
        SEL_ISSUE(0); SEL_COMMIT(0);
        wg_sync();
        for (int h = 0; h < nh; ++h) {
            if (h + 1 < nh) SEL_ISSUE(h + 1);
            if ((wave >> 2) == (h & 1)) { const int idx = 4 * h + (wave & 3);
                if (idx < ntl) { const int j = TL[1 + idx];
                    const bool sel = j >= 128 ? true : (j < 64 ? ((ms0 >> j) & 1ull) : ((ms1 >> (j - 64)) & 1ull));
                    if (j <= 125) attn_tile<0>(lds + AS_TB + wave * TILE_BYTES, qf, sel ? bias_far : -INFINITY, 0, 0, true, lut, m_run, l_run, o0, o1, p0, p1, lane);
                    else attn_tile<1>(lds + AS_TB + wave * TILE_BYTES, qf, 0.f, qpos, 64 * j, sel, lut, m_run, l_run, o0, o1, p0, p1, lane); } }
            if (h + 1 < nh) SEL_COMMIT(h + 1);
            wg_sync();
        }
#undef SEL_ISSUE
#undef SEL_COMMIT
        as_write_state(lds, AS_MO, wave, lane, m_run, l_run, o0, o1);
        wg_sync();
        as_merge<8>(lds, AS_MO, 1, tid);
        wg_sync();
    }
    {
#ifdef PROBE_DELAY
        for (int dly = 0; dly < 4000; ++dly) __builtin_amdgcn_s_sleep(127);
#endif
        AS_RESET();
        StageRegsF rf[4];
        const StageOffF sof = stage_off_f32(tid);
#define WIN_ISSUE(h_) do { _Pragma("unroll") for (int s4 = 0; s4 < 4; ++s4) { const int wt = 4 * (h_) + s4; if (wt < 9) { \
            if (wt < 8) stage_f32_issue_off(cache_win, b * 512 + 64 * wt, kvh, sof, rf[s4]); \
            else stage_tile_bf16(WKV, (long)NPR + b * STOK, STOK, kvh, lds + AS_TB + ((((h_) & 1) << 2) + s4) * TILE_BYTES, tid); } } } while (0)
#define WIN_COMMIT(h_) do { _Pragma("unroll") for (int s4 = 0; s4 < 4; ++s4) { const int wt = 4 * (h_) + s4; \
            if (wt < 8) stage_f32_commit_off(rf[s4], lds + AS_TB + ((((h_) & 1) << 2) + s4) * TILE_BYTES, sof); } } while (0)
        WIN_ISSUE(0); WIN_COMMIT(0);
        wg_sync();
        for (int h = 0; h < 3; ++h) {
            if (h + 1 < 3) WIN_ISSUE(h + 1);
            if ((wave >> 2) == (h & 1)) { const int wt = 4 * h + (wave & 3);
                if (wt < 9) attn_tile<2>(lds + AS_TB + wave * TILE_BYTES, qf, 0.f, qpos, PAST - 512 + 64 * wt, true, lut, m_run, l_run, o0, o1, p0, p1, lane); }
            if (h + 1 < 3) WIN_COMMIT(h + 1);
            wg_sync();
        }
#undef WIN_ISSUE
#undef WIN_COMMIT
        as_write_state(lds, AS_MO, wave, lane, m_run, l_run, o0, o1);
        wg_sync();
        as_merge<8>(lds, AS_MO, 2, tid);
        wg_sync();
    }
#endif
    {
        const int q = tid >> 4, d = (tid & 15) * 4, gq = q >> 3, tq = q & 7, mq = NPR + b * STOK + tq, hq = kvh * 4 + gq;
        const f32x4 v = *(const LAS f32x4*)((const LAS float*)(lds + AS_OT) + q * 64 + d);
        float ssq = (v.x * v.x + v.y * v.y) + (v.z * v.z + v.w * v.w);
        ssq += __shfl_xor(ssq, 1); ssq += __shfl_xor(ssq, 2); ssq += __shfl_xor(ssq, 4); ssq += __shfl_xor(ssq, 8);
        *(u64*)(MIX + (size_t)mq * DMIX + hq * 64 + d) = (u64)pk2(v.x, v.y) | ((u64)pk2(v.z, v.w) << 32);
        if ((tid & 15) == 0) SSQA[(size_t)mq * 16 + hq] = ssq;
    }
    wg_sync();
#undef AS_RESET
}

__device__ __forceinline__ void sample_q_unit(int unit, const float* X1, const float* mix_pre, const float* w_in, float* QS32, LAS unsigned char* lds, int tid, int wave, int lane) {
    const int r0 = (unit >> 4) * 16, c0 = (unit & 15) * 64;
    LAS float* xs = (LAS float*)lds;
    for (int rr = 2 * wave; rr < 2 * wave + 2; ++rr) {
        const GAS f32x4* xr = (const GAS f32x4*)(X1 + (size_t)(NPR + r0 + rr) * DM) + lane; const GAS f32x4* gr = (const GAS f32x4*)mix_pre + lane;
        f32x4 v[4]; float ss = 0.f;
#pragma unroll
        for (int j = 0; j < 4; ++j) { v[j] = xr[64 * j]; ss += (v[j].x * v[j].x + v[j].y * v[j].y) + (v[j].z * v[j].z + v[j].w * v[j].w); }
        const float rs = 1.0f / sqrtf(wave_sum(ss) * (1.f / DM) + EPS);
#pragma unroll
        for (int j = 0; j < 4; ++j) { const f32x4 gg = gr[64 * j]; *(LAS f32x4*)(xs + rr * 1024 + 4 * lane + 256 * j) = (f32x4){v[j].x * rs * gg.x, v[j].y * rs * gg.y, v[j].z * rs * gg.z, v[j].w * rs * gg.w}; }
    }
    wg_sync();
    {
        const int kq = tid >> 5, cp = tid & 31, c = c0 + 2 * cp;
        float acc[16][2];
#pragma unroll
        for (int r = 0; r < 16; ++r) { acc[r][0] = 0.f; acc[r][1] = 0.f; }
        const float* wp = w_in + (size_t)(64 * kq) * DIN + c;
#pragma unroll 4
        for (int k8 = 0; k8 < 8; ++k8) {
            float2 w[8];
#pragma unroll
            for (int i = 0; i < 8; ++i) w[i] = *(const float2*)(wp + (size_t)(8 * k8 + i) * DIN);
#pragma unroll
            for (int r = 0; r < 16; ++r) {
                const f32x4 xa = *(const LAS f32x4*)(xs + r * 1024 + 64 * kq + 8 * k8), xb = *(const LAS f32x4*)(xs + r * 1024 + 64 * kq + 8 * k8 + 4);
                acc[r][0] += xa.x * w[0].x + xa.y * w[1].x + xa.z * w[2].x + xa.w * w[3].x + xb.x * w[4].x + xb.y * w[5].x + xb.z * w[6].x + xb.w * w[7].x;
                acc[r][1] += xa.x * w[0].y + xa.y * w[1].y + xa.z * w[2].y + xa.w * w[3].y + xb.x * w[4].y + xb.y * w[5].y + xb.z * w[6].y + xb.w * w[7].y;
            }
        }
        LAS float* red = (LAS float*)(lds + 65536);
#pragma unroll
        for (int r = 0; r < 16; ++r) { typedef float f32x2v __attribute__((ext_vector_type(2))); *(LAS f32x2v*)(red + (kq * 16 + r) * 64 + 2 * cp) = (f32x2v){acc[r][0], acc[r][1]}; }
        wg_sync();
        for (int idx = tid; idx < 1024; idx += NWAVES * 64) { const int r = idx >> 6, cc = idx & 63; float sum = 0.f;
#pragma unroll
            for (int q = 0; q < 16; ++q) sum += red[(q * 16 + r) * 64 + cc];
            QS32[(size_t)(r0 + r) * DM + c0 + cc] = sum * C2; }
    }
    wg_sync();
}

constexpr int REP_0 = 1, REP_3 = 1, REP_13 = 1, REP_1 = 1, REP_2 = 1, REP_4 = 1, REP_5A = 1, REP_5B = 1, REP_6 = 1, REP_7A = 1, REP_7B = 1, REP_7C = 1, REP_9 = 1, REP_11 = 1, REP_12 = 1;
struct Args { const float* in[30]; float* out; unsigned char* ws; int ph_lo, ph_hi; };
constexpr int N_PHASES = 14;

#define x_prompt (args.in[0])
#define x_sample (args.in[1])
#define cache_cmp (args.in[2])
#define cache_slc (args.in[3])
#define cache_win (args.in[4])
#define state_ssm (args.in[5])
#define state_conv (args.in[6])
#define page_table ((const int*)args.in[7])
#define rel_table (args.in[8])
#define ffn1_pre (args.in[9])
#define ffn1_post (args.in[10])
#define ffn1_w_in (args.in[11])
#define ffn1_w_out (args.in[12])
#define mix_pre (args.in[13])
#define mix_post (args.in[14])
#define w_in (args.in[15])
#define w_out (args.in[16])
#define att_out_norm (args.in[17])
#define cmp_pe (args.in[18])
#define w_cmp (args.in[19])
#define conv_w (args.in[20])
#define conv_b (args.in[21])
#define dt_bias (args.in[22])
#define a_log (args.in[23])
#define d_skip (args.in[24])
#define ssd_norm (args.in[25])
#define ffn2_pre (args.in[26])
#define ffn2_post (args.in[27])
#define ffn2_w_in (args.in[28])
#define ffn2_w_out (args.in[29])
#define W1A ((bf16*)(args.ws + WS_W1A))
#define W1B ((bf16*)(args.ws + WS_W1B))
#define WIN ((bf16*)(args.ws + WS_WIN))
#define WOUT ((bf16*)(args.ws + WS_WOUT))
#define W2A ((bf16*)(args.ws + WS_W2A))
#define W2B ((bf16*)(args.ws + WS_W2B))
#define WCF ((bf16*)(args.ws + WS_WCF))
#define PEB ((float*)(args.ws + WS_PEB))
#define WCFL ((bf16*)(args.ws + WS_WCFL))
#define QS32 ((float*)(args.ws + WS_QS32))
#define KCS32 ((float*)(args.ws + WS_KCS32))
#define GATES ((float*)(args.ws + WS_GATES))
#define DTR ((float*)(args.ws + WS_DT))
#define SSQA ((float*)(args.ws + WS_SSQA))
#define SSQY ((float*)(args.ws + WS_SSQY))
#define DC ((float*)(args.ws + WS_DC))
#define KCP ((bf16*)(args.ws + WS_KCP))
#define KCS ((bf16*)(args.ws + WS_KCS))
#define XN ((bf16*)(args.ws + WS_XN))
#define QB ((bf16*)(args.ws + WS_Q))
#define CKV ((bf16*)(args.ws + WS_CKV))
#define SKV ((bf16*)(args.ws + WS_SKV))
#define WKV ((bf16*)(args.ws + WS_WKV))
#define ZB ((bf16*)(args.ws + WS_Z))
#define XBC ((bf16*)(args.ws + WS_XBC))
#define ACT ((bf16*)(args.ws + WS_ACT))
#define O32 ((float*)(args.ws + WS_O32))
#define X1 ((float*)(args.ws + WS_X1))
#define MIX ((bf16*)(args.ws + WS_MIX))
#define STB ((bf16*)(args.ws + WS_ST))
#define PART ((float*)(args.ws + WS_PART))
#define KMP ((float*)(args.ws + WS_KMP))
#define XCV (args.ws + WS_XCV)
#define BCV (args.ws + WS_BCV)
#define CCV (args.ws + WS_CCV)
#define SCV ((float*)(args.ws + WS_SCV))
__global__ void __launch_bounds__(NWAVES * 64, 2) mk_fwd(Args args) {
    extern __shared__ __attribute__((aligned(16))) unsigned char lds_raw[];
    LAS unsigned char* lds = (LAS unsigned char*)lds_raw;
    volatile LAS unsigned* MISC = (volatile LAS unsigned*)(lds + MISC_OFF);
    const int tid = threadIdx.x, lane = tid & 63, wave = __builtin_amdgcn_readfirstlane(tid >> 6);
    const int G = gridDim.x, bx = blockIdx.x;
    const int vcu = (G % 8 == 0) ? (bx % 8) * (G / 8) + bx / 8 : bx;
    const int gw = vcu * NWAVES + wave, NGW = G * NWAVES;
    unsigned char* ws = args.ws;
    gu32* ctl = (gu32*)(ws + WS_CTL);
    float* out = args.out;
    for (int u = tid; u < 64; u += NWAVES * 64) ((LAS unsigned*)(lds + MISC_OFF))[u] = 0u;
    __syncthreads();
    XcdBarrier bar = xcd_barrier_post((unsigned*)(ctl + CW_BAR), MISC + 8);
    const int lo = args.ph_lo, hi = args.ph_hi;
#define IN(k) (lo <= (k) && (k) < hi)
#define SEAM(k) do { if (IN(k) && IN((k) + 1)) xcd_barrier(bar); } while (0)

    if (IN(0)) {
    _Pragma("unroll 1") for (int rep0_ = 0; rep0_ < REP_0; ++rep0_) {
        int ln = lane; asm volatile("" : "+v"(ln));
        LAS float* scr = (LAS float*)(lds + wave * 16896);
        constexpr int I_A = 16 * (2 * DFF / 64), I_B = (DFF / 64) * (DM / 64), I_IN = 16 * (DINP / 64), I_OUT = (DMIX / 64) * (DM / 64);
        constexpr int NITEMS = I_A + I_B + I_IN + I_OUT;
        for (int it = gw; it < NITEMS; it += NGW) {
            int r = it;
            if (r < I_A) { transpose_item64<0>(ffn1_w_in, DM, 2 * DFF, W1A, nullptr, nullptr, scr, r, 2 * DFF / 64, ln); continue; } r -= I_A;
            if (r < I_B) { transpose_item64<1>(ffn1_w_out, DFF, DM, W1B, nullptr, nullptr, scr, r, DM / 64, ln); continue; } r -= I_B;
            if (r < I_IN) { transpose_item64<2>(w_in, DM, DIN, WIN, nullptr, nullptr, scr, r, DINP / 64, ln); continue; } r -= I_IN;
            transpose_item64<3>(w_out, DMIX, DM, WOUT, att_out_norm, ssd_norm, scr, r, DM / 64, ln);
        }
        for (int m = gw; m < NPR; m += 4 * NGW) {
            const int m1 = m + NGW < NPR ? m + NGW : m, m2 = m + 2 * NGW < NPR ? m + 2 * NGW : m, m3 = m + 3 * NGW < NPR ? m + 3 * NGW : m;
            rms_rows4_to_bf16(x_prompt + (size_t)m * DM, x_prompt + (size_t)m1 * DM, x_prompt + (size_t)m2 * DM, x_prompt + (size_t)m3 * DM, ffn1_pre,
                              XN + (size_t)m * DM, XN + (size_t)m1 * DM, XN + (size_t)m2 * DM, XN + (size_t)m3 * DM, ln);
        }
        for (int m = NPR + gw; m < MT; m += NGW) rms_row_to_bf16(x_sample + (size_t)(m - NPR) * DM, ffn1_pre, XN + (size_t)m * DM, ln);
#if 0
        for (int r = gw; r < SBAT * 504; r += NGW) {
            const int b = r / 504, j = r % 504;
            const GAS f32x4* s = (const GAS f32x4*)(cache_win + ((size_t)b * 512 + j + 8) * KVW) + ln;
            GAS f32x4* d = (GAS f32x4*)(out + O_SWIN + ((size_t)b * 512 + j) * KVW) + ln;
            d[0] = s[0]; d[64] = s[64];
        }
#endif
        for (int f = bx * (NWAVES * 64) + tid; f < 2 * 256 * 2 * 64; f += G * NWAVES * 64) {
            const int ln = f & 63, et = (f >> 6) & 1, ks = (f >> 7) & 255, c = f >> 15;
            const int l = ks >> 2, d0 = 32 * ((ks & 3) >> 1) + 16 * (ln >> 5) + 8 * (ks & 1), e = 32 * et + (ln & 31);
            const float* src = w_cmp + (((size_t)l * 2 + c) * 64 + d0) * 64 + e;
            v4u o; o.x = pk2(src[0], src[64]); o.y = pk2(src[128], src[192]); o.z = pk2(src[256], src[320]); o.w = pk2(src[384], src[448]);
            *(GAS v4u*)(WCF + (size_t)f * 8) = o;
            if (SPLIT_RANK && c == 0) {
                unsigned lw[8];
#pragma unroll
                for (int j = 0; j < 8; ++j) { const float x = src[64 * j]; lw[j] = f2bf(x - __uint_as_float(f2bf(x) << 16)); }
                v4u ol; ol.x = lw[0] | (lw[1] << 16); ol.y = lw[2] | (lw[3] << 16); ol.z = lw[4] | (lw[5] << 16); ol.w = lw[6] | (lw[7] << 16);
                *(GAS v4u*)(WCFL + (size_t)f * 8) = ol;
            }
        }
        if (bx < 16) {
            LAS float* red = (LAS float*)(lds + 140032);
            const int sub = tid >> 7, ce = tid & 127, c = ce >> 6, e = ce & 63, l = 4 * bx + sub;
            float s0 = 0.f, s1 = 0.f;
#pragma unroll 8
            for (int d = 0; d < 64; d += 2) { s0 += cmp_pe[(l * 2 + c) * 64 + d] * w_cmp[(((size_t)l * 2 + c) * 64 + d) * 64 + e]; s1 += cmp_pe[(l * 2 + c) * 64 + d + 1] * w_cmp[(((size_t)l * 2 + c) * 64 + d + 1) * 64 + e]; }
            red[tid] = s0 + s1;
            __syncthreads();
            if (tid < 128) PEB[bx * 128 + tid] = (red[tid] + red[tid + 128]) + (red[tid + 256] + red[tid + 384]);
        }
    }}
    SEAM(0);

    if (IN(1)) {
    _Pragma("unroll") for (int rep_ = 0; rep_ < REP_1; ++rep_) {
        pg8::Gemm g{XN, W1A, MT, 2 * DFF, DM}; pg8::StaticOrder S; S.init(MT, 2 * DFF, G, bx, DM);
        EpiSwiglu E{ACT};
        if (G == 256 && bx >= (65 * 22) % 256 && (bx & 1)) { const int hu = bx - (65 * 22) % 256, b = hu >> 4, b0 = (hu & 15) * 8;
            compress_sample_unit<false>(cache_cmp, page_table + b * NPAGES, b0, WCF, PEB, KCS + ((size_t)b * 128 + b0) * KVW, lds, tid, wave, lane); }
        pg8::gemm_phase<EpiSwiglu, pg8::StaticOrder, true, true>(lds, g, S, E);
        if (G == 256 && bx >= (65 * 22) % 256 && !(bx & 1)) { const int hu = bx - (65 * 22) % 256, b = hu >> 4, b0 = (hu & 15) * 8;
            compress_sample_unit<false>(cache_cmp, page_table + b * NPAGES, b0, WCF, PEB, KCS + ((size_t)b * 128 + b0) * KVW, lds, tid, wave, lane); }
    }}
    SEAM(1);
    if (IN(2)) {
    _Pragma("unroll") for (int rep_ = 0; rep_ < REP_2; ++rep_) {
        pg8::Gemm g{ACT, W1B, MT, DM, DFF}; MixedOrder S; S.S.init(NPR, DM, G, bx, DFF); S.nks = DFF / 256; EpiF32Mixed E{(bf16*)O32, PART};
        pg8::gemm_phase<EpiF32Mixed, MixedOrder, true, true>(lds, g, S, E);
        {
            int ln = lane; asm volatile("" : "+v"(ln));
            LAS float* scr = (LAS float*)(lds + wave * 16896);
            const int first = (G == 256) ? 4 * (DFF / 256) : 0;
            if (bx >= first) for (int it = (bx - first) * NWAVES + wave; it < 16 * (2 * DFF / 64); it += (G - first) * NWAVES)
                transpose_item64<0>(ffn2_w_in, DM, 2 * DFF, W2A, nullptr, nullptr, scr, it, 2 * DFF / 64, ln);
        }
    }}
    SEAM(2);
    if (IN(3)) {
    _Pragma("unroll 1") for (int rep3_ = 0; rep3_ < REP_3; ++rep3_) {
        int ln = lane; asm volatile("" : "+v"(ln));
        for (int m = gw; m < NPR; m += 2 * NGW) {
            RowRegs ra, rb; const int m2 = (m + NGW < NPR) ? m + NGW : m;
            row_load(ra, x_prompt + (size_t)m * DM, (const bf16*)O32 + (size_t)m * DM, ln); row_load(rb, x_prompt + (size_t)m2 * DM, (const bf16*)O32 + (size_t)m2 * DM, ln);
            row_finish(ra, ffn1_post, 0.5f, X1 + (size_t)m * DM, mix_pre, XN + (size_t)m * DM, ln);
            row_finish(rb, ffn1_post, 0.5f, X1 + (size_t)m2 * DM, mix_pre, XN + (size_t)m2 * DM, ln);
        }
        for (int m = NPR + gw; m < MT; m += NGW)
            row_post<false>(x_sample + (size_t)(m - NPR) * DM, PART + (size_t)(m - NPR) * DM, DFF / 256, (size_t)NSA * DM, ffn1_post, 0.5f, X1 + (size_t)m * DM, mix_pre, XN + (size_t)m * DM, ln);
    }}
    SEAM(3);
    if (IN(4)) {
    _Pragma("unroll") for (int rep_ = 0; rep_ < REP_4; ++rep_) {
        pg8::Gemm g{XN, WIN, MT, DINP, DM}; pg8::StaticOrder S; S.init(MT, DINP, G, bx, DM);
        EpiInProj E{QB, CKV, ZB, XBC, GATES, DTR, out};
        if (G == 256 && bx >= (65 * 21) % 256 && (bx & 1)) { const int hu = 106 + bx - (65 * 21) % 256, b = hu >> 4, b0 = (hu & 15) * 8;
            compress_sample_unit<false>(cache_cmp, page_table + b * NPAGES, b0, WCF, PEB, KCS + ((size_t)b * 128 + b0) * KVW, lds, tid, wave, lane); }
        pg8::gemm_phase<EpiInProj, pg8::StaticOrder, true, true>(lds, g, S, E);
        if (G == 256 && bx >= (65 * 21) % 256 && !(bx & 1)) { const int hu = 106 + bx - (65 * 21) % 256, b = hu >> 4, b0 = (hu & 15) * 8;
            compress_sample_unit<false>(cache_cmp, page_table + b * NPAGES, b0, WCF, PEB, KCS + ((size_t)b * 128 + b0) * KVW, lds, tid, wave, lane); }
    }}
    SEAM(4);

    if (IN(5)) {
    {
        if (SPLIT_RANK) for (int u = vcu; u < 256; u += G) sample_q_unit(u, X1, mix_pre, w_in, QS32, lds, tid, wave, lane);
        for (int e = vcu * (NWAVES * 64) + tid; e < 2 * NPR * 4; e += G * NWAVES * 64) {
            const int br = e >= NPR * 4, r = (e - br * NPR * 4) >> 2, kv = e & 3;
            const GAS v4u* kp = (const GAS v4u*)((br ? WKV : SKV) + (size_t)r * KVW + kv * 128);
            float ss = 0.f;
#pragma unroll
            for (int q = 0; q < 8; ++q) { const v4u w = kp[q];
                const float a0 = __uint_as_float(w.x << 16), a1 = __uint_as_float(w.x & 0xffff0000u), a2 = __uint_as_float(w.y << 16), a3 = __uint_as_float(w.y & 0xffff0000u);
                const float a4 = __uint_as_float(w.z << 16), a5 = __uint_as_float(w.z & 0xffff0000u), a6 = __uint_as_float(w.w << 16), a7 = __uint_as_float(w.w & 0xffff0000u);
                ss += (a0 * a0 + a1 * a1) + (a2 * a2 + a3 * a3) + (a4 * a4 + a5 * a5) + (a6 * a6 + a7 * a7); }
#pragma unroll
            for (int o = 4; o < 64; o <<= 1) ss = fmaxf(ss, __shfl_xor(ss, o));
            if (lane < 4) KMP[((size_t)br * (NPR / 16) + (r >> 4)) * 4 + kv] = ss;
        }
        _Pragma("unroll 1") for (int pass = 0; pass < 2; ++pass) {
        if (((pass ^ vcu) & 1) == 0) {
        _Pragma("unroll 1") for (int rep_ = 0; rep_ < REP_5A; ++rep_)
        for (int hu = (G == 256 ? 277 : 0) + vcu; hu < SBAT * 16; hu += G) { const int b = hu >> 4, b0 = (hu & 15) * 8;
            compress_sample_unit<false>(cache_cmp, page_table + b * NPAGES, b0, WCF, PEB, KCS + ((size_t)b * 128 + b0) * KVW, lds, tid, wave, lane); }
        _Pragma("unroll 1") for (int rep_ = 0; rep_ < REP_5A; ++rep_) {
            const int p0 = (G == 256) ? (vcu >= 235 ? vcu - 235 : NB * 8) : vcu, pst = (G == 256) ? 21 : G;
            for (int u = p0; u < NB * 8; u += pst) { const int b = u >> 3, b0 = (u & 7) * 8;
                compress_sample_unit<true>(CKV + (size_t)b * SEQ * KVW, nullptr, b0, WCF, PEB, KCP + ((size_t)b * 64 + b0) * KVW, lds, tid, wave, lane); }
        }
        } else {
        _Pragma("unroll 1") for (int rep_ = 0; rep_ < REP_5B; ++rep_)
            for (int gi = vcu; gi < NB * 32 * 2; gi += G) ssd_a_item<8>(8 * gi, XBC, DTR, dt_bias, a_log, conv_w, conv_b, STB, DC, XCV, BCV, CCV, SCV, lds, tid, wave, lane);
        }
        }
    }}
    SEAM(5);
    if (IN(6)) {
        ssd_scan(STB, DC, out + O_PSSM, vcu * (NWAVES * 64) + tid, G * NWAVES * 64);
        asm volatile("s_waitcnt vmcnt(0)" ::: "memory"); __syncthreads();
        if (tid == 0) { __builtin_amdgcn_fence(__ATOMIC_RELEASE, "agent"); asm volatile("s_waitcnt vmcnt(0)" ::: "memory"); (void)xb_add((unsigned*)(ctl + CW_SCAN), 1u); }
        _Pragma("unroll 1") for (int rep_ = 0; rep_ < REP_6; ++rep_) {
            const int npu = (1024 - vcu + G - 1) / G, nsu = IN(7) ? ((G == 256) ? ((vcu & 1) ? 0 : 1) : (SBAT * 4 - vcu + G - 1) / G) : 0;
            const int spos = (G == 256) ? ((vcu >> 1) & 3) : npu;
            bool fresh = true;
            for (int st = 0; st < npu + nsu; ++st) {
                if (st >= spos && st < spos + nsu) {
                    const int su = (G == 256) ? (vcu >> 1) : vcu + (st - spos) * G;
                    attn_sample_unit(su >> 2, su & 3, QB, QS32, KCS, KCS32, SKV, WKV, cache_slc, cache_win, page_table, GATES, rel_table, MIX, SSQA, out, lds, tid, wave, lane);
                    fresh = true;
                } else {
                    const int u = vcu + (st < spos ? st : st - nsu) * G;
                    const int slot = u >> 8, w = u & 255, bk = w >> 4, jj = w & 15;
                    const int ih = jj >> 1, od = jj & 1;
                    const int qb = (G != 256) ? (slot == 0 ? jj : (slot == 1 ? 31 - jj : (slot == 2 ? 32 + jj : 63 - jj)))
                                 : (slot == 0 ? jj : (slot == 1 ? 31 - jj : (slot == 2 ? 32 + 8 * od + ih : 55 + 8 * od - ih)));
                    attn_prompt_unit(fresh || G != 256, bk >> 2, bk & 3, qb, QB, KCP, SKV, WKV, GATES, rel_table, KMP, MIX, SSQA, lds, tid, wave, lane);
                    fresh = false;
                }
            }
        }
    }
    if (IN(6) != IN(7)) SEAM(6);
    if (IN(7)) {
    {
        const int c_lo = (G == 256) ? (vcu >> 1) * 8 : vcu, c_n = (G == 256) ? ((vcu & 1) ? 8 : 0) : (1024 - vcu + G - 1) / G, c_st = (G == 256) ? 1 : G;
        if (c_n > 0 && IN(6)) {
            if (tid == 0) { unsigned* bw_ = (unsigned*)(ctl + CW_BAR); XB_SPIN(xb_ld((unsigned*)(ctl + CW_SCAN)) < (unsigned)G, bw_);
                __builtin_amdgcn_fence(__ATOMIC_ACQUIRE, "agent"); asm volatile("s_waitcnt vmcnt(0)" ::: "memory"); }
            __syncthreads();
        }
        _Pragma("unroll 1") for (int rep_ = 0; rep_ < REP_7B; ++rep_) {
            if (c_st == 1) ssd_c_pair_run(c_lo, c_n, XCV, BCV, CCV, SCV, d_skip, STB, ZB, MIX, SSQY, lds, tid, wave, lane);
            else for (int k = 0, u = c_lo; k < c_n; ++k, u += c_st) ssd_c_pair_run(u, 1, XCV, BCV, CCV, SCV, d_skip, STB, ZB, MIX, SSQY, lds, tid, wave, lane);
        }
        _Pragma("unroll 1") for (int rep_ = 0; rep_ < REP_7C; ++rep_) {
            const int s0 = (G == 256) ? ((vcu & 1) ? vcu >> 1 : SBAT * 16) : vcu, sst = (G == 256) ? 128 : G;
            for (int u = s0; u < SBAT * 16; u += sst) ssd_sample_unit(u, XBC, DTR, dt_bias, a_log, conv_w, conv_b, d_skip, state_ssm, state_conv, ZB, MIX, SSQY, out + O_SSSM, lds, tid);
        }
    }}
    SEAM(7);
    if (IN(9)) {
    _Pragma("unroll") for (int rep_ = 0; rep_ < REP_9; ++rep_) {
        pg8::Gemm g{MIX, WOUT, MT, DM, DMIX}; MixedOrder S; S.S.init(NPR, DM, G, bx, DMIX); S.nks = DMIX / 256;
        {
            pg8::Unit u0, u1; const bool h0_ = S.next(0, u0), h1_ = S.next(1, u1);
            if (h0_) rs_fill((LAS float*)(lds + 131072), u0.pm, SSQA, SSQY, tid);
            if (h1_) rs_fill((LAS float*)(lds + 131072), u1.pm, SSQA, SSQY, tid);
            __syncthreads();
        }
        EpiOutProj E{(bf16*)O32, PART, (const LAS float*)(lds + 131072)};
        pg8::gemm_phase<EpiOutProj, MixedOrder, true, true>(lds, g, S, E);
        {
            int ln = lane; asm volatile("" : "+v"(ln));
            LAS float* scr = (LAS float*)(lds + wave * 16896);
            const int first = (G == 256) ? 4 * (DMIX / 256) : 0;
            if (bx >= first) for (int it = (bx - first) * NWAVES + wave; it < (DFF / 64) * (DM / 64); it += (G - first) * NWAVES)
                transpose_item64<1>(ffn2_w_out, DFF, DM, W2B, nullptr, nullptr, scr, it, DM / 64, ln);
        }
    }}
    SEAM(9);
    if (IN(10)) {
        int ln = lane; asm volatile("" : "+v"(ln));
        for (int m = gw; m < NPR; m += 2 * NGW) {
            RowRegs ra, rb; const int m2 = (m + NGW < NPR) ? m + NGW : m;
            row_load(ra, X1 + (size_t)m * DM, (const bf16*)O32 + (size_t)m * DM, ln); row_load(rb, X1 + (size_t)m2 * DM, (const bf16*)O32 + (size_t)m2 * DM, ln);
            row_finish(ra, mix_post, 1.0f, X1 + (size_t)m * DM, ffn2_pre, XN + (size_t)m * DM, ln, false);
            row_finish(rb, mix_post, 1.0f, X1 + (size_t)m2 * DM, ffn2_pre, XN + (size_t)m2 * DM, ln, false);
        }
        for (int m = NPR + gw; m < MT; m += NGW)
            row_post<false>(X1 + (size_t)m * DM, PART + (size_t)(m - NPR) * DM, DMIX / 256, (size_t)NSA * DM, mix_post, 1.0f, X1 + (size_t)m * DM, ffn2_pre, XN + (size_t)m * DM, ln);
    }
    SEAM(10);
    if (IN(11)) {
    _Pragma("unroll") for (int rep_ = 0; rep_ < REP_11; ++rep_) {
        pg8::Gemm g{XN, W2A, MT, 2 * DFF, DM}; pg8::StaticOrder S; S.init(MT, 2 * DFF, G, bx, DM);
        EpiSwiglu E{ACT};
        pg8::gemm_phase<EpiSwiglu, pg8::StaticOrder, true, true>(lds, g, S, E);
        {
            const int first = (G == 256) ? (65 * 22) % 256 : 0, nw_ = (G - first) * NWAVES, w0 = (bx - first) * NWAVES + wave;
            if (bx >= first) for (int r = w0; r < SBAT * 504; r += nw_) {
                const int b = r / 504, j = r % 504;
                const GAS f32x4* s_ = (const GAS f32x4*)(cache_win + ((size_t)b * 512 + j + 8) * KVW) + lane;
                GAS f32x4* d_ = (GAS f32x4*)(out + O_SWIN + ((size_t)b * 512 + j) * KVW) + lane;
                __builtin_nontemporal_store(s_[0], d_); __builtin_nontemporal_store(s_[64], d_ + 64);
            }
        }
    }}
    SEAM(11);
    if (IN(12)) {
    _Pragma("unroll") for (int rep_ = 0; rep_ < REP_12; ++rep_) {
        pg8::Gemm g{ACT, W2B, MT, DM, DFF}; MixedOrder S; S.S.init(NPR, DM, G, bx, DFF); S.nks = DFF / 256; EpiF32Mixed E{XN  , PART};
        pg8::gemm_phase<EpiF32Mixed, MixedOrder, true, true>(lds, g, S, E);
    }}
    SEAM(12);
    if (IN(13)) {
    _Pragma("unroll 1") for (int rep13_ = 0; rep13_ < REP_13; ++rep13_) {
        int ln = lane; asm volatile("" : "+v"(ln));
        for (int m = gw; m < NPR; m += 2 * NGW) {
            RowRegs2 ra, rb; const int m2 = (m + NGW < NPR) ? m + NGW : m;
            row_load2(ra, X1 + (size_t)m * DM, (const bf16*)O32 + (size_t)m * DM, XN + (size_t)m * DM, ln); row_load2(rb, X1 + (size_t)m2 * DM, (const bf16*)O32 + (size_t)m2 * DM, XN + (size_t)m2 * DM, ln);
            row_finish2(ra, mix_post, ffn2_post, 0.5f, out + (size_t)m * DM, ln);
            row_finish2(rb, mix_post, ffn2_post, 0.5f, out + (size_t)m2 * DM, ln);
        }
        for (int m = NPR + gw; m < MT; m += NGW)
            row_post<false>(X1 + (size_t)m * DM, PART + (size_t)(m - NPR) * DM, DFF / 256, (size_t)NSA * DM, ffn2_post, 0.5f, out + (size_t)m * DM, nullptr, nullptr, ln);
    }}

#undef IN
#undef SEAM
}

#undef x_prompt
#undef x_sample
#undef cache_cmp
#undef cache_slc
#undef cache_win
#undef state_ssm
#undef state_conv
#undef page_table
#undef rel_table
#undef ffn1_pre
#undef ffn1_post
#undef ffn1_w_in
#undef ffn1_w_out
#undef mix_pre
#undef mix_post
#undef w_in
#undef w_out
#undef att_out_norm
#undef cmp_pe
#undef w_cmp
#undef conv_w
#undef conv_b
#undef dt_bias
#undef a_log
#undef d_skip
#undef ssd_norm
#undef ffn2_pre
#undef ffn2_post
#undef ffn2_w_in
#undef ffn2_w_out
#undef W1A
#undef W1B
#undef WIN
#undef WOUT
#undef W2A
#undef W2B
#undef WCF
#undef PEB
#undef WCFL
#undef QS32
#undef KCS32
#undef GATES
#undef DTR
#undef SSQA
#undef SSQY
#undef DC
#undef KCP
#undef KCS
#undef XN
#undef QB
#undef CKV
#undef SKV
#undef WKV
#undef ZB
#undef XBC
#undef ACT
#undef O32
#undef X1
#undef MIX
#undef STB
#undef PART
#undef KMP
#undef XCV
#undef BCV
#undef CCV
#undef SCV
extern "C" void kernel_launch(void* const* d_in, const int* in_sizes, int n_in, void* d_out, int out_size, void* d_ws, size_t ws_size, hipStream_t stream) {
    static int grid = 0;
    if (grid == 0) {
        if (n_in != 30 || out_size != (int)O_END || ws_size < WS_END) { fprintf(stderr, "kernel_launch: unexpected shapes n_in %d out %d ws %zu\n", n_in, out_size, ws_size); grid = -1; return; }
        int dev = 0, cus = 0, per_cu = 0;
        if (hipGetDevice(&dev) != hipSuccess || hipDeviceGetAttribute(&cus, hipDeviceAttributeMultiprocessorCount, dev) != hipSuccess) { grid = -1; return; }
        if (hipFuncSetAttribute((const void*)mk_fwd, hipFuncAttributeMaxDynamicSharedMemorySize, LDS_BYTES) != hipSuccess) { fprintf(stderr, "kernel_launch: hipFuncSetAttribute failed\n"); grid = -1; return; }
        if (hipOccupancyMaxActiveBlocksPerMultiprocessor(&per_cu, (const void*)mk_fwd, NWAVES * 64, LDS_BYTES) != hipSuccess || per_cu < 1) { fprintf(stderr, "kernel_launch: occupancy query says %d\n", per_cu); }
        (void)hipGetLastError();
        grid = cus;
    }
    if (grid < 0) return;
    if (hipMemsetAsync((char*)d_ws + WS_CTL, 0, CTL_ZERO_BYTES, stream) != hipSuccess) return;
    Args a{};
    for (int i = 0; i < 30; ++i) a.in[i] = (const float*)d_in[i];
    a.out = (float*)d_out; a.ws = (unsigned char*)d_ws; a.ph_lo = 0; a.ph_hi = N_PHASES;
    hipLaunchKernelGGL(mk_fwd, dim3(grid), dim3(NWAVES * 64), LDS_BYTES, stream, a);
}
```

```cpp
#include <hip/hip_runtime.h>
#include <cstdio>
#include <cstdint>
namespace pg8 {
#define PG8_LAS __attribute__((address_space(3)))
typedef unsigned short bf16_t;
typedef short bf16x8 __attribute__((ext_vector_type(8)));
typedef float f32x4 __attribute__((ext_vector_type(4)));
typedef unsigned u32x4 __attribute__((ext_vector_type(4)));
constexpr int BM = 256, BK = 64, HALF = 128, HTB = HALF * BK * 2  , STAGE_BYTES = 8 * HTB, NXCD = 8, WGM = 8;

__host__ __device__ __forceinline__ int lds_byte(int r, int c) { const int st = (r >> 4) * 2 + (c >> 5), rr = r & 15, cc = c & 31, ob = rr * 64 + cc * 2; return st * 1024 + (ob ^ (((ob >> 9) & 1) << 5)); }
__host__ __device__ __forceinline__ void stage_rc(int b, int& R, int& C) { const int st = b / 1024, sb = b % 1024, swz = sb ^ (((sb >> 9) & 1) << 5); R = (st >> 1) * 16 + swz / 64; C = (st & 1) * 32 + (swz % 64) / 2; }
__host__ __device__ __forceinline__ int perm32(int rho) { const int n = rho >> 4, i = rho & 15; return 8 * (i >> 2) + 4 * n + (i & 3); }

struct Unit { int pm, pn, ko, kl; };
struct Gemm { const bf16_t* A; const bf16_t* Bt; int M, N, K; };

struct StaticOrder {
    int nM, nN, nwg, G, c, kfull;
    __host__ __device__ void init(int M, int N, int G_, int c_, int K_) { nM = M / BM; nN = N / BM; nwg = nM * nN; G = G_; c = c_; kfull = K_; }
    __host__ __device__ __forceinline__ bool next(int i, Unit& u) const {
        const long L = (long)i * G + c; if (L >= nwg) return false;
        int wgid = (int)L; { const int q = nwg / NXCD, r = nwg % NXCD, xcd = wgid % NXCD, off = wgid / NXCD; wgid = (xcd < r ? xcd * (q + 1) : r * (q + 1) + (xcd - r) * q) + off; }
        const int nig = WGM * nN, gid = wgid / nig, fm = gid * WGM, gsz = (nM - fm) < WGM ? (nM - fm) : WGM;
        u.pm = fm + ((wgid % nig) % gsz); u.pn = (wgid % nig) / gsz; u.ko = 0; u.kl = kfull; return true;
    }
    __device__ __forceinline__ void a_ready(const Unit&) const {}
    __device__ __forceinline__ void done(const Unit&) const {}
};

__device__ __forceinline__ unsigned cvt_pk_bf16(float lo, float hi) { unsigned r; asm volatile("v_cvt_pk_bf16_f32 %0, %1, %2" : "=v"(r) : "v"(lo), "v"(hi)); return r; }
template <class Epi, class Sched, bool ALIGN_EPI = false, bool SP2 = false>
__device__ __forceinline__ void gemm_phase(PG8_LAS unsigned char* lds, const Gemm g, const Sched& S, const Epi& E) {
    int tid_ = threadIdx.x; asm volatile("" : "+v"(tid_));
    const int tid = tid_, wid = __builtin_amdgcn_readfirstlane(tid >> 6), lane = tid & 63, wr = wid >> 2, wc = wid & 3, fr = lane & 15, fq = lane >> 4;
    const int K = g.K; int nt;
    unsigned voffA[2], voffB[2];
#pragma unroll
    for (int i = 0; i < 2; ++i) { int R, C; stage_rc(tid * 16 + i * 8192, R, C); const int Rb = Epi::PERM ? ((R & ~31) + perm32(R & 31)) : R;
        voffA[i] = (unsigned)(R * K + C) * 2u; voffB[i] = (unsigned)(Rb * K + C) * 2u; }
    const size_t kstep = (size_t)(BK * 2);
    const size_t hstep = (size_t)HALF * K * 2;
    const size_t tstep = 2 * hstep;
    const unsigned ldsw = (unsigned)wid * 1024u;
    const int aoff = lds_byte(wr * 64 + fr, fq * 8), boff = lds_byte(wc * 32 + fr, fq * 8);
#define PG8_SA(b, h) (((b) * 2 + (h)) * HTB)
#define PG8_SB(b, h) ((4 + (b) * 2 + (h)) * HTB)
#define PG8_STAGE(bufoff, gbase, voff) do { _Pragma("unroll") for (int _i = 0; _i < 2; ++_i) \
        __builtin_amdgcn_global_load_lds((const unsigned*)((const char*)(gbase) + (voff)[_i]), (PG8_LAS unsigned*)(lds + (bufoff) + ldsw + _i * 8192), 16, 0, 0); } while (0)
#define PG8_LDA(dst, b, h) do { _Pragma("unroll") for (int m = 0; m < 4; ++m) _Pragma("unroll") for (int k = 0; k < 2; ++k) dst[m][k] = *(const PG8_LAS bf16x8*)(lds + PG8_SA(b, h) + aoff + m * 2048 + k * 1024); } while (0)
#define PG8_LDB(dst, b, h) do { _Pragma("unroll") for (int n = 0; n < 2; ++n) _Pragma("unroll") for (int k = 0; k < 2; ++k) dst[n][k] = *(const PG8_LAS bf16x8*)(lds + PG8_SB(b, h) + boff + n * 2048 + k * 1024); } while (0)
#define PG8_MMA(ai, bj, At, Bt) do { __builtin_amdgcn_s_setprio(1); _Pragma("unroll") for (int m = 0; m < 4; ++m) _Pragma("unroll") for (int n = 0; n < 2; ++n) _Pragma("unroll") for (int k = 0; k < 2; ++k) \
        acc[ai][bj][m][n] = __builtin_amdgcn_mfma_f32_16x16x32_bf16(Bt[n][k], At[m][k], acc[ai][bj][m][n], 0, 0, 0); __builtin_amdgcn_s_setprio(0); } while (0)
#define PG8_WAIT_V(n) asm volatile("s_waitcnt vmcnt(" #n ")" ::: "memory")
#define PG8_WAIT_L(n) asm volatile("s_waitcnt lgkmcnt(" #n ")" ::: "memory")
#define PG8_BAR __builtin_amdgcn_s_barrier()
#define PG8_SCHED __builtin_amdgcn_sched_barrier(0)
    Unit cur, nxt; int ui = 0;
    if (!S.next(0, cur)) return;
    nt = cur.kl / BK;
    f32x4 acc[2][2][4][2];
#pragma unroll
    for (int a = 0; a < 2; ++a)
#pragma unroll
        for (int b = 0; b < 2; ++b)
#pragma unroll
            for (int m = 0; m < 4; ++m)
#pragma unroll
                for (int n = 0; n < 2; ++n) acc[a][b][m][n] = (f32x4){0.f, 0.f, 0.f, 0.f};
    bf16x8 At[4][2], B0[2][2], B1[2][2];
    const char* cA = (const char*)g.A + (size_t)cur.pm * tstep + (size_t)cur.ko * 2; const char* cB = (const char*)g.Bt + (size_t)cur.pn * tstep + (size_t)cur.ko * 2;
    S.a_ready(cur);
    if constexpr (SP2) {
        PG8_STAGE(PG8_SB(0, 0), cB, voffB); PG8_STAGE(PG8_SB(0, 1), cB + hstep, voffB); PG8_STAGE(PG8_SA(0, 0), cA, voffA); PG8_STAGE(PG8_SA(0, 1), cA + hstep, voffA);
        if (wr == 1) PG8_BAR;
        PG8_WAIT_V(2); PG8_BAR;
        PG8_STAGE(PG8_SB(1, 0), cB + kstep, voffB); PG8_STAGE(PG8_SA(1, 0), cA + kstep, voffA); PG8_STAGE(PG8_SB(1, 1), cB + hstep + kstep, voffB);
        PG8_WAIT_V(6); PG8_BAR;
    } else {
        PG8_STAGE(PG8_SB(0, 0), cB, voffB); PG8_STAGE(PG8_SA(0, 0), cA, voffA); PG8_STAGE(PG8_SB(0, 1), cB + hstep, voffB); PG8_STAGE(PG8_SA(0, 1), cA + hstep, voffA);
        if (wr == 1) PG8_BAR;
        PG8_WAIT_V(4); PG8_BAR;
        PG8_STAGE(PG8_SB(1, 0), cB + kstep, voffB); PG8_STAGE(PG8_SA(1, 0), cA + kstep, voffA); PG8_STAGE(PG8_SB(1, 1), cB + hstep + kstep, voffB);
        PG8_WAIT_V(6); PG8_BAR;
    }
    for (;;) {
        const bool has_next = S.next(ui + 1, nxt);
        const char* nA = has_next ? (const char*)g.A + (size_t)nxt.pm * tstep + (size_t)nxt.ko * 2 : cA; const char* nB = has_next ? (const char*)g.Bt + (size_t)nxt.pn * tstep + (size_t)nxt.ko * 2 : cB;
        for (int t = 0; t < nt; t += 2) {
            if constexpr (Epi::KHOOK) { if ((t == 16 || t == 24) && cur.pm != 64) E.khook(t, acc, wr, fr); }
            const bool last = (t == nt - 2);
            const char* a1 = cA + (size_t)(t + 1) * kstep;
            const char* a2 = last ? nA : cA + (size_t)(t + 2) * kstep; const char* b2 = last ? nB : cB + (size_t)(t + 2) * kstep;
            const char* a3 = a2 + kstep; const char* b3 = b2 + kstep;
            if (last && has_next) S.a_ready(nxt);
            if constexpr (SP2) {
            PG8_LDB(B0, 0, 0); PG8_LDB(B1, 0, 1); PG8_SCHED; PG8_LDA(At, 0, 0); PG8_STAGE(PG8_SA(1, 1), a1 + hstep, voffA);
            PG8_WAIT_V(8); PG8_WAIT_L(0); PG8_BAR; PG8_MMA(0, 0, At, B0); PG8_MMA(0, 1, At, B1); PG8_BAR; PG8_SCHED;
            PG8_LDA(At, 0, 1); PG8_STAGE(PG8_SB(0, 0), b2, voffB); PG8_STAGE(PG8_SB(0, 1), b2 + hstep, voffB); PG8_STAGE(PG8_SA(0, 0), a2, voffA);
            PG8_WAIT_V(8); PG8_WAIT_L(0); PG8_BAR; PG8_MMA(1, 0, At, B0); PG8_MMA(1, 1, At, B1); PG8_BAR; PG8_SCHED;
            PG8_LDB(B0, 1, 0); PG8_LDB(B1, 1, 1); PG8_SCHED; PG8_LDA(At, 1, 0); PG8_STAGE(PG8_SA(0, 1), a2 + hstep, voffA);
            PG8_WAIT_V(8); PG8_WAIT_L(0); PG8_BAR; PG8_MMA(0, 0, At, B0); PG8_MMA(0, 1, At, B1); PG8_BAR; PG8_SCHED;
            PG8_LDA(At, 1, 1); PG8_STAGE(PG8_SB(1, 0), b3, voffB); PG8_STAGE(PG8_SB(1, 1), b3 + hstep, voffB); PG8_STAGE(PG8_SA(1, 0), a3, voffA);
            PG8_WAIT_V(8); PG8_WAIT_L(0); PG8_BAR; PG8_MMA(1, 0, At, B0); PG8_MMA(1, 1, At, B1); PG8_BAR; PG8_SCHED;
            } else {
            PG8_LDB(B0, 0, 0); PG8_SCHED; PG8_LDA(At, 0, 0); PG8_STAGE(PG8_SA(1, 1), a1 + hstep, voffA);
            PG8_WAIT_L(8); PG8_BAR; PG8_WAIT_L(0); PG8_MMA(0, 0, At, B0); PG8_BAR; PG8_SCHED;
            PG8_LDB(B1, 0, 1); PG8_STAGE(PG8_SB(0, 0), b2, voffB);
            PG8_BAR; PG8_WAIT_L(0); PG8_MMA(0, 1, At, B1); PG8_BAR;
            PG8_LDA(At, 0, 1); PG8_STAGE(PG8_SA(0, 0), a2, voffA);
            PG8_BAR; PG8_WAIT_L(0); PG8_MMA(1, 0, At, B0); PG8_BAR; PG8_SCHED;
            PG8_STAGE(PG8_SB(0, 1), b2 + hstep, voffB);
            PG8_WAIT_V(6); PG8_BAR; PG8_MMA(1, 1, At, B1); PG8_BAR;
            PG8_LDB(B0, 1, 0); PG8_SCHED; PG8_LDA(At, 1, 0); PG8_STAGE(PG8_SA(0, 1), a2 + hstep, voffA);
            PG8_WAIT_L(8); PG8_BAR; PG8_WAIT_L(0); PG8_MMA(0, 0, At, B0); PG8_BAR; PG8_SCHED;
            PG8_LDB(B1, 1, 1); PG8_STAGE(PG8_SB(1, 0), b3, voffB);
            PG8_BAR; PG8_WAIT_L(0); PG8_MMA(0, 1, At, B1); PG8_BAR;
            PG8_LDA(At, 1, 1); PG8_STAGE(PG8_SA(1, 0), a3, voffA);
            PG8_BAR; PG8_WAIT_L(0); PG8_MMA(1, 0, At, B0); PG8_BAR; PG8_SCHED;
            PG8_STAGE(PG8_SB(1, 1), b3 + hstep, voffB);
            PG8_WAIT_V(6); PG8_BAR; PG8_MMA(1, 1, At, B1); PG8_BAR;
            }
        }
        if constexpr (ALIGN_EPI) { if (wr == 0) PG8_BAR; }
        if constexpr (!Epi::AFTER_DRAIN) { E(acc, cur, wr, wc, fr, fq); S.done(cur); }
        if (!has_next) break;
#pragma unroll
        for (int a = 0; a < 2; ++a)
#pragma unroll
            for (int b = 0; b < 2; ++b)
#pragma unroll
                for (int m = 0; m < 4; ++m)
#pragma unroll
                    for (int n = 0; n < 2; ++n) acc[a][b][m][n] = (f32x4){0.f, 0.f, 0.f, 0.f};
        cur = nxt; cA = nA; cB = nB; ++ui; nt = cur.kl / BK;
        if constexpr (ALIGN_EPI) { if (wr == 1) PG8_BAR; }
    }
    PG8_WAIT_V(0);
    if constexpr (!ALIGN_EPI) { if (wr == 0) PG8_BAR; }
    PG8_BAR;
    if constexpr (Epi::AFTER_DRAIN) { E.fused(acc, cur, wr, wc, fr, fq, lds, wid, lane); S.done(cur); }
#undef PG8_SA
#undef PG8_SB
#undef PG8_STAGE
#undef PG8_LDA
#undef PG8_LDB
#undef PG8_MMA
#undef PG8_WAIT_V
#undef PG8_WAIT_L
#undef PG8_BAR
#undef PG8_SCHED
}
}
#define GAS __attribute__((address_space(1)))
#define LAS __attribute__((address_space(3)))
typedef unsigned short bf16;
typedef unsigned v4u __attribute__((ext_vector_type(4)));
typedef float f32x4 __attribute__((ext_vector_type(4)));
typedef short bf16x8 __attribute__((ext_vector_type(8)));
typedef GAS unsigned gu32;
typedef GAS unsigned long long gu64;
#define RLX_AGENT __ATOMIC_RELAXED, __HIP_MEMORY_SCOPE_AGENT
#define LDS_WAIT() asm volatile("s_waitcnt lgkmcnt(0)" ::: "memory")
#define VM_WAIT() asm volatile("s_waitcnt vmcnt(0)" ::: "memory")
__device__ __forceinline__ unsigned long long rt() { return __builtin_amdgcn_s_memrealtime(); }
__device__ __forceinline__ unsigned f2bf(float f) { unsigned u = __builtin_bit_cast(unsigned, f); return (u + 0x7fffu + ((u >> 16) & 1u)) >> 16; }
typedef float pk2_f32x2_t __attribute__((ext_vector_type(2))); typedef __bf16 pk2_bf16x2_t __attribute__((ext_vector_type(2)));
__device__ __forceinline__ unsigned pk2(float lo, float hi) { pk2_f32x2_t v = {lo, hi}; pk2_bf16x2_t b = __builtin_convertvector(v, pk2_bf16x2_t); return __builtin_bit_cast(unsigned, b); }
#define XB_TMO      128
#define XB_XCNT(j)  (256  + 64 * (j))
#define XB_XSUB(j)  (1280 + 64 * (j))
#define XB_XGEN(j)  (2304 + 64 * (j))
#define XB_TOP      3328
#define XB_TOPGEN   3392
#define XCD_BAR_WORDS 3456
#define XB_SPIN_CAP (1u << 18)

__device__ __forceinline__ unsigned xb_ld(unsigned* p)              { return __hip_atomic_load(p, __ATOMIC_RELAXED, __HIP_MEMORY_SCOPE_AGENT); }
__device__ __forceinline__ unsigned xb_add(unsigned* p, unsigned v) { return __hip_atomic_fetch_add(p, v, __ATOMIC_RELAXED, __HIP_MEMORY_SCOPE_AGENT); }
__device__ __forceinline__ unsigned xb_xcc_id() { return (unsigned)__builtin_amdgcn_s_getreg((3 << 11) | 20) & 0xFu; }
#define XB_SPIN(cond, bar) do { unsigned _sp = 0; while (cond) { __builtin_amdgcn_s_sleep(1); \
    if ((++_sp & 255u) == 0u) { if (xb_ld(&(bar)[XB_TMO])) break; if (_sp > XB_SPIN_CAP) { atomicAdd(&(bar)[XB_TMO], 1u); break; } } } } while (0)

struct XcdBarrier {
    unsigned* bar; unsigned x;
    volatile LAS unsigned* st;
};

__device__ __forceinline__ XcdBarrier xcd_barrier_post(unsigned* bar, volatile LAS unsigned* st) {
    XcdBarrier b; b.bar = bar; b.x = xb_xcc_id(); b.st = st;
    if (threadIdx.x == 0) (void)xb_add(&bar[XB_XCNT(b.x)], 1u);
    return b;
}
__device__ __forceinline__ void xcd_barrier_complete(unsigned* bar, unsigned x, unsigned& nloc, unsigned& nx) {
    const unsigned G = gridDim.x * gridDim.y * gridDim.z;
    unsigned sum, cnt, mine, sp = 0u;
    for (;;) {
        sum = 0u; cnt = 0u; mine = 0u;
#pragma unroll
        for (unsigned j = 0; j < 16; ++j) { const unsigned c = xb_ld(&bar[XB_XCNT(j)]); sum += c; cnt += (c > 0u) ? 1u : 0u; mine = (j == x) ? c : mine; }
        if (sum == G) break;
        __builtin_amdgcn_s_sleep(1);
        if ((++sp & 255u) == 0u) { if (xb_ld(&bar[XB_TMO])) break; if (sp > XB_SPIN_CAP) { atomicAdd(&bar[XB_TMO], 1u); break; } }
    }
    nloc = mine > 0u ? mine : 1u; nx = cnt > 0u ? cnt : 1u;
}

__device__ __forceinline__ void xcd_barrier(const XcdBarrier& b) {
    asm volatile("s_waitcnt vmcnt(0)" ::: "memory");
    __syncthreads();
    if (threadIdx.x == 0) {
        unsigned* bar = b.bar;
        __builtin_amdgcn_s_waitcnt(0);
        unsigned nloc = b.st[0], nx = b.st[1];
        if (nloc == 0u) { xcd_barrier_complete(bar, b.x, nloc, nx); b.st[0] = nloc; b.st[1] = nx; }
        const unsigned old = xb_add(&bar[XB_XSUB(b.x)], 1u);
        const unsigned gen = old / nloc;
        if (old + 1u == (gen + 1u) * nloc) {
            __builtin_amdgcn_fence(__ATOMIC_RELEASE, "agent");
            asm volatile("s_waitcnt vmcnt(0)" ::: "memory");
            const unsigned og = xb_add(&bar[XB_TOP], 1u);
            const unsigned tg = og / nx;
            if (og + 1u == (tg + 1u) * nx) xb_add(&bar[XB_TOPGEN], 1u);
            else XB_SPIN(xb_ld(&bar[XB_TOPGEN]) == tg, bar);
            __builtin_amdgcn_fence(__ATOMIC_ACQUIRE, "agent");
            xb_add(&bar[XB_XGEN(b.x)], 1u);
            asm volatile("s_waitcnt vmcnt(0)" ::: "memory");
        } else {
            XB_SPIN(xb_ld(&bar[XB_XGEN(b.x)]) == gen, bar);
            __builtin_amdgcn_fence(__ATOMIC_ACQUIRE, "agent");
            asm volatile("s_waitcnt vmcnt(0)" ::: "memory");
        }
    }
    __syncthreads();
}

constexpr int NWAVES = 8;
constexpr int DM = 1024, NB = 4, SEQ = 4096, NPR = NB * SEQ, SBAT = 32, STOK = 8, NSA = SBAT * STOK, MT = NPR + NSA;
constexpr int DFF = 2816, DIN = 5184, DINP = 5376, DMIX = 2048, KVW = 512, CONVD = 1536;
constexpr int PAST = 8192, NPAGES = 64, NPB = 128;
constexpr float EPS = 1e-6f;
constexpr float C2 = 0.125f * 1.4426950408889634f;
constexpr float LOG2E = 1.4426950408889634f;

constexpr size_t O_YP = 0, O_YS = 16777216, O_PCMP = 17039360, O_PSLC = 25427968, O_PWIN = 33816576, O_PSSM = 34865152, O_PCONV = 35389440,
                 O_SCMP = 35407872, O_SSLC = 35538944, O_SWIN = 35670016, O_SSSM = 44058624, O_SCONV = 48252928, O_END = 48400384;

constexpr size_t MiB = 1u << 20;
constexpr size_t WS_CTL = 0, CTL_ZERO_BYTES = 1 * MiB;
constexpr size_t WS_W1A = 2 * MiB, WS_W1B = 13 * MiB, WS_WIN = 19 * MiB, WS_WOUT = 30 * MiB, WS_W2A = 34 * MiB, WS_W2B = 45 * MiB, WS_WCF = 51 * MiB, WS_PEB = 52 * MiB, WS_KMP = 52 * MiB + 655360, WS_WCFL = 52 * MiB + 65536, WS_QS32 = 69 * MiB, WS_KCS32 = 618 * MiB, WS_PART = 624 * MiB;
constexpr size_t WS_GATES = 53 * MiB, WS_DT = 57 * MiB, WS_SSQA = 59 * MiB, WS_SSQY = 61 * MiB, WS_DC = 63 * MiB, WS_KCP = 64 * MiB, WS_KCS = 65 * MiB;
constexpr size_t WS_XN = 70 * MiB, WS_Q = 103 * MiB, WS_CKV = 136 * MiB, WS_SKV = 153 * MiB, WS_WKV = 170 * MiB, WS_Z = 187 * MiB, WS_XBC = 220 * MiB;
constexpr size_t WS_XCV = 269 * MiB, WS_BCV = 301 * MiB, WS_CCV = 309 * MiB, WS_SCV = 317 * MiB;
constexpr size_t WS_ACT = 269 * MiB, WS_O32 = 359 * MiB, WS_X1 = 424 * MiB, WS_MIX = 489 * MiB, WS_ST = 554 * MiB, WS_END = 636 * MiB;
constexpr int CW_BAR = 4096, CW_KMAX = 8192, CW_SCAN = 12288;

constexpr int LDS_BYTES = 163840;
constexpr int MISC_OFF = LDS_BYTES - 256;

__device__ __forceinline__ float wave_sum(float v) {
#pragma unroll
    for (int o = 1; o < 64; o <<= 1) v += __shfl_xor(v, o);
    return v;
}
__device__ __forceinline__ float fast_exp2(float x) { return __builtin_amdgcn_exp2f(x); }
__device__ __forceinline__ float fast_rcp(float x) { return __builtin_amdgcn_rcpf(x); }
__device__ __forceinline__ float silu_f(float x) { return x * fast_rcp(1.0f + fast_exp2(-x * LOG2E)); }
__device__ __forceinline__ float sigmoid_f(float x) { return fast_rcp(1.0f + fast_exp2(-x * LOG2E)); }
typedef float f32x2_t __attribute__((ext_vector_type(2))); typedef __bf16 bf16x2_t __attribute__((ext_vector_type(2)));
__device__ __forceinline__ unsigned cvtpk(float lo, float hi) { f32x2_t v = {lo, hi}; bf16x2_t b = __builtin_convertvector(v, bf16x2_t); return __builtin_bit_cast(unsigned, b); }
__device__ __forceinline__ float bf2f(unsigned short h) { return __uint_as_float(((unsigned)h) << 16); }

struct EpiSwiglu {
    static constexpr bool PERM = true, AFTER_DRAIN = false, KHOOK = false;
    bf16* O;
    __device__ __forceinline__ void operator()(const pg8::f32x4 (&acc)[2][2][4][2], const pg8::Unit& u, int wr, int wc, int fr, int fq) const {
        const int row0 = u.pm * 256 + wr * 64 + fr, col0 = u.pn * 128 + wc * 32 + 8 * fq;
#pragma unroll
        for (int ai = 0; ai < 2; ++ai)
#pragma unroll
            for (int m = 0; m < 4; ++m) {
                bf16* rowp = O + (size_t)(row0 + ai * 128 + m * 16) * DFF + col0;
                const pg8::f32x4 g0 = acc[ai][0][m][0], g1 = acc[ai][0][m][1], u0 = acc[ai][1][m][0], u1 = acc[ai][1][m][1];
                pg8::u32x4 w;
                w.x = cvtpk(silu_f(g0[0]) * u0[0], silu_f(g0[1]) * u0[1]); w.y = cvtpk(silu_f(g0[2]) * u0[2], silu_f(g0[3]) * u0[3]);
                w.z = cvtpk(silu_f(g1[0]) * u1[0], silu_f(g1[1]) * u1[1]); w.w = cvtpk(silu_f(g1[2]) * u1[2], silu_f(g1[3]) * u1[3]);
                *(pg8::u32x4*)rowp = w;
            }
    }
};
struct EpiF32 {
    static constexpr bool PERM = false, AFTER_DRAIN = false, KHOOK = false;
    float* C;
    __device__ __forceinline__ void operator()(const pg8::f32x4 (&acc)[2][2][4][2], const pg8::Unit& u, int wr, int wc, int fr, int fq) const {
        const int row0 = u.pm * 256 + wr * 64 + fr, col0 = u.pn * 256 + wc * 32 + 4 * fq;
#pragma unroll
        for (int ai = 0; ai < 2; ++ai)
#pragma unroll
            for (int m = 0; m < 4; ++m) { float* rowp = C + (size_t)(row0 + ai * 128 + m * 16) * DM + col0;
#pragma unroll
                for (int bj = 0; bj < 2; ++bj)
#pragma unroll
                    for (int n = 0; n < 2; ++n) *(pg8::f32x4*)(rowp + bj * 128 + n * 16) = acc[ai][bj][m][n]; }
    }
};
struct MixedOrder {
    pg8::StaticOrder S; int nks;
    __device__ __forceinline__ bool next(int i, pg8::Unit& u) const {
        if (i * S.G + S.c < S.nwg) return S.next(i, u);
        const int L = i * S.G + S.c - S.nwg; if (L >= 4 * nks) return false;
        u.pm = 64; u.pn = L & 3; u.ko = (L >> 2) * 256; u.kl = 256; return true; }
    __device__ __forceinline__ void a_ready(const pg8::Unit&) const {}
    __device__ __forceinline__ void done(const pg8::Unit&) const {}
};
struct EpiF32Mixed {
    static constexpr bool PERM = true, AFTER_DRAIN = false, KHOOK = false;
    bf16* C; float* P;
    __device__ __forceinline__ void operator()(const pg8::f32x4 (&acc)[2][2][4][2], const pg8::Unit& u, int wr, int wc, int fr, int fq) const {
        const int col0 = u.pn * 256 + wc * 32 + 8 * fq;
        if (u.pm == 64) {
            float* base = P + (size_t)(u.ko >> 8) * (NSA * DM) + (size_t)(wr * 64 + fr) * DM + col0;
#pragma unroll
            for (int ai = 0; ai < 2; ++ai)
#pragma unroll
                for (int m = 0; m < 4; ++m) { float* rowp = base + (size_t)(ai * 128 + m * 16) * DM;
#pragma unroll
                    for (int bj = 0; bj < 2; ++bj) { *(pg8::f32x4*)(rowp + bj * 128) = acc[ai][bj][m][0]; *(pg8::f32x4*)(rowp + bj * 128 + 4) = acc[ai][bj][m][1]; } }
        } else {
            bf16* base = C + (size_t)(u.pm * 256 + wr * 64 + fr) * DM + col0;
#pragma unroll
            for (int ai = 0; ai < 2; ++ai)
#pragma unroll
                for (int m = 0; m < 4; ++m) { bf16* rowp = base + (size_t)(ai * 128 + m * 16) * DM;
#pragma unroll
                    for (int bj = 0; bj < 2; ++bj) { const pg8::f32x4 v0 = acc[ai][bj][m][0], v1 = acc[ai][bj][m][1];
                        pg8::u32x4 w; w.x = cvtpk(v0[0], v0[1]); w.y = cvtpk(v0[2], v0[3]); w.z = cvtpk(v1[0], v1[1]); w.w = cvtpk(v1[2], v1[3]);
                        *(pg8::u32x4*)(rowp + bj * 128) = w; } }
        }
    }
};
__device__ __forceinline__ void rs_fill(LAS float* RS, int pm, const float* SSQA, const float* SSQY, int tid) {
    if (tid < 256) {
        const size_t row = (size_t)pm * 256 + tid; float sa = 0.f, s0 = 0.f, s1 = 0.f;
        const GAS f32x4* a4 = (const GAS f32x4*)(SSQA + row * 16); const GAS f32x4* y4 = (const GAS f32x4*)(SSQY + row * 16);
#pragma unroll
        for (int q = 0; q < 4; ++q) { const f32x4 v = a4[q]; sa += (v.x + v.y) + (v.z + v.w); }
        { const f32x4 v = y4[0], w = y4[1]; s0 = ((v.x + v.y) + (v.z + v.w)) + ((w.x + w.y) + (w.z + w.w)); }
        { const f32x4 v = y4[2], w = y4[3]; s1 = ((v.x + v.y) + (v.z + v.w)) + ((w.x + w.y) + (w.z + w.w)); }
        const float ra = 1.0f / sqrtf(sa * (1.f / 1024.f) + EPS), r0 = 1.0f / sqrtf(s0 * (1.f / 512.f) + EPS), r1 = 1.0f / sqrtf(s1 * (1.f / 512.f) + EPS);
        LAS f32x4* r = (LAS f32x4*)(RS + ((pm == 64 ? 1 : 0) * 256 + tid) * 4);
        *r = (pm == 64) ? (f32x4){ra, r0, r1, 0.f} : (f32x4){ra / r0, r0 / r1, r1, 0.f};
    }
}
struct EpiOutProj {
    static constexpr bool PERM = true, AFTER_DRAIN = false, KHOOK = true;
    bf16* C; float* P; const LAS float* RS;
    __device__ __forceinline__ void khook(int t, pg8::f32x4 (&acc)[2][2][4][2], int wr, int fr) const {
        const LAS float* r0 = RS + (wr * 64 + fr) * 4 + (t == 16 ? 0 : 1);
#pragma unroll
        for (int ai = 0; ai < 2; ++ai)
#pragma unroll
            for (int m = 0; m < 4; ++m) { const float f = r0[(ai * 128 + m * 16) * 4];
#pragma unroll
                for (int bj = 0; bj < 2; ++bj)
#pragma unroll
                    for (int n = 0; n < 2; ++n) acc[ai][bj][m][n] = acc[ai][bj][m][n] * f; }
    }
    __device__ __forceinline__ void operator()(const pg8::f32x4 (&acc)[2][2][4][2], const pg8::Unit& u, int wr, int wc, int fr, int fq) const {
        asm volatile("" : "+v"(fr), "+v"(fq));
        const int col0 = u.pn * 256 + wc * 32 + 8 * fq;
        const int ui = (u.pm == 64) ? 1 : 0, seg = u.ko < 1024 ? 0 : (u.ko < 1536 ? 1 : 2);
#pragma unroll
        for (int ai = 0; ai < 2; ++ai)
#pragma unroll
            for (int m = 0; m < 4; ++m) {
                const int rl = ai * 128 + wr * 64 + m * 16 + fr;
                const LAS float* r = RS + (ui * 256 + rl) * 4;
                if (u.pm == 64) {
                    const float f = r[seg];
                    float* rowp = P + (size_t)(u.ko >> 8) * (NSA * DM) + (size_t)rl * DM + col0;
#pragma unroll
                    for (int bj = 0; bj < 2; ++bj) { *(pg8::f32x4*)(rowp + bj * 128) = acc[ai][bj][m][0] * f; *(pg8::f32x4*)(rowp + bj * 128 + 4) = acc[ai][bj][m][1] * f; }
                } else {
                    const float f = r[2];
                    bf16* rowp = C + (size_t)(u.pm * 256 + rl) * DM + col0;
#pragma unroll
                    for (int bj = 0; bj < 2; ++bj) { const pg8::f32x4 v0 = acc[ai][bj][m][0] * f, v1 = acc[ai][bj][m][1] * f;
                        pg8::u32x4 w; w.x = cvtpk(v0[0], v0[1]); w.y = cvtpk(v0[2], v0[3]); w.z = cvtpk(v1[0], v1[1]); w.w = cvtpk(v1[2], v1[3]);
                        *(pg8::u32x4*)(rowp + bj * 128) = w; }
                }
            }
    }
};
struct EpiInProj {
    static constexpr bool PERM = true, AFTER_DRAIN = false, KHOOK = false;
    bf16 *Q, *CKV, *Z, *XBC; float *GATES, *DT, *out;
    __device__ __forceinline__ void operator()(const pg8::f32x4 (&acc)[2][2][4][2], const pg8::Unit& u, int wr, int wc, int fr, int fq) const {
        const int pn = u.pn;
        const bool samp = (u.pm == 64);
#pragma unroll
        for (int ai = 0; ai < 2; ++ai)
#pragma unroll
            for (int m = 0; m < 4; ++m) {
                const int row = u.pm * 256 + ai * 128 + wr * 64 + m * 16 + fr;
                const int pb = row >> 12, pt = row & 4095;
                const int sr = row - NPR, sb = sr >> 3, st = sr & 7;
#pragma unroll
                for (int bj = 0; bj < 2; ++bj) {
                    const int cb = bj * 128 + wc * 32 + 8 * fq;
                    const pg8::f32x4 v0 = acc[ai][bj][m][0], v1 = acc[ai][bj][m][1];
                    if (pn < 4) {
                        pg8::u32x4 w; w.x = cvtpk(v0[0] * C2, v0[1] * C2); w.y = cvtpk(v0[2] * C2, v0[3] * C2); w.z = cvtpk(v1[0] * C2, v1[1] * C2); w.w = cvtpk(v1[2] * C2, v1[3] * C2);
                        *(pg8::u32x4*)(Q + (size_t)row * DM + pn * 256 + cb) = w;
                    } else if (pn < 10) {
                        const int which = (pn - 4) >> 1, col = ((pn - 4) & 1) * 256 + cb;
                        pg8::u32x4 w; w.x = cvtpk(v0[0], v0[1]); w.y = cvtpk(v0[2], v0[3]); w.z = cvtpk(v1[0], v1[1]); w.w = cvtpk(v1[2], v1[3]);
                        *(pg8::u32x4*)(CKV + (size_t)which * ((WS_SKV - WS_CKV) / 2) + (size_t)row * KVW + col) = w;
                        size_t fo; bool st_ok = true;
                        if (!samp) {
                            if (which < 2) fo = O_PCMP + (size_t)which * (O_PSLC - O_PCMP) + (size_t)row * KVW + col;
                            else { st_ok = (pt >= SEQ - 512); fo = O_PWIN + ((size_t)pb * 512 + (pt - (SEQ - 512))) * KVW + col; }
                        } else {
                            if (which < 2) fo = O_SCMP + (size_t)which * (O_SSLC - O_SCMP) + (size_t)sr * KVW + col;
                            else fo = O_SWIN + ((size_t)sb * 512 + 504 + st) * KVW + col;
                        }
                        if (st_ok) { __builtin_nontemporal_store(v0, (GAS pg8::f32x4*)(out + fo)); __builtin_nontemporal_store(v1, (GAS pg8::f32x4*)(out + fo + 4)); }
                    } else if (pn < 14) {
                        pg8::u32x4 w; w.x = cvtpk(v0[0], v0[1]); w.y = cvtpk(v0[2], v0[3]); w.z = cvtpk(v1[0], v1[1]); w.w = cvtpk(v1[2], v1[3]);
                        *(pg8::u32x4*)(Z + (size_t)row * DM + (pn - 10) * 256 + cb) = w;
                    } else if (pn < 20) {
                        const int col = (pn - 14) * 256 + cb;
                        pg8::u32x4 w; w.x = cvtpk(v0[0], v0[1]); w.y = cvtpk(v0[2], v0[3]); w.z = cvtpk(v1[0], v1[1]); w.w = cvtpk(v1[2], v1[3]);
                        *(pg8::u32x4*)(XBC + (size_t)row * CONVD + col) = w;
                        size_t fo; bool st_ok;
                        if (!samp) { st_ok = (pt >= SEQ - 3); fo = O_PCONV + ((size_t)pb * 3 + (pt - (SEQ - 3))) * CONVD + col; }
                        else { st_ok = (st >= STOK - 3); fo = O_SCONV + ((size_t)sb * 3 + (st - (STOK - 3))) * CONVD + col; }
                        if (st_ok) { __builtin_nontemporal_store(v0, (GAS pg8::f32x4*)(out + fo)); __builtin_nontemporal_store(v1, (GAS pg8::f32x4*)(out + fo + 4)); }
                    } else {
                        if (cb < 48) { float* fo = GATES + (size_t)row * 48 + cb; *(pg8::f32x4*)fo = v0; *(pg8::f32x4*)(fo + 4) = v1; }
                        else if (cb < 64) { float* fo = DT + (size_t)row * 16 + (cb - 48); *(pg8::f32x4*)fo = v0; *(pg8::f32x4*)(fo + 4) = v1; }
                    }
                }
            }
    }
};

template <int MODE> __device__ __forceinline__ int src_col(int n) {
    if (MODE == 0) return ((n >> 7) & 1 ? DFF : 0) + (n >> 8) * 128 + (n & 127);
    if (MODE == 2) {
        if (n < 2560) return n;
        if (n < 3584) return n + 48;
        if (n < 5120) return n + 48;
        if (n < 5168) return n - 2560;
        if (n < 5184) return n;
        return -1;
    }
    return n;
}
template <int MODE> __device__ __forceinline__ void transpose_item64(const float* W, int K, int ldw, bf16* WT, const float* g1, const float* g2, LAS float* scr, int item, int nblk, int lane) {
    const int kb = item / nblk, nb = item % nblk, k0 = 64 * kb, n0 = 64 * nb, kr = lane >> 4, nq = lane & 15;
    const int sc = src_col<MODE>(n0 + 4 * nq);
    f32x4 v[16];
#pragma unroll
    for (int i = 0; i < 16; ++i) v[i] = sc >= 0 ? __builtin_nontemporal_load((const GAS f32x4*)(W + (size_t)(k0 + 4 * i + kr) * ldw + sc)) : (f32x4){0.f, 0.f, 0.f, 0.f};
#pragma unroll
    for (int i = 0; i < 16; ++i) { const int k = 4 * i + kr; f32x4 x = v[i];
        if (MODE == 3) { const int kg = k0 + k; const float gs = (kg < 1024) ? g1[kg] : g2[kg - 1024]; x = x * gs; }
        LAS float* d = scr + k * 65 + 4 * nq; d[0] = x.x; d[1] = x.y; d[2] = x.z; d[3] = x.w; }
    LDS_WAIT(); asm volatile("" ::: "memory");
    const int c = lane & 7;
#pragma unroll
    for (int j = 0; j < 8; ++j) { const int n = (lane >> 3) + 8 * j; const LAS float* s_ = scr + (8 * c) * 65 + n;
        v4u o; o.x = pk2(s_[0 * 65], s_[1 * 65]); o.y = pk2(s_[2 * 65], s_[3 * 65]); o.z = pk2(s_[4 * 65], s_[5 * 65]); o.w = pk2(s_[6 * 65], s_[7 * 65]);
        *(GAS v4u*)(WT + (size_t)(n0 + n) * K + k0 + 8 * c) = o; }
    LDS_WAIT(); asm volatile("" ::: "memory");
}
template <int MODE> __device__ __forceinline__ void transpose_item(const float* W, int K, int ldw, bf16* WT, const float* g1, const float* g2, LAS float* scr, int item, int nblk, int lane) {
    const int kb = item / nblk, nb = item % nblk, k0 = 64 * kb, n0 = 32 * nb;
    const int sc = src_col<MODE>(n0 + (lane & 31));
#pragma unroll 8
    for (int i = 0; i < 32; ++i) { const int kk = 2 * i + (lane >> 5); float v = sc >= 0 ? W[(size_t)(k0 + kk) * ldw + sc] : 0.f;
        if (MODE == 3) { const int k = k0 + kk; v *= (k < 1024) ? g1[k] : g2[k - 1024]; }
        scr[kk * 33 + (lane & 31)] = v; }
    LDS_WAIT(); asm volatile("" ::: "memory");
    const int c = lane & 7;
#pragma unroll
    for (int j = 0; j < 4; ++j) { const int n = (lane >> 3) + 8 * j; const LAS float* s = scr + (8 * c) * 33 + n;
        v4u o; o.x = pk2(s[0 * 33], s[1 * 33]); o.y = pk2(s[2 * 33], s[3 * 33]); o.z = pk2(s[4 * 33], s[5 * 33]); o.w = pk2(s[6 * 33], s[7 * 33]);
        *(GAS v4u*)(WT + (size_t)(n0 + n) * K + k0 + 8 * c) = o; }
    LDS_WAIT(); asm volatile("" ::: "memory");
}
__device__ __forceinline__ void rms_row_to_bf16(const float* xrow, const float* g, bf16* orow, int lane) {
    const GAS f32x4* xr = (const GAS f32x4*)xrow + lane; const GAS f32x4* gr = (const GAS f32x4*)g + lane;
    f32x4 v[4]; float s = 0.f;
#pragma unroll
    for (int j = 0; j < 4; ++j) { v[j] = xr[64 * j]; s += (v[j].x * v[j].x + v[j].y * v[j].y) + (v[j].z * v[j].z + v[j].w * v[j].w); }
    const float rs = 1.0f / sqrtf(wave_sum(s) * (1.f / DM) + EPS);
    GAS unsigned long long* o8 = (GAS unsigned long long*)orow + lane;
#pragma unroll
    for (int j = 0; j < 4; ++j) { const f32x4 gg = gr[64 * j];
        o8[64 * j] = (unsigned long long)pk2(v[j].x * rs * gg.x, v[j].y * rs * gg.y) | ((unsigned long long)pk2(v[j].z * rs * gg.z, v[j].w * rs * gg.w) << 32); }
}
__device__ __forceinline__ void rms_rows4_to_bf16(const float* x0, const float* x1, const float* x2, const float* x3, const float* g, bf16* o0, bf16* o1, bf16* o2, bf16* o3, int lane) {
    const float* xs[4] = {x0, x1, x2, x3}; bf16* os[4] = {o0, o1, o2, o3};
    f32x4 v[4][4];
#pragma unroll
    for (int r = 0; r < 4; ++r) { const GAS f32x4* xr = (const GAS f32x4*)xs[r] + lane;
#pragma unroll
        for (int j = 0; j < 4; ++j) v[r][j] = xr[64 * j]; }
    const GAS f32x4* gr = (const GAS f32x4*)g + lane;
    f32x4 gg[4];
#pragma unroll
    for (int j = 0; j < 4; ++j) gg[j] = gr[64 * j];
#pragma unroll
    for (int r = 0; r < 4; ++r) { float s = 0.f;
#pragma unroll
        for (int j = 0; j < 4; ++j) s += (v[r][j].x * v[r][j].x + v[r][j].y * v[r][j].y) + (v[r][j].z * v[r][j].z + v[r][j].w * v[r][j].w);
        const float rs = 1.0f / sqrtf(wave_sum(s) * (1.f / DM) + EPS);
        GAS unsigned long long* o8 = (GAS unsigned long long*)os[r] + lane;
#pragma unroll
        for (int j = 0; j < 4; ++j)
            o8[64 * j] = (unsigned long long)pk2(v[r][j].x * rs * gg[j].x, v[r][j].y * rs * gg[j].y) | ((unsigned long long)pk2(v[r][j].z * rs * gg[j].z, v[r][j].w * rs * gg[j].w) << 32); }
}
struct RowRegs { f32x4 x[4]; unsigned long long o[4]; };
__device__ __forceinline__ void row_load(RowRegs& r, const float* xin, const bf16* orow, int lane) {
    const GAS f32x4* xr = (const GAS f32x4*)xin + lane; const GAS unsigned long long* ob = (const GAS unsigned long long*)orow + lane;
#pragma unroll
    for (int j = 0; j < 4; ++j) { r.x[j] = xr[64 * j]; r.o[j] = ob[64 * j]; }
}
__device__ __forceinline__ void row_finish(RowRegs& r, const float* gpost, float coef, float* x1row, const float* gpre, bf16* xnrow, int lane, bool wx = true) {
    const GAS f32x4* gp = (const GAS f32x4*)gpost + lane;
    f32x4 o[4]; float s = 0.f;
#pragma unroll
    for (int j = 0; j < 4; ++j) { const unsigned lo = (unsigned)r.o[j], hi = (unsigned)(r.o[j] >> 32);
        o[j] = (f32x4){__uint_as_float(lo << 16), __uint_as_float(lo & 0xffff0000u), __uint_as_float(hi << 16), __uint_as_float(hi & 0xffff0000u)};
        s += (o[j].x * o[j].x + o[j].y * o[j].y) + (o[j].z * o[j].z + o[j].w * o[j].w); }
    const float rs = coef / sqrtf(wave_sum(s) * (1.f / DM) + EPS);
    float s2 = 0.f;
    GAS f32x4* xo = (GAS f32x4*)x1row + lane;
#pragma unroll
    for (int j = 0; j < 4; ++j) { const f32x4 gg = gp[64 * j]; f32x4 x = r.x[j];
        x.x += o[j].x * rs * gg.x; x.y += o[j].y * rs * gg.y; x.z += o[j].z * rs * gg.z; x.w += o[j].w * rs * gg.w;
        if (wx) xo[64 * j] = x;
        r.x[j] = x;
        s2 += (x.x * x.x + x.y * x.y) + (x.z * x.z + x.w * x.w); }
    if (gpre) {
        const float rs2 = 1.0f / sqrtf(wave_sum(s2) * (1.f / DM) + EPS);
        const GAS f32x4* gq = (const GAS f32x4*)gpre + lane;
        GAS unsigned long long* o8 = (GAS unsigned long long*)xnrow + lane;
#pragma unroll
        for (int j = 0; j < 4; ++j) { const f32x4 gg = gq[64 * j]; const f32x4 x = r.x[j];
            o8[64 * j] = (unsigned long long)pk2(x.x * rs2 * gg.x, x.y * rs2 * gg.y) | ((unsigned long long)pk2(x.z * rs2 * gg.z, x.w * rs2 * gg.w) << 32); }
    }
}
struct RowRegs2 { f32x4 x[4]; unsigned long long o1[4], o2[4]; };
__device__ __forceinline__ void row_load2(RowRegs2& r, const float* xin, const bf16* o1row, const bf16* o2row, int lane) {
    const GAS f32x4* xr = (const GAS f32x4*)xin + lane; const GAS unsigned long long* a = (const GAS unsigned long long*)o1row + lane; const GAS unsigned long long* b = (const GAS unsigned long long*)o2row + lane;
#pragma unroll
    for (int j = 0; j < 4; ++j) { r.x[j] = xr[64 * j]; r.o1[j] = a[64 * j]; r.o2[j] = b[64 * j]; }
}
__device__ __forceinline__ void row_finish2(RowRegs2& r, const float* g1, const float* g2, float c2, float* yrow, int lane) {
    f32x4 a[4], b[4]; float s1 = 0.f, s2 = 0.f;
#pragma unroll
    for (int j = 0; j < 4; ++j) { const unsigned l1 = (unsigned)r.o1[j], h1 = (unsigned)(r.o1[j] >> 32), l2 = (unsigned)r.o2[j], h2 = (unsigned)(r.o2[j] >> 32);
        a[j] = (f32x4){__uint_as_float(l1 << 16), __uint_as_float(l1 & 0xffff0000u), __uint_as_float(h1 << 16), __uint_as_float(h1 & 0xffff0000u)};
        b[j] = (f32x4){__uint_as_float(l2 << 16), __uint_as_float(l2 & 0xffff0000u), __uint_as_float(h2 << 16), __uint_as_float(h2 & 0xffff0000u)};
        s1 += (a[j].x * a[j].x + a[j].y * a[j].y) + (a[j].z * a[j].z + a[j].w * a[j].w);
        s2 += (b[j].x * b[j].x + b[j].y * b[j].y) + (b[j].z * b[j].z + b[j].w * b[j].w); }
    const float rs1 = 1.0f / sqrtf(wave_sum(s1) * (1.f / DM) + EPS), rs2 = c2 / sqrtf(wave_sum(s2) * (1.f / DM) + EPS);
    const GAS f32x4* p1 = (const GAS f32x4*)g1 + lane; const GAS f32x4* p2 = (const GAS f32x4*)g2 + lane;
    GAS f32x4* yo = (GAS f32x4*)yrow + lane;
#pragma unroll
    for (int j = 0; j < 4; ++j) { const f32x4 u = p1[64 * j], v = p2[64 * j]; f32x4 x = r.x[j];
        x.x += a[j].x * rs1 * u.x; x.y += a[j].y * rs1 * u.y; x.z += a[j].z * rs1 * u.z; x.w += a[j].w * rs1 * u.w;
        x.x += b[j].x * rs2 * v.x; x.y += b[j].y * rs2 * v.y; x.z += b[j].z * rs2 * v.z; x.w += b[j].w * rs2 * v.w;
        __builtin_nontemporal_store(x, yo + 64 * j); }
}
template <bool OBF> __device__ __forceinline__ void row_post(const float* xin, const void* orow_, int nparts, size_t pstride, const float* gpost, float coef, float* x1row, const float* gpre, bf16* xnrow, int lane) {
    const float* orow = (const float*)orow_;
    const GAS f32x4* xr = (const GAS f32x4*)xin + lane; const GAS f32x4* orr = (const GAS f32x4*)orow + lane; const GAS f32x4* gp = (const GAS f32x4*)gpost + lane;
    f32x4 x[4], o[4]; float s = 0.f;
#pragma unroll
    for (int j = 0; j < 4; ++j) x[j] = xr[64 * j];
    if (OBF) {
        const GAS unsigned long long* ob = (const GAS unsigned long long*)orow_ + lane;
#pragma unroll
        for (int j = 0; j < 4; ++j) { const unsigned long long w = ob[64 * j]; const unsigned lo = (unsigned)w, hi = (unsigned)(w >> 32);
            o[j] = (f32x4){__uint_as_float(lo << 16), __uint_as_float(lo & 0xffff0000u), __uint_as_float(hi << 16), __uint_as_float(hi & 0xffff0000u)}; }
    } else {
#pragma unroll
        for (int j = 0; j < 4; ++j) o[j] = orr[64 * j];
    }
    for (int q = 1; q < nparts; ++q) {
        const GAS f32x4* pr = (const GAS f32x4*)(orow + q * pstride) + lane;
#pragma unroll
        for (int j = 0; j < 4; ++j) o[j] = o[j] + pr[64 * j]; }
#pragma unroll
    for (int j = 0; j < 4; ++j) s += (o[j].x * o[j].x + o[j].y * o[j].y) + (o[j].z * o[j].z + o[j].w * o[j].w);
    const float rs = coef / sqrtf(wave_sum(s) * (1.f / DM) + EPS);
    float s2 = 0.f;
    GAS f32x4* xo = (GAS f32x4*)x1row + lane;
#pragma unroll
    for (int j = 0; j < 4; ++j) { const f32x4 gg = gp[64 * j];
        x[j].x += o[j].x * rs * gg.x; x[j].y += o[j].y * rs * gg.y; x[j].z += o[j].z * rs * gg.z; x[j].w += o[j].w * rs * gg.w;
        xo[64 * j] = x[j];
        s2 += (x[j].x * x[j].x + x[j].y * x[j].y) + (x[j].z * x[j].z + x[j].w * x[j].w); }
    if (gpre) {
        const float rs2 = 1.0f / sqrtf(wave_sum(s2) * (1.f / DM) + EPS);
        const GAS f32x4* gq = (const GAS f32x4*)gpre + lane;
        GAS unsigned long long* o8 = (GAS unsigned long long*)xnrow + lane;
#pragma unroll
        for (int j = 0; j < 4; ++j) { const f32x4 gg = gq[64 * j];
            o8[64 * j] = (unsigned long long)pk2(x[j].x * rs2 * gg.x, x[j].y * rs2 * gg.y) | ((unsigned long long)pk2(x[j].z * rs2 * gg.z, x[j].w * rs2 * gg.w) << 32); }
    }
}

typedef float f32x16 __attribute__((ext_vector_type(16)));
#define MFMA32(a, b, c) __builtin_amdgcn_mfma_f32_32x32x16_bf16((a), (b), (c), 0, 0, 0)
__device__ __forceinline__ int crow(int r, int hi) { return (r & 3) + 8 * (r >> 2) + 4 * hi; }
constexpr int SSTR = 272;
__device__ __forceinline__ float softplus_f(float x) { return x > 20.f ? x : log1pf(__expf(x)); }
__device__ __forceinline__ void wg_sync() { __syncthreads(); }

__device__ __forceinline__ void ssd_chunk_scalars(const float* DTR, const float* dt_bias, const float* a_log, int m0, int h, LAS float* dts, LAS float* css, int wave, int lane) {
    if (wave == 0) {
        const float bias = dt_bias[h], a = -__expf(a_log[h]);
        const float d0 = softplus_f(DTR[(size_t)(m0 + 2 * lane) * 16 + h] + bias), d1 = softplus_f(DTR[(size_t)(m0 + 2 * lane + 1) * 16 + h] + bias);
        const float l0 = d0 * a, l1 = d1 * a;
        float s = l0 + l1;
#pragma unroll
        for (int o = 1; o < 64; o <<= 1) { const float t = __shfl_up(s, o); if (lane >= o) s += t; }
        dts[2 * lane] = d0; dts[2 * lane + 1] = d1; css[2 * lane] = s - l1; css[2 * lane + 1] = s;
    }
}
template <int NCP, bool TR> __device__ __forceinline__ void conv_tile(const bf16* XBC, int m0, bool has_hist, int ch0, const float* conv_w, const float* conv_b,
                                                                     LAS unsigned char* dst, const LAS float* rowscale, int tid_, int toff = 0) {
    const int tid = (tid_ - toff) & (NWAVES * 64 - 1);
    constexpr int NG = NCP / 4;
    for (int task = tid; task < NG * 16; task += NWAVES * 64) {
        const int cg = task % NG, seg = task / NG, ch = ch0 + 8 * cg, l0 = 8 * seg;
        v4u xr[11];
#pragma unroll
        for (int r = 0; r < 11; ++r) {
            const int l = l0 - 3 + r;
            xr[r] = (v4u){0u, 0u, 0u, 0u};
            if (l >= 0 || has_hist) xr[r] = *(const GAS v4u*)(XBC + (size_t)(m0 + l) * CONVD + ch);
        }
        f32x4 w[4][2], bia[2];
#pragma unroll
        for (int k = 0; k < 4; ++k) { w[k][0] = *(const GAS f32x4*)(conv_w + k * CONVD + ch); w[k][1] = *(const GAS f32x4*)(conv_w + k * CONVD + ch + 4); }
        bia[0] = *(const GAS f32x4*)(conv_b + ch); bia[1] = *(const GAS f32x4*)(conv_b + ch + 4);
#define CONV_X(r, c) (((c) & 1) ? __uint_as_float(xr[r][(c) >> 1] & 0xffff0000u) : __uint_as_float(xr[r][(c) >> 1] << 16))
#define CONV_W(k, c) (w[k][(c) >> 2][(c) & 3])
        if (TR) {
#pragma unroll
            for (int c = 0; c < 8; ++c) {
                float y[8];
#pragma unroll
                for (int i = 0; i < 8; ++i) { float s0 = bia[c >> 2][c & 3];
#pragma unroll
                    for (int k = 0; k < 4; ++k) s0 += CONV_W(k, c) * CONV_X(i + k, c);
                    y[i] = silu_f(s0); if (rowscale) y[i] *= rowscale[l0 + i]; }
                v4u o; o.x = pk2(y[0], y[1]); o.y = pk2(y[2], y[3]); o.z = pk2(y[4], y[5]); o.w = pk2(y[6], y[7]);
                *(LAS v4u*)(dst + (8 * cg + c) * SSTR + l0 * 2) = o;
            }
        } else {
#pragma unroll
            for (int i = 0; i < 8; ++i) {
                float y[8];
#pragma unroll
                for (int c = 0; c < 8; ++c) { float s0 = bia[c >> 2][c & 3];
#pragma unroll
                    for (int k = 0; k < 4; ++k) s0 += CONV_W(k, c) * CONV_X(i + k, c);
                    y[c] = silu_f(s0); }
                v4u o; o.x = pk2(y[0], y[1]); o.y = pk2(y[2], y[3]); o.z = pk2(y[4], y[5]); o.w = pk2(y[6], y[7]);
                *(LAS v4u*)(dst + (l0 + i) * SSTR + (8 * cg) * 2) = o;
            }
        }
#undef CONV_X
#undef CONV_W
    }
}

template <int NCP, bool LT, bool GN>
__device__ __forceinline__ void conv_multi(const bf16* XBC, int m0, bool has_hist, int ch0, const float* conv_w, const float* conv_b,
                                           LAS unsigned char* lt, const LAS float* rowscale, unsigned char* gt, unsigned char* gn, int tid_, int toff) {
    const int tid = (tid_ - toff) & (NWAVES * 64 - 1);
    constexpr int NG = NCP / 4;
    for (int task = tid; task < NG * 16; task += NWAVES * 64) {
        const int cg = task % NG, seg = task / NG, ch = ch0 + 8 * cg, l0 = 8 * seg;
        v4u xr[11];
#pragma unroll
        for (int r = 0; r < 11; ++r) {
            const int l = l0 - 3 + r;
            xr[r] = (v4u){0u, 0u, 0u, 0u};
            if (l >= 0 || has_hist) xr[r] = *(const GAS v4u*)(XBC + (size_t)(m0 + l) * CONVD + ch);
        }
        f32x4 w[4][2], bia[2];
#pragma unroll
        for (int k = 0; k < 4; ++k) { w[k][0] = *(const GAS f32x4*)(conv_w + k * CONVD + ch); w[k][1] = *(const GAS f32x4*)(conv_w + k * CONVD + ch + 4); }
        bia[0] = *(const GAS f32x4*)(conv_b + ch); bia[1] = *(const GAS f32x4*)(conv_b + ch + 4);
#define CONV_X(r, c) (((c) & 1) ? __uint_as_float(xr[r][(c) >> 1] & 0xffff0000u) : __uint_as_float(xr[r][(c) >> 1] << 16))
#define CONV_W(k, c) (w[k][(c) >> 2][(c) & 3])
#define CONV_Y(i, c) silu_f(bia[(c) >> 2][(c) & 3] + CONV_W(0, c) * CONV_X((i), c) + CONV_W(1, c) * CONV_X((i) + 1, c) + CONV_W(2, c) * CONV_X((i) + 2, c) + CONV_W(3, c) * CONV_X((i) + 3, c))
        if (!GN) {
#pragma unroll
            for (int c = 0; c < 8; ++c) {
                float y[8];
#pragma unroll
                for (int i = 0; i < 8; ++i) y[i] = CONV_Y(i, c);
                if (gt) { v4u o; o.x = cvtpk(y[0], y[1]); o.y = cvtpk(y[2], y[3]); o.z = cvtpk(y[4], y[5]); o.w = cvtpk(y[6], y[7]);
                    *(GAS v4u*)(gt + (8 * cg + c) * 256 + l0 * 2) = o; }
                if (LT) {
                    if (rowscale) { const LAS float* rsp = rowscale + (cg >> 3) * 128 + l0;
#pragma unroll
                        for (int i = 0; i < 8; ++i) y[i] *= rsp[i]; }
                    v4u o; o.x = cvtpk(y[0], y[1]); o.y = cvtpk(y[2], y[3]); o.z = cvtpk(y[4], y[5]); o.w = cvtpk(y[6], y[7]);
                    *(LAS v4u*)(lt + (8 * cg + c) * SSTR + l0 * 2) = o; }
            }
        } else if (LT) {
            float y[8][8];
#pragma unroll
            for (int c = 0; c < 8; ++c) {
#pragma unroll
                for (int i = 0; i < 8; ++i) y[c][i] = CONV_Y(i, c);
                v4u o; o.x = cvtpk(y[c][0], y[c][1]); o.y = cvtpk(y[c][2], y[c][3]); o.z = cvtpk(y[c][4], y[c][5]); o.w = cvtpk(y[c][6], y[c][7]);
                *(LAS v4u*)(lt + (8 * cg + c) * SSTR + l0 * 2) = o;
            }
            if (gn) {
#pragma unroll
                for (int i = 0; i < 8; ++i) { v4u o; o.x = cvtpk(y[0][i], y[1][i]); o.y = cvtpk(y[2][i], y[3][i]); o.z = cvtpk(y[4][i], y[5][i]); o.w = cvtpk(y[6][i], y[7][i]);
                    *(GAS v4u*)(gn + (l0 + i) * (NCP * 4) + cg * 16) = o; }
            }
        } else {
#pragma unroll
            for (int i = 0; i < 8; ++i) {
                float y[8];
#pragma unroll
                for (int c = 0; c < 8; ++c) y[c] = CONV_Y(i, c);
                v4u o; o.x = cvtpk(y[0], y[1]); o.y = cvtpk(y[2], y[3]); o.z = cvtpk(y[4], y[5]); o.w = cvtpk(y[6], y[7]);
                *(GAS v4u*)(gn + (l0 + i) * (NCP * 4) + cg * 16) = o;
            }
        }
#undef CONV_X
#undef CONV_W
#undef CONV_Y
    }
}

template <int NH>
__device__ __forceinline__ void ssd_a_item(int unit0, const bf16* XBC, const float* DTR, const float* dt_bias, const float* a_log, const float* conv_w, const float* conv_b,
                                           bf16* STB, float* DC, unsigned char* XCV, unsigned char* BCV, unsigned char* CCV, float* SCV, LAS unsigned char* lds, int tid_, int wave, int lane_) {
    asm volatile("; MARK_ssd_a_item_BEGIN" ::: "memory");
    int tid = tid_, lane = lane_; asm volatile("" : "+v"(tid), "+v"(lane));
    const int hf = unit0 & 15, c = (unit0 >> 4) & 31, b = unit0 >> 9, m0 = b * SEQ + c * 128, g = hf >> 3;
    const bool ex = (hf & 7) == 0;
    LAS unsigned char* BT = lds;
    LAS unsigned char* XT = lds + 128 * SSTR;
    LAS float* wsc = (LAS float*)(lds + 384 * SSTR);
    if (wave < NH) {
        const int h = hf + wave;
        const float bias = dt_bias[h], a = -__expf(a_log[h]);
        const float d0 = softplus_f(DTR[(size_t)(m0 + 2 * lane) * 16 + h] + bias), d1 = softplus_f(DTR[(size_t)(m0 + 2 * lane + 1) * 16 + h] + bias);
        const float l0 = d0 * a, l1 = d1 * a;
        float s = l0 + l1;
#pragma unroll
        for (int o = 1; o < 64; o <<= 1) { const float t = __shfl_up(s, o); if (lane >= o) s += t; }
        const float tot = __shfl(s, 63);
        wsc[wave * 128 + 2 * lane] = d0 * __expf(tot - (s - l1)); wsc[wave * 128 + 2 * lane + 1] = d1 * __expf(tot - s);
        float* sc = SCV + (size_t)(unit0 + wave) * 256;
        sc[2 * lane] = d0; sc[2 * lane + 1] = d1; sc[128 + 2 * lane] = s - l1; sc[128 + 2 * lane + 1] = s;
        if (lane == 63) DC[unit0 + wave] = __expf(s);
    }
    wg_sync();
    const size_t grp = (size_t)((b * 32 + c) * 2 + g);
    conv_multi<64, true, true>(XBC, m0, c > 0, 1024 + g * 128, conv_w, conv_b, BT, nullptr, nullptr, ex ? BCV + grp * 32768 : nullptr, tid, 0);
    if (ex) conv_multi<64, false, true>(XBC, m0, c > 0, 1280 + g * 128, conv_w, conv_b, nullptr, nullptr, nullptr, CCV + grp * 32768, tid, 256);
    constexpr int NR = NH < 4 ? NH : 4;
    const int pt = wave >> 2, nt = wave & 3, r32 = lane & 31, h2 = lane >> 5;
#pragma unroll 1
    for (int r = 0; r < (NH + 3) / 4; ++r) {
        if (r) wg_sync();
        conv_multi<32 * NR, true, false>(XBC, m0, c > 0, (hf + 4 * r) * 64, conv_w, conv_b, XT, wsc + 4 * r * 128, XCV + (size_t)(unit0 + 4 * r) * 16384, nullptr, tid, NH == 8 ? 0 : 256);
        wg_sync();
        bf16x8 bfr[8];
#pragma unroll
        for (int ks = 0; ks < 8; ++ks) bfr[ks] = *(const LAS bf16x8*)(BT + (32 * nt + r32) * SSTR + (16 * ks + 8 * h2) * 2);
#pragma unroll
        for (int k = 0; k < NR; ++k) {
            f32x16 acc;
#pragma unroll
            for (int i = 0; i < 16; ++i) acc[i] = 0.f;
#pragma unroll
            for (int ks = 0; ks < 8; ++ks) {
                const bf16x8 a = *(const LAS bf16x8*)(XT + (64 * k + 32 * pt + r32) * SSTR + (16 * ks + 8 * h2) * 2);
                acc = MFMA32(a, bfr[ks], acc);
            }
            bf16* dstp = STB + (size_t)(unit0 + 4 * r + k) * 8192 + 32 * nt + r32;
#pragma unroll
            for (int i = 0; i < 16; ++i) dstp[(32 * pt + crow(i, h2)) * 128] = (bf16)f2bf(acc[i]);
        }
    }
    wg_sync();
}

__device__ __forceinline__ void ssd_a_unit(int unit, const bf16* XBC, const float* DTR, const float* dt_bias, const float* a_log, const float* conv_w, const float* conv_b,
                                           bf16* STB, float* DC, LAS unsigned char* lds, int tid, int wave, int lane) {
    asm volatile("; MARK_ssd_a_unit_BEGIN" ::: "memory");
    const int h = unit & 15, c = (unit >> 4) & 31, b = unit >> 9, m0 = b * SEQ + c * 128, g = h >> 3;
    LAS unsigned char* XT = lds;
    LAS unsigned char* BT = lds + 64 * SSTR;
    LAS float* dts = (LAS float*)(lds + 192 * SSTR);
    LAS float* css = dts + 128;
    LAS float* wsc = css + 128;
    ssd_chunk_scalars(DTR, dt_bias, a_log, m0, h, dts, css, wave, lane);
    wg_sync();
    if (tid < 128) wsc[tid] = dts[tid] * __expf(css[127] - css[tid]);
    if (tid == 0) DC[unit] = __expf(css[127]);
    wg_sync();
    conv_tile<32, true>(XBC, m0, c > 0, h * 64, conv_w, conv_b, XT, wsc, tid, 256);
    conv_tile<64, true>(XBC, m0, c > 0, 1024 + g * 128, conv_w, conv_b, BT, nullptr, tid);
    wg_sync();
    const int pt = wave >> 2, nt = wave & 3, r32 = lane & 31, h2 = lane >> 5;
    f32x16 acc;
#pragma unroll
    for (int i = 0; i < 16; ++i) acc[i] = 0.f;
#pragma unroll
    for (int ks = 0; ks < 8; ++ks) {
        const bf16x8 a = *(const LAS bf16x8*)(XT + (32 * pt + r32) * SSTR + (16 * ks + 8 * h2) * 2);
        const bf16x8 bb = *(const LAS bf16x8*)(BT + (32 * nt + r32) * SSTR + (16 * ks + 8 * h2) * 2);
        acc = MFMA32(a, bb, acc);
    }
    bf16* dstp = STB + (size_t)unit * 8192 + 32 * nt + r32;
#pragma unroll
    for (int i = 0; i < 16; ++i) dstp[(32 * pt + crow(i, h2)) * 128] = (bf16)f2bf(acc[i]);
    wg_sync();
}

__device__ __forceinline__ void ssd_scan(bf16* STB, const float* DC, float* pssm, int gthread, int nthreads) {
    asm volatile("; MARK_ssd_scan_BEGIN" ::: "memory");
    typedef unsigned long long u64s;
    for (int e4 = gthread; e4 < NB * 16 * 2048; e4 += nthreads) {
        const int bh = e4 >> 11, w4 = e4 & 2047, b = bh >> 4, h = bh & 15;
        float hs[4] = {0.f, 0.f, 0.f, 0.f};
        GAS u64s* p = (GAS u64s*)(STB + ((size_t)(b * 32) * 16 + h) * 8192) + w4;
#pragma unroll 16
        for (int c = 0; c < 32; ++c) {
            const u64s st = p[(size_t)c * 16 * 2048];
            const float dc = DC[(b * 32 + c) * 16 + h];
            p[(size_t)c * 16 * 2048] = (u64s)pk2(hs[0], hs[1]) | ((u64s)pk2(hs[2], hs[3]) << 32);
            const unsigned lo = (unsigned)st, hi = (unsigned)(st >> 32);
            hs[0] = hs[0] * dc + __uint_as_float(lo << 16); hs[1] = hs[1] * dc + __uint_as_float(lo & 0xffff0000u);
            hs[2] = hs[2] * dc + __uint_as_float(hi << 16); hs[3] = hs[3] * dc + __uint_as_float(hi & 0xffff0000u);
        }
        *((GAS f32x4*)(pssm + (size_t)bh * 8192) + w4) = (f32x4){hs[0], hs[1], hs[2], hs[3]};
    }
}

__device__ __forceinline__ void ssd_c_unit(int unit, const bf16* XBC, const float* DTR, const float* dt_bias, const float* a_log, const float* conv_w, const float* conv_b,
                                           const float* d_skip, const bf16* STB, const bf16* ZB, bf16* MIX, float* SSQY, LAS unsigned char* lds, int tid, int wave, int lane) {
    asm volatile("; MARK_ssd_c_unit_BEGIN" ::: "memory");
    const int h = unit & 15, c = (unit >> 4) & 31, b = unit >> 9, m0 = b * SEQ + c * 128, g = h >> 3;
    LAS unsigned char* CL = lds;
    LAS unsigned char* BL = lds + 128 * SSTR;
    LAS unsigned char* XT = lds + 256 * SSTR;
    LAS unsigned char* HL = lds + 320 * SSTR;
    LAS float* dts = (LAS float*)(lds + 384 * SSTR);
    LAS float* css = dts + 128;
    LAS float* ssp = css + 128;
    ssd_chunk_scalars(DTR, dt_bias, a_log, m0, h, dts, css, wave, lane);
    conv_tile<64, false>(XBC, m0, c > 0, 1024 + 256 + g * 128, conv_w, conv_b, CL, nullptr, tid);
    conv_tile<64, false>(XBC, m0, c > 0, 1024 + g * 128, conv_w, conv_b, BL, nullptr, tid);
    conv_tile<32, true>(XBC, m0, c > 0, h * 64, conv_w, conv_b, XT, nullptr, tid);
    {
        const GAS v4u* src = (const GAS v4u*)(STB + (size_t)unit * 8192);
#pragma unroll
        for (int j = 0; j < 2; ++j) { const int e8 = tid + 512 * j, p = e8 >> 4, n = (e8 & 15) * 8; *(LAS v4u*)(HL + p * SSTR + n * 2) = src[e8]; }
    }
    wg_sync();
    const int pt = wave >> 2, ls = wave & 3, r32 = lane & 31, h2 = lane >> 5;
    const int l = 32 * ls + r32;
    const float csl = css[l];
    bf16x8 cf[8];
#pragma unroll
    for (int ks = 0; ks < 8; ++ks) cf[ks] = *(const LAS bf16x8*)(CL + l * SSTR + (16 * ks + 8 * h2) * 2);
    f32x16 acc;
#pragma unroll
    for (int i = 0; i < 16; ++i) acc[i] = 0.f;
#pragma unroll
    for (int ks = 0; ks < 8; ++ks) {
        const bf16x8 a = *(const LAS bf16x8*)(HL + (32 * pt + r32) * SSTR + (16 * ks + 8 * h2) * 2);
        acc = MFMA32(a, cf[ks], acc);
    }
    { const float el = __expf(csl);
#pragma unroll
      for (int i = 0; i < 16; ++i) acc[i] *= el; }
    for (int st = 0; st <= ls; ++st) {
        f32x16 mt;
#pragma unroll
        for (int i = 0; i < 16; ++i) mt[i] = 0.f;
#pragma unroll
        for (int ks = 0; ks < 8; ++ks) {
            const bf16x8 a = *(const LAS bf16x8*)(BL + (32 * st + r32) * SSTR + (16 * ks + 8 * h2) * 2);
            mt = MFMA32(a, cf[ks], mt);
        }
        unsigned pk[8];
#pragma unroll
        for (int i = 0; i < 16; i += 2) {
            const int s0 = 32 * st + crow(i, h2), s1 = s0 + 1;
            const float v0 = (l >= s0) ? mt[i] * __expf(csl - css[s0]) * dts[s0] : 0.f;
            const float v1 = (l >= s1) ? mt[i + 1] * __expf(csl - css[s1]) * dts[s1] : 0.f;
            pk[i >> 1] = pk2(v0, v1);
        }
#pragma unroll
        for (int k2 = 0; k2 < 2; ++k2) {
            v4u bw; bw.x = pk[4 * k2]; bw.y = pk[4 * k2 + 1]; bw.z = pk[4 * k2 + 2]; bw.w = pk[4 * k2 + 3];
            const bf16x8 bfrag = __builtin_bit_cast(bf16x8, bw);
            const LAS unsigned char* xp = XT + (32 * pt + r32) * SSTR + (32 * st + 16 * k2 + 4 * h2) * 2;
            const unsigned long long a_lo = *(const LAS unsigned long long*)xp, a_hi = *(const LAS unsigned long long*)(xp + 16);
            typedef unsigned long long u64x2 __attribute__((ext_vector_type(2)));
            u64x2 aw; aw.x = a_lo; aw.y = a_hi;
            acc = MFMA32(__builtin_bit_cast(bf16x8, aw), bfrag, acc);
        }
    }
    const float Dh = d_skip[h];
    const int m = m0 + l;
    float ssq = 0.f;
#pragma unroll
    for (int gq = 0; gq < 4; ++gq) {
        const int p0 = 32 * pt + 8 * gq + 4 * h2;
        const unsigned long long zz = *(const unsigned long long*)(ZB + (size_t)m * DM + h * 64 + p0);
        float y[4];
#pragma unroll
        for (int j = 0; j < 4; ++j) {
            const float xv = bf2f(*(const LAS unsigned short*)(XT + (p0 + j) * SSTR + l * 2));
            const float zv = bf2f((unsigned short)(zz >> (16 * j)));
            y[j] = (acc[4 * gq + j] + Dh * xv) * silu_f(zv);
            ssq += y[j] * y[j];
        }
        *(unsigned long long*)(MIX + (size_t)m * DMIX + 1024 + h * 64 + p0) = (unsigned long long)pk2(y[0], y[1]) | ((unsigned long long)pk2(y[2], y[3]) << 32);
    }
    ssq += __shfl_xor(ssq, 32);
    if (h2 == 0) ssp[pt * 128 + l] = ssq;
    wg_sync();
    if (tid < 128) SSQY[(size_t)(m0 + tid) * 16 + h] = ssp[tid] + ssp[128 + tid];
    wg_sync();
}

#ifdef PROBE_SSDCOARSE
#define PROBE_MASK 0xfffe
#else
#define PROBE_MASK 0xffff
#endif
__device__ __forceinline__ void ssd_sample_unit(int unit, const bf16* XBC, const float* DTR, const float* dt_bias, const float* a_log, const float* conv_w, const float* conv_b,
                                                const float* d_skip, const float* state_ssm, const float* state_conv, const bf16* ZB, bf16* MIX, float* SSQY, float* sssm,
                                                LAS unsigned char* lds, int tid_) {
    asm volatile("; MARK_ssd_sample_unit_BEGIN" ::: "memory");
    int tid = tid_; asm volatile("" : "+v"(tid));
    const int h = unit & 15, b = unit >> 4, g = h >> 3, m0 = NPR + b * 8;
    LAS float* xs = (LAS float*)lds;
    LAS float* Bs = xs + 512;
    LAS float* Cs = Bs + 1024;
    LAS float* cbd = Cs + 1024;
    LAS float* ysq = cbd + 64;
    LAS float* yo = ysq + 512;
    LAS float* dtl = yo + 512;
    LAS float* csl = dtl + 8;
    const int p = tid >> 3, nq = tid & 7;
    const GAS f32x4* hp = (const GAS f32x4*)(state_ssm + ((size_t)(b * 16 + h) * 64 + p) * 128 + nq * 16);
    GAS f32x4* ho = (GAS f32x4*)(sssm + ((size_t)(b * 16 + h) * 64 + p) * 128 + nq * 16);
    f32x4 hv[4];
#pragma unroll
    for (int j = 0; j < 4; ++j) hv[j] = hp[j];
    const unsigned short zraw = ZB[(size_t)(m0 + nq) * DM + h * 64 + p];
    if (tid >= 448 && tid < 456) {
        const int t = tid - 448;
        const float d = softplus_f(DTR[(size_t)(m0 + t) * 16 + h] + dt_bias[h]), a = -__expf(a_log[h]);
        float run = d * a;
#pragma unroll
        for (int o = 1; o < 8; o <<= 1) { const float tmp = __shfl_up(run, o); if (t >= o) run += tmp; }
        dtl[t] = d; csl[t] = run;
    }
    if (tid < 320) {
        const int cc = tid;
        const int ch = cc < 64 ? h * 64 + cc : (cc < 192 ? 1024 + g * 128 + (cc - 64) : 1280 + g * 128 + (cc - 192));
        float xv[11], w[4];
#pragma unroll
        for (int r = 0; r < 3; ++r) xv[r] = state_conv[((size_t)b * 3 + r) * CONVD + ch];
#pragma unroll
        for (int r = 3; r < 11; ++r) xv[r] = bf2f(XBC[(size_t)(m0 + r - 3) * CONVD + ch]);
#pragma unroll
        for (int k = 0; k < 4; ++k) w[k] = conv_w[k * CONVD + ch];
        const float cb = conv_b[ch];
        LAS float* dst = cc < 64 ? xs + cc : (cc < 192 ? Bs + (cc - 64) : Cs + (cc - 192));
        const int dstr = cc < 64 ? 64 : 128;
#pragma unroll
        for (int t = 0; t < 8; ++t) { float s = cb;
#pragma unroll
            for (int k = 0; k < 4; ++k) s += w[k] * xv[t + k];
            dst[t * dstr] = silu_f(s); }
    }
    wg_sync();
    {
        const int pr = tid >> 3, l = pr >> 3, s = pr & 7, part = tid & 7;
        float d = 0.f;
#pragma unroll
        for (int n = 0; n < 16; ++n) d += Cs[l * 128 + part * 16 + n] * Bs[s * 128 + part * 16 + n];
        d += __shfl_xor(d, 1); d += __shfl_xor(d, 2); d += __shfl_xor(d, 4);
        if (part == 0) cbd[l * 8 + s] = (s <= l) ? d * __expf(csl[l] - csl[s]) * dtl[s] : 0.f;
    }
#pragma unroll
    for (int l = 0; l < 8; ++l) { float s = 0.f;
#pragma unroll
        for (int j = 0; j < 4; ++j) { const LAS float* cp = Cs + l * 128 + nq * 16 + 4 * j; s += (hv[j].x * cp[0] + hv[j].y * cp[1]) + (hv[j].z * cp[2] + hv[j].w * cp[3]); }
        s += __shfl_xor(s, 1); s += __shfl_xor(s, 2); s += __shfl_xor(s, 4);
        if (nq == 0) yo[l * 64 + p] = s; }
    { const float c7 = csl[7], e7 = __expf(c7);
#pragma unroll
      for (int j = 0; j < 4; ++j) hv[j] = hv[j] * e7;
#pragma unroll
      for (int l = 0; l < 8; ++l) { const float wl = dtl[l] * __expf(c7 - csl[l]) * xs[l * 64 + p];
#pragma unroll
          for (int j = 0; j < 4; ++j) { const LAS float* bp = Bs + l * 128 + nq * 16 + 4 * j; hv[j].x += wl * bp[0]; hv[j].y += wl * bp[1]; hv[j].z += wl * bp[2]; hv[j].w += wl * bp[3]; } }
#pragma unroll
      for (int j = 0; j < 4; ++j) ho[j] = hv[j]; }
    wg_sync();
    {
        const int l = nq;
        float y = __expf(csl[l]) * yo[l * 64 + p] + d_skip[h] * xs[l * 64 + p];
#pragma unroll
        for (int s = 0; s < 8; ++s) y += cbd[l * 8 + s] * xs[s * 64 + p];
        y *= silu_f(bf2f(zraw));
        MIX[(size_t)(m0 + l) * DMIX + 1024 + h * 64 + p] = (bf16)f2bf(y);
        ysq[l * 64 + p] = y * y;
    }
    wg_sync();
    { const int l = tid >> 6; const float v = wave_sum(ysq[l * 64 + (tid & 63)]); if ((tid & 63) == 0) SSQY[(size_t)(m0 + l) * 16 + h] = v; }
    wg_sync();
}

struct PairRegs { v4u rc[4], rb[4], rx[4], rh[4]; float sv; };
__device__ __forceinline__ void pair_issue(int pu, bool full  , const unsigned char* XCV, const unsigned char* BCV, const unsigned char* CCV, const float* SCV, const bf16* STB, int tid, PairRegs& R) {
    const int hp = pu & 3, g = (pu >> 2) & 1, c = (pu >> 3) & 31, b = pu >> 8, h0 = g * 8 + 2 * hp;
    const size_t grp = (size_t)((b * 32 + c) * 2 + g), unit0 = (size_t)(b * 32 + c) * 16 + h0;
    const GAS v4u* sC = (const GAS v4u*)(CCV + grp * 32768); const GAS v4u* sB = (const GAS v4u*)(BCV + grp * 32768);
    const GAS v4u* sX = (const GAS v4u*)(XCV + unit0 * 16384); const GAS v4u* sH = (const GAS v4u*)(STB + unit0 * 8192);
#pragma unroll
    for (int j = 0; j < 4; ++j) { R.rx[j] = sX[tid + 512 * j]; R.rh[j] = sH[tid + 512 * j]; }
    if (full) {
#pragma unroll
        for (int j = 0; j < 4; ++j) { R.rc[j] = sC[tid + 512 * j]; R.rb[j] = sB[tid + 512 * j]; }
    }
    R.sv = SCV[(unit0 + (tid >> 8)) * 256 + (tid & 255)];
}
__device__ __forceinline__ void ssd_c_pair_run(int pu0, int n, const unsigned char* XCV, const unsigned char* BCV, const unsigned char* CCV, const float* SCV,
                                               const float* d_skip, const bf16* STB, const bf16* ZB, bf16* MIX, float* SSQY, LAS unsigned char* lds, int tid_, int wave, int lane_) {
    asm volatile("; MARK_ssd_c_pair_BEGIN" ::: "memory");
    int tid = tid_, lane = lane_; asm volatile("" : "+v"(tid), "+v"(lane));
    LAS unsigned char* CL = lds;
    LAS unsigned char* BL = lds + 128 * SSTR;
    LAS unsigned char* XT = lds + 256 * SSTR;
    LAS unsigned char* HL = lds + 384 * SSTR;
    LAS float* dts = (LAS float*)(lds + 512 * SSTR);
    LAS float* css = dts + 256;
    LAS float* ssp = css + 256;
    PairRegs R;
    if (n > 0) pair_issue(pu0, true, XCV, BCV, CCV, SCV, STB, tid, R);
#pragma unroll 1
    for (int k = 0; k < n; ++k) {
    const int pu = pu0 + k;
    const int hp = pu & 3, g = (pu >> 2) & 1, c = (pu >> 3) & 31, b = pu >> 8, m0 = b * SEQ + c * 128, h0 = g * 8 + 2 * hp;
    const int hsel = wave >> 2, h = h0 + hsel;
    {
#pragma unroll
        for (int j = 0; j < 4; ++j) { const int e8 = tid + 512 * j, off = (e8 >> 4) * SSTR + (e8 & 15) * 16;
            *(LAS v4u*)(XT + off) = R.rx[j]; *(LAS v4u*)(HL + off) = R.rh[j]; }
        if (k == 0 || hp == 0) {
#pragma unroll
            for (int j = 0; j < 4; ++j) { const int e8 = tid + 512 * j, off = (e8 >> 4) * SSTR + (e8 & 15) * 16;
                *(LAS v4u*)(CL + off) = R.rc[j]; *(LAS v4u*)(BL + off) = R.rb[j]; }
        }
        if ((tid & 255) < 128) dts[(tid >> 8) * 128 + (tid & 127)] = R.sv; else css[(tid >> 8) * 128 + (tid & 127)] = R.sv;
    }
    if (k + 1 < n) pair_issue(pu + 1, ((pu + 1) & 3) == 0, XCV, BCV, CCV, SCV, STB, tid, R);
    wg_sync();
    const int ls = wave & 3, r32 = lane & 31, h2 = lane >> 5;
    const int l = 32 * ls + r32;
    const LAS float* csh = css + hsel * 128; const LAS float* dth = dts + hsel * 128;
    const LAS unsigned char* XTh = XT + hsel * 64 * SSTR; const LAS unsigned char* HLh = HL + hsel * 64 * SSTR;
    const float csl = csh[l];
    bf16x8 cf[8];
#pragma unroll
    for (int ks = 0; ks < 8; ++ks) cf[ks] = *(const LAS bf16x8*)(CL + l * SSTR + (16 * ks + 8 * h2) * 2);
    f32x16 acc0, acc1;
#pragma unroll
    for (int i = 0; i < 16; ++i) { acc0[i] = 0.f; acc1[i] = 0.f; }
#pragma unroll
    for (int ks = 0; ks < 8; ++ks) {
        const bf16x8 a0 = *(const LAS bf16x8*)(HLh + r32 * SSTR + (16 * ks + 8 * h2) * 2);
        const bf16x8 a1 = *(const LAS bf16x8*)(HLh + (32 + r32) * SSTR + (16 * ks + 8 * h2) * 2);
        acc0 = MFMA32(a0, cf[ks], acc0); acc1 = MFMA32(a1, cf[ks], acc1);
    }
    { const float el = __expf(csl);
#pragma unroll
      for (int i = 0; i < 16; ++i) { acc0[i] *= el; acc1[i] *= el; } }
    for (int st = 0; st <= ls; ++st) {
        f32x16 mt;
#pragma unroll
        for (int i = 0; i < 16; ++i) mt[i] = 0.f;
#pragma unroll
        for (int ks = 0; ks < 8; ++ks) {
            const bf16x8 a = *(const LAS bf16x8*)(BL + (32 * st + r32) * SSTR + (16 * ks + 8 * h2) * 2);
            mt = MFMA32(a, cf[ks], mt);
        }
        unsigned pk[8];
#pragma unroll
        for (int i = 0; i < 16; i += 2) {
            const int s0 = 32 * st + crow(i, h2), s1 = s0 + 1;
            const float v0 = (l >= s0) ? mt[i] * __expf(csl - csh[s0]) * dth[s0] : 0.f;
            const float v1 = (l >= s1) ? mt[i + 1] * __expf(csl - csh[s1]) * dth[s1] : 0.f;
            pk[i >> 1] = pk2(v0, v1);
        }
#pragma unroll
        for (int k2 = 0; k2 < 2; ++k2) {
            v4u bw; bw.x = pk[4 * k2]; bw.y = pk[4 * k2 + 1]; bw.z = pk[4 * k2 + 2]; bw.w = pk[4 * k2 + 3];
            const bf16x8 bfrag = __builtin_bit_cast(bf16x8, bw);
            typedef unsigned long long u64x2 __attribute__((ext_vector_type(2)));
            const LAS unsigned char* xp = XTh + r32 * SSTR + (32 * st + 16 * k2 + 4 * h2) * 2;
            u64x2 aw0; aw0.x = *(const LAS unsigned long long*)xp; aw0.y = *(const LAS unsigned long long*)(xp + 16);
            u64x2 aw1; aw1.x = *(const LAS unsigned long long*)(xp + 32 * SSTR); aw1.y = *(const LAS unsigned long long*)(xp + 32 * SSTR + 16);
            acc0 = MFMA32(__builtin_bit_cast(bf16x8, aw0), bfrag, acc0);
            acc1 = MFMA32(__builtin_bit_cast(bf16x8, aw1), bfrag, acc1);
        }
    }
    const float Dh = d_skip[h];
    const int m = m0 + l;
    float ssq = 0.f;
#pragma unroll
    for (int pt = 0; pt < 2; ++pt)
#pragma unroll
        for (int gq = 0; gq < 4; ++gq) {
            const int p0 = 32 * pt + 8 * gq + 4 * h2;
            const unsigned long long zz = *(const unsigned long long*)(ZB + (size_t)m * DM + h * 64 + p0);
            float y[4];
#pragma unroll
            for (int j = 0; j < 4; ++j) {
                const float xv = bf2f(*(const LAS unsigned short*)(XTh + (p0 + j) * SSTR + l * 2));
                const float zv = bf2f((unsigned short)(zz >> (16 * j)));
                const float av = pt == 0 ? acc0[4 * gq + j] : acc1[4 * gq + j];
                y[j] = (av + Dh * xv) * silu_f(zv);
                ssq += y[j] * y[j];
            }
            *(unsigned long long*)(MIX + (size_t)m * DMIX + 1024 + h * 64 + p0) = (unsigned long long)pk2(y[0], y[1]) | ((unsigned long long)pk2(y[2], y[3]) << 32);
        }
    ssq += __shfl_xor(ssq, 32);
    if (h2 == 0) ssp[hsel * 128 + l] = ssq;
    wg_sync();
    if (tid < 256) SSQY[(size_t)(m0 + (tid & 127)) * 16 + h0 + (tid >> 7)] = ssp[tid];
    wg_sync();
    }
}

__device__ const unsigned char BKT[129] = {0, 1, 2, 3, 4, 5, 6, 7, 8, 9, 10, 11, 12, 13, 14, 15, 16, 16, 16, 17, 17, 18, 18, 18, 19, 19, 19, 20, 20, 20, 20, 21, 21, 21, 21, 22, 22, 22, 22, 22, 23, 23, 23, 23, 23, 23, 24, 24, 24, 24, 24, 24, 25, 25, 25, 25, 25, 25, 25, 26, 26, 26, 26, 26, 26, 26, 26, 27, 27, 27, 27, 27, 27, 27, 27, 27, 27, 28, 28, 28, 28, 28, 28, 28, 28, 28, 28, 29, 29, 29, 29, 29, 29, 29, 29, 29, 29, 29, 29, 30, 30, 30, 30, 30, 30, 30, 30, 30, 30, 30, 30, 30, 30, 31, 31, 31, 31, 31, 31, 31, 31, 31, 31, 31, 31, 31, 31, 31, 31};
#define PROBE_KN 1
#ifndef SPLIT_RANK
#define SPLIT_RANK 0
#endif
constexpr int KSTR = 144, VSTR = 144;
__device__ __forceinline__ int vpos(int key) { return (key & ~12) | ((key & 8) >> 1) | ((key & 4) << 1); }
constexpr int TILE_K_BYTES = 64 * KSTR, TILE_BYTES = 64 * KSTR + 64 * VSTR;
constexpr float NEG_BIG = -1.0e30f;
constexpr int LUT_STRIDE = 132;
typedef unsigned long long u64;

struct StageRegs { v4u k; u64 v0, v1; };
__device__ __forceinline__ void stage_issue_bf16(const bf16* base, long row0, int nvalid, int kvh, int tid_, StageRegs& r) {
    int tid = tid_; asm volatile("" : "+v"(tid));
    const int key = tid >> 3, ch = tid & 7, kp = tid >> 4, dq = tid & 15;
    r.k = (v4u){0u, 0u, 0u, 0u}; r.v0 = 0ull; r.v1 = 0ull;
    if (key < nvalid) r.k = *(const GAS v4u*)(base + (size_t)(row0 + key) * KVW + kvh * 128 + ch * 8);
    if (2 * kp < nvalid) r.v0 = *(const GAS u64*)(base + (size_t)(row0 + 2 * kp) * KVW + kvh * 128 + 64 + dq * 4);
    if (2 * kp + 1 < nvalid) r.v1 = *(const GAS u64*)(base + (size_t)(row0 + 2 * kp + 1) * KVW + kvh * 128 + 64 + dq * 4);
}
__device__ __forceinline__ void stage_commit(const StageRegs& r, LAS unsigned char* tb, int tid_) {
    int tid = tid_; asm volatile("" : "+v"(tid));
    const int key = tid >> 3, ch = tid & 7, kp = tid >> 4, dq = tid & 15;
    *(LAS v4u*)(tb + key * KSTR + ch * 16) = r.k;
    const unsigned a0 = (unsigned)r.v0, a1 = (unsigned)(r.v0 >> 32), b0 = (unsigned)r.v1, b1 = (unsigned)(r.v1 >> 32);
    LAS unsigned char* vt = tb + TILE_K_BYTES + (4 * dq) * VSTR + vpos(2 * kp) * 2;
    *(LAS unsigned*)(vt) = (a0 & 0xffffu) | (b0 << 16);
    *(LAS unsigned*)(vt + VSTR) = (a0 >> 16) | (b0 & 0xffff0000u);
    *(LAS unsigned*)(vt + 2 * VSTR) = (a1 & 0xffffu) | (b1 << 16);
    *(LAS unsigned*)(vt + 3 * VSTR) = (a1 >> 16) | (b1 & 0xffff0000u);
}
__device__ __forceinline__ void stage_tile_bf16(const bf16* base, long row0, int nvalid, int kvh, LAS unsigned char* tb, int tid) {
    StageRegs r; stage_issue_bf16(base, row0, nvalid, kvh, tid, r); stage_commit(r, tb, tid);
}
__device__ __forceinline__ void stage_issue_full(const bf16* base, int row0  , int kvh, int tid_, StageRegs& r) {
    int tid = tid_; asm volatile("" : "+v"(tid));
    const GAS unsigned char* ub = (const GAS unsigned char*)(base + (size_t)__builtin_amdgcn_readfirstlane(row0) * KVW + kvh * 128);
    const unsigned offk = (unsigned)(tid >> 3) * (KVW * 2) + (unsigned)(tid & 7) * 16, offv = (unsigned)(tid >> 4) * (4 * KVW) + 128 + (unsigned)(tid & 15) * 8;
    r.k = *(const GAS v4u*)(ub + offk); r.v0 = *(const GAS u64*)(ub + offv); r.v1 = *(const GAS u64*)(ub + offv + KVW * 2);
}
__device__ __forceinline__ void stage_tile_full(const bf16* base, int row0, int kvh, LAS unsigned char* tb, int tid) {
    StageRegs r; stage_issue_full(base, row0, kvh, tid, r); stage_commit(r, tb, tid);
}
struct StageOff { unsigned offk, offv, wk, wv; };
__device__ __forceinline__ StageOff stage_off(int tid) {
    StageOff o; const int key = tid >> 3, ch = tid & 7, kp = tid >> 4, dq = tid & 15;
    o.offk = (unsigned)key * (KVW * 2) + (unsigned)ch * 16; o.offv = (unsigned)kp * (4 * KVW) + 128 + (unsigned)dq * 8;
    o.wk = (unsigned)(key * KSTR + ch * 16); o.wv = (unsigned)(TILE_K_BYTES + (4 * dq) * VSTR + vpos(2 * kp) * 2);
    asm volatile("" : "+v"(o.offk), "+v"(o.offv), "+v"(o.wk), "+v"(o.wv));
    return o;
}
__device__ __forceinline__ void stage_issue_off(const bf16* base, int row0  , int kvh, const StageOff& o, StageRegs& r) {
    const GAS unsigned char* ub = (const GAS unsigned char*)(base + (size_t)__builtin_amdgcn_readfirstlane(row0) * KVW + kvh * 128);
    r.k = *(const GAS v4u*)(ub + o.offk); r.v0 = *(const GAS u64*)(ub + o.offv); r.v1 = *(const GAS u64*)(ub + o.offv + KVW * 2);
}
__device__ __forceinline__ void stage_commit_off(const StageRegs& r, LAS unsigned char* tb, const StageOff& o) {
    *(LAS v4u*)(tb + o.wk) = r.k;
    const unsigned a0 = (unsigned)r.v0, a1 = (unsigned)(r.v0 >> 32), b0 = (unsigned)r.v1, b1 = (unsigned)(r.v1 >> 32);
    LAS unsigned char* vt = tb + o.wv;
    *(LAS unsigned*)(vt) = (a0 & 0xffffu) | (b0 << 16);
    *(LAS unsigned*)(vt + VSTR) = (a0 >> 16) | (b0 & 0xffff0000u);
    *(LAS unsigned*)(vt + 2 * VSTR) = (a1 & 0xffffu) | (b1 << 16);
    *(LAS unsigned*)(vt + 3 * VSTR) = (a1 >> 16) | (b1 & 0xffff0000u);
}
__device__ __forceinline__ void stage_tile_f32(const float* base, long row0, int kvh, LAS unsigned char* tb, int tid) {
    const int key = tid >> 3, ch = tid & 7, kp = tid >> 4, dq = tid & 15;
    const GAS f32x4* kpx = (const GAS f32x4*)(base + (size_t)(row0 + key) * KVW + kvh * 128 + ch * 8);
    const f32x4 k0 = kpx[0], k1 = kpx[1];
    const f32x4 va = *(const GAS f32x4*)(base + (size_t)(row0 + 2 * kp) * KVW + kvh * 128 + 64 + dq * 4);
    const f32x4 vb = *(const GAS f32x4*)(base + (size_t)(row0 + 2 * kp + 1) * KVW + kvh * 128 + 64 + dq * 4);
    v4u o; o.x = pk2(k0.x, k0.y); o.y = pk2(k0.z, k0.w); o.z = pk2(k1.x, k1.y); o.w = pk2(k1.z, k1.w);
    *(LAS v4u*)(tb + key * KSTR + ch * 16) = o;
    LAS unsigned char* vt = tb + TILE_K_BYTES + (4 * dq) * VSTR + vpos(2 * kp) * 2;
    *(LAS unsigned*)(vt) = pk2(va.x, vb.x); *(LAS unsigned*)(vt + VSTR) = pk2(va.y, vb.y); *(LAS unsigned*)(vt + 2 * VSTR) = pk2(va.z, vb.z); *(LAS unsigned*)(vt + 3 * VSTR) = pk2(va.w, vb.w);
}


struct StageRegsF { f32x4 k0, k1, va, vb; };
__device__ __forceinline__ void stage_f32_issue(const float* base, long row0, int kvh, int tid_, StageRegsF& r) {
    int tid = tid_; asm volatile("" : "+v"(tid));
    const int key = tid >> 3, ch = tid & 7, kp = tid >> 4, dq = tid & 15;
    const GAS f32x4* kpx = (const GAS f32x4*)(base + (size_t)(row0 + key) * KVW + kvh * 128 + ch * 8);
    r.k0 = kpx[0]; r.k1 = kpx[1];
    r.va = *(const GAS f32x4*)(base + (size_t)(row0 + 2 * kp) * KVW + kvh * 128 + 64 + dq * 4);
    r.vb = *(const GAS f32x4*)(base + (size_t)(row0 + 2 * kp + 1) * KVW + kvh * 128 + 64 + dq * 4);
}
__device__ __forceinline__ void stage_f32_commit(const StageRegsF& r, LAS unsigned char* tb, int tid_) {
    int tid = tid_; asm volatile("" : "+v"(tid));
    const int key = tid >> 3, ch = tid & 7, kp = tid >> 4, dq = tid & 15;
    v4u o; o.x = pk2(r.k0.x, r.k0.y); o.y = pk2(r.k0.z, r.k0.w); o.z = pk2(r.k1.x, r.k1.y); o.w = pk2(r.k1.z, r.k1.w);
    *(LAS v4u*)(tb + key * KSTR + ch * 16) = o;
    LAS unsigned char* vt = tb + TILE_K_BYTES + (4 * dq) * VSTR + vpos(2 * kp) * 2;
    *(LAS unsigned*)(vt) = pk2(r.va.x, r.vb.x); *(LAS unsigned*)(vt + VSTR) = pk2(r.va.y, r.vb.y); *(LAS unsigned*)(vt + 2 * VSTR) = pk2(r.va.z, r.vb.z); *(LAS unsigned*)(vt + 3 * VSTR) = pk2(r.va.w, r.vb.w);
}

struct StageOffF { unsigned offk, offv, wk, wv; };
__device__ __forceinline__ StageOffF stage_off_f32(int tid) {
    StageOffF o; const int key = tid >> 3, ch = tid & 7, kp = tid >> 4, dq = tid & 15;
    o.offk = (unsigned)key * (KVW * 4) + (unsigned)ch * 32; o.offv = (unsigned)kp * (2 * KVW * 4) + 256 + (unsigned)dq * 16;
    o.wk = (unsigned)(key * KSTR + ch * 16); o.wv = (unsigned)(TILE_K_BYTES + (4 * dq) * VSTR + vpos(2 * kp) * 2);
    asm volatile("" : "+v"(o.offk), "+v"(o.offv), "+v"(o.wk), "+v"(o.wv));
    return o;
}
__device__ __forceinline__ void stage_f32_issue_off(const float* base, int row0  , int kvh, const StageOffF& o, StageRegsF& r) {
    const GAS unsigned char* ub = (const GAS unsigned char*)(base + (size_t)__builtin_amdgcn_readfirstlane(row0) * KVW + kvh * 128);
    r.k0 = __builtin_nontemporal_load((const GAS f32x4*)(ub + o.offk)); r.k1 = __builtin_nontemporal_load((const GAS f32x4*)(ub + o.offk + 16));
    r.va = __builtin_nontemporal_load((const GAS f32x4*)(ub + o.offv)); r.vb = __builtin_nontemporal_load((const GAS f32x4*)(ub + o.offv + KVW * 4));
}
__device__ __forceinline__ void stage_f32_commit_off(const StageRegsF& r, LAS unsigned char* tb, const StageOffF& o) {
    v4u w; w.x = pk2(r.k0.x, r.k0.y); w.y = pk2(r.k0.z, r.k0.w); w.z = pk2(r.k1.x, r.k1.y); w.w = pk2(r.k1.z, r.k1.w);
    *(LAS v4u*)(tb + o.wk) = w;
    LAS unsigned char* vt = tb + o.wv;
    *(LAS unsigned*)(vt) = pk2(r.va.x, r.vb.x); *(LAS unsigned*)(vt + VSTR) = pk2(r.va.y, r.vb.y); *(LAS unsigned*)(vt + 2 * VSTR) = pk2(r.va.z, r.vb.z); *(LAS unsigned*)(vt + 3 * VSTR) = pk2(r.va.w, r.vb.w);
}

__device__ __forceinline__ void split8(const f32x4 a, const f32x4 b, v4u& hi, v4u& lo) {
    const float x[8] = {a.x, a.y, a.z, a.w, b.x, b.y, b.z, b.w}; unsigned h[8], l[8];
#pragma unroll
    for (int i = 0; i < 8; ++i) { h[i] = f2bf(x[i]); l[i] = f2bf(x[i] - __uint_as_float(h[i] << 16)); }
    hi.x = h[0] | (h[1] << 16); hi.y = h[2] | (h[3] << 16); hi.z = h[4] | (h[5] << 16); hi.w = h[6] | (h[7] << 16);
    lo.x = l[0] | (l[1] << 16); lo.y = l[2] | (l[3] << 16); lo.z = l[4] | (l[5] << 16); lo.w = l[6] | (l[7] << 16);
}
__device__ __forceinline__ void stage_k_hilo(const float* base, long row0, int kvh, LAS unsigned char* tb, LAS unsigned char* tb_lo, int tid) {
    const int key = tid >> 3, ch = tid & 7;
    const GAS f32x4* kp = (const GAS f32x4*)(base + ((size_t)(row0 + key) * 4 + kvh) * 64 + ch * 8);
    v4u hi, lo; split8(kp[0], kp[1], hi, lo);
    *(LAS v4u*)(tb + key * KSTR + ch * 16) = hi; *(LAS v4u*)(tb_lo + key * KSTR + ch * 16) = lo;
}

template <int MODE  , bool SPLIT = false>
__device__ __forceinline__ void attn_tile(const LAS unsigned char* tb, const bf16x8 (&qf)[4], float cinit, int qpos, int kpos0, bool sel,
                                          const LAS float* lut, float& m_run, float& l_run, f32x16& o0, f32x16& o1, f32x16& p0, f32x16& p1, int lane,
                                          const LAS unsigned char* tb_lo = nullptr, const bf16x8* qlo = nullptr) {
    constexpr bool NEAR = MODE != 0;
    constexpr int KS = MODE == 3 ? 64 : 1;
    const int r32 = lane & 31, h2 = lane >> 5;
    const float c0 = NEAR ? 0.f : cinit;
#pragma unroll
    for (int i = 0; i < 16; ++i) { p0[i] = c0; p1[i] = c0; }
#pragma unroll
    for (int ks = 0; ks < 4; ++ks) {
        const bf16x8 ka = *(const LAS bf16x8*)(tb + r32 * KSTR + (16 * ks + 8 * h2) * 2);
        const bf16x8 kb = *(const LAS bf16x8*)(tb + (32 + r32) * KSTR + (16 * ks + 8 * h2) * 2);
        p0 = MFMA32(ka, qf[ks], p0); p1 = MFMA32(kb, qf[ks], p1);
        if (SPLIT) {
            const bf16x8 la = *(const LAS bf16x8*)(tb_lo + r32 * KSTR + (16 * ks + 8 * h2) * 2);
            const bf16x8 lb = *(const LAS bf16x8*)(tb_lo + (32 + r32) * KSTR + (16 * ks + 8 * h2) * 2);
            p0 = MFMA32(ka, qlo[ks], p0); p1 = MFMA32(kb, qlo[ks], p1);
            p0 = MFMA32(la, qf[ks], p0); p1 = MFMA32(lb, qf[ks], p1);
        }
    }
    if (NEAR) {
        int base = sel ? qpos - kpos0 - KS * 4 * h2 : -0x20000000;
        asm volatile("" : "+v"(base));
#pragma unroll
        for (int i = 0; i < 16; ++i) {
            const int d0 = base - KS * ((i & 3) + 8 * (i >> 2)), d1 = d0 - 32 * KS;
            const bool ok0 = MODE == 2 ? ((unsigned)d0 < 512u) : (d0 >= 0), ok1 = MODE == 2 ? ((unsigned)d1 < 512u) : (d1 >= 0);
            const float b0 = lut[min(max(d0, 0), 128)], b1 = lut[min(max(d1, 0), 128)];
            p0[i] = ok0 ? p0[i] + b0 : -INFINITY; p1[i] = ok1 ? p1[i] + b1 : -INFINITY;
        }
    }
    float mx = fmaxf(p0[0], p1[0]);
#pragma unroll
    for (int i = 1; i < 16; ++i) mx = fmaxf(mx, fmaxf(p0[i], p1[i]));
    mx = fmaxf(mx, __shfl_xor(mx, 32));
    const float m_new = fmaxf(m_run, mx), alpha = fast_exp2(m_run - m_new);
    m_run = m_new;
    float rs = 0.f;
#pragma unroll
    for (int i = 0; i < 16; ++i) { p0[i] = fast_exp2(p0[i] - m_new); p1[i] = fast_exp2(p1[i] - m_new); rs += p0[i] + p1[i]; }
    l_run = l_run * alpha + rs;
#pragma unroll
    for (int i = 0; i < 16; ++i) { o0[i] *= alpha; o1[i] *= alpha; }
#pragma unroll
    for (int kt = 0; kt < 2; ++kt)
#pragma unroll
        for (int k2 = 0; k2 < 2; ++k2) {
            v4u bw;
            if (kt == 0) { bw.x = cvtpk(p0[8 * k2], p0[8 * k2 + 1]); bw.y = cvtpk(p0[8 * k2 + 2], p0[8 * k2 + 3]); bw.z = cvtpk(p0[8 * k2 + 4], p0[8 * k2 + 5]); bw.w = cvtpk(p0[8 * k2 + 6], p0[8 * k2 + 7]); }
            else         { bw.x = cvtpk(p1[8 * k2], p1[8 * k2 + 1]); bw.y = cvtpk(p1[8 * k2 + 2], p1[8 * k2 + 3]); bw.z = cvtpk(p1[8 * k2 + 4], p1[8 * k2 + 5]); bw.w = cvtpk(p1[8 * k2 + 6], p1[8 * k2 + 7]); }
            const bf16x8 pb = __builtin_bit_cast(bf16x8, bw);
            typedef u64 u64x2 __attribute__((ext_vector_type(2)));
            const LAS unsigned char* vp = tb + TILE_K_BYTES + r32 * VSTR + (32 * kt + 16 * k2 + 8 * h2) * 2;
            const bf16x8 a0 = *(const LAS bf16x8*)vp, a1 = *(const LAS bf16x8*)(vp + 32 * VSTR);
            o0 = MFMA32(a0, pb, o0);
            o1 = MFMA32(a1, pb, o1);
        }
}

template <int MODE>
__device__ __forceinline__ void attn_tile_fixed(const LAS unsigned char* tb, const bf16x8 (&qf)[4], float cinit, int qpos, int kpos0, bool sel,
                                                const LAS float* lut, float mq, float& l_run, f32x16& o0, f32x16& o1, int lane_, unsigned loff) {
    constexpr bool NEAR = MODE != 0;
    int lane = lane_; asm volatile("" : "+v"(lane));
    const int h2 = lane >> 5;
    const LAS unsigned char* tl = tb + loff;
    const float c0 = NEAR ? -mq : cinit;
    f32x16 p0, p1;
#pragma unroll
    for (int i = 0; i < 16; ++i) { p0[i] = c0; p1[i] = c0; }
    {
        bf16x8 kf[8];
#pragma unroll
        for (int ks = 0; ks < 4; ++ks) { kf[2 * ks] = *(const LAS bf16x8*)(tl + 32 * ks); kf[2 * ks + 1] = *(const LAS bf16x8*)(tl + 32 * KSTR + 32 * ks); }
        asm volatile("s_waitcnt lgkmcnt(0)" ::: "memory");
#pragma unroll
        for (int ks = 0; ks < 4; ++ks) { p0 = MFMA32(kf[2 * ks], qf[ks], p0); p1 = MFMA32(kf[2 * ks + 1], qf[ks], p1); }
    }
    if (NEAR) {
        int base = sel ? qpos - kpos0 - 4 * h2 : -0x20000000;
        asm volatile("" : "+v"(base));
#pragma unroll
        for (int i = 0; i < 16; ++i) {
            const int d0 = base - ((i & 3) + 8 * (i >> 2)), d1 = d0 - 32;
            const bool ok0 = MODE == 2 ? ((unsigned)d0 < 512u) : (d0 >= 0), ok1 = MODE == 2 ? ((unsigned)d1 < 512u) : (d1 >= 0);
            const float b0 = lut[min(max(d0, 0), 128)], b1 = lut[min(max(d1, 0), 128)];
            p0[i] = ok0 ? p0[i] + b0 : -INFINITY; p1[i] = ok1 ? p1[i] + b1 : -INFINITY;
        }
    }
    float rs = 0.f;
#pragma unroll
    for (int i = 0; i < 16; ++i) { p0[i] = fast_exp2(p0[i]); p1[i] = fast_exp2(p1[i]); rs += p0[i] + p1[i]; }
    l_run += rs;
    {
        typedef u64 u64x2 __attribute__((ext_vector_type(2)));
        bf16x8 va[4], vb[4];
#pragma unroll
        for (int q = 0; q < 4; ++q) { const LAS unsigned char* vp = tl + TILE_K_BYTES + 32 * q;
            va[q] = *(const LAS bf16x8*)vp; vb[q] = *(const LAS bf16x8*)(vp + 32 * VSTR); }
        bf16x8 pb[4];
#pragma unroll
        for (int q = 0; q < 4; ++q) { v4u bw;
            if (q < 2) { bw.x = cvtpk(p0[8 * q], p0[8 * q + 1]); bw.y = cvtpk(p0[8 * q + 2], p0[8 * q + 3]); bw.z = cvtpk(p0[8 * q + 4], p0[8 * q + 5]); bw.w = cvtpk(p0[8 * q + 6], p0[8 * q + 7]); }
            else { const int k2 = q - 2; bw.x = cvtpk(p1[8 * k2], p1[8 * k2 + 1]); bw.y = cvtpk(p1[8 * k2 + 2], p1[8 * k2 + 3]); bw.z = cvtpk(p1[8 * k2 + 4], p1[8 * k2 + 5]); bw.w = cvtpk(p1[8 * k2 + 6], p1[8 * k2 + 7]); }
            pb[q] = __builtin_bit_cast(bf16x8, bw); }
        asm volatile("s_waitcnt lgkmcnt(0)" ::: "memory");
#pragma unroll
        for (int q = 0; q < 4; ++q) { o0 = MFMA32(va[q], pb[q], o0); o1 = MFMA32(vb[q], pb[q], o1); }
    }
}

#define APIN(x) asm volatile("" : "+v"(x))
#define ASB() __builtin_amdgcn_sched_barrier(0)
__device__ __forceinline__ void attn_far_first(const LAS unsigned char* buf, const bf16x8 (&qf)[4], f32x16& C0, f32x16& C1, float cin, unsigned loff) {
    const LAS unsigned char* kp = buf + loff;
    f32x16 Zc;
#pragma unroll
    for (int i = 0; i < 16; ++i) Zc[i] = cin;
#pragma unroll
    for (int ks = 0; ks < 4; ++ks) {
        const bf16x8 ka = *(const LAS bf16x8*)(kp + 32 * ks), kb = *(const LAS bf16x8*)(kp + 32 * KSTR + 32 * ks);
        C0 = MFMA32(ka, qf[ks], ks == 0 ? Zc : C0); C1 = MFMA32(kb, qf[ks], ks == 0 ? Zc : C1); }
#pragma unroll
    for (int i = 0; i < 16; ++i) { C0[i] = fast_exp2(C0[i]); C1[i] = fast_exp2(C1[i]); }
}
__device__ __forceinline__ void attn_far_step(const LAS unsigned char* bufK, const LAS unsigned char* bufV, const bf16x8 (&qf)[4],
                                              f32x16& C0, f32x16& C1, f32x16& P0, f32x16& P1, float cin, float& l_run, f32x16& o0, f32x16& o1, unsigned loff) {
    const LAS unsigned char* vp = bufV + TILE_K_BYTES + loff;
    const LAS unsigned char* kp = bufK + loff;
#define KFR_(i) (*(const LAS bf16x8*)(kp + 32 * ((i) >> 1) + ((i) & 1) * 32 * KSTR))
#define VFR_(i) (*(const LAS bf16x8*)(vp + 32 * ((i) >> 1) + ((i) & 1) * 32 * VSTR))
    bf16x8 k0, k1, k2, k3, k4, k5, k6, k7, v0, v1, v2, v3, v4, v5, v6, v7; v4u pw0, pw1, pw2, pw3;
    typedef u64 u64x8 __attribute__((ext_vector_type(8)));
    const u64 c2 = ((u64)__float_as_uint(cin) << 32) | (u64)__float_as_uint(cin);
    const u64x8 z8 = {c2, c2, c2, c2, c2, c2, c2, c2};
    const f32x16 Z = __builtin_bit_cast(f32x16, z8);
    ASB();
    k0 = KFR_(0); k1 = KFR_(1); k2 = KFR_(2); ASB();
    float sacc = P0[0] + P0[1];
#define GAPA_(RD, MF, a0, a1, a2, a3, WA, EA, WB, EB) do { RD; ASB(); MF; sacc += a0; sacc += a1; sacc += a2; sacc += a3; WA = EA; WB = EB; APIN(WA); APIN(WB); APIN(sacc); ASB(); } while (0)
    unsigned w00, w01, w02, w03, w10, w11, w12, w13, w20, w21, w22, w23, w30, w31, w32, w33;
    GAPA_(k3 = KFR_(3), C0 = MFMA32(k0, qf[0], Z),  P0[2], P0[3], P0[4], P0[5],     w00, cvtpk(P0[0], P0[1]),   w01, cvtpk(P0[2], P0[3]));
    GAPA_(k4 = KFR_(4), C1 = MFMA32(k1, qf[0], Z),  P0[6], P0[7], P0[8], P0[9],     w02, cvtpk(P0[4], P0[5]),   w03, cvtpk(P0[6], P0[7]));
    GAPA_(k5 = KFR_(5), C0 = MFMA32(k2, qf[1], C0), P0[10], P0[11], P0[12], P0[13], w10, cvtpk(P0[8], P0[9]),   w11, cvtpk(P0[10], P0[11]));
    GAPA_(k6 = KFR_(6), C1 = MFMA32(k3, qf[1], C1), P0[14], P0[15], P1[0], P1[1],   w12, cvtpk(P0[12], P0[13]), w13, cvtpk(P0[14], P0[15]));
    GAPA_(k7 = KFR_(7), C0 = MFMA32(k4, qf[2], C0), P1[2], P1[3], P1[4], P1[5],     w20, cvtpk(P1[0], P1[1]),   w21, cvtpk(P1[2], P1[3]));
    GAPA_(v0 = VFR_(0), C1 = MFMA32(k5, qf[2], C1), P1[6], P1[7], P1[8], P1[9],     w22, cvtpk(P1[4], P1[5]),   w23, cvtpk(P1[6], P1[7]));
    GAPA_(v1 = VFR_(1), C0 = MFMA32(k6, qf[3], C0), P1[10], P1[11], P1[12], P1[13], w30, cvtpk(P1[8], P1[9]),   w31, cvtpk(P1[10], P1[11]));
    GAPA_(v2 = VFR_(2), C1 = MFMA32(k7, qf[3], C1), P1[14], P1[15], 0.f, 0.f,       w32, cvtpk(P1[12], P1[13]), w33, cvtpk(P1[14], P1[15]));
    l_run += sacc;
    pw0 = (v4u){w00, w01, w02, w03}; pw1 = (v4u){w10, w11, w12, w13}; pw2 = (v4u){w20, w21, w22, w23}; pw3 = (v4u){w30, w31, w32, w33};
    const bf16x8 pb0 = __builtin_bit_cast(bf16x8, pw0), pb1 = __builtin_bit_cast(bf16x8, pw1), pb2 = __builtin_bit_cast(bf16x8, pw2), pb3 = __builtin_bit_cast(bf16x8, pw3);
#define EX_(v) fast_exp2(v)
#define GAPB_(RD, MF, X, i) do { RD; ASB(); MF; X[i] = EX_(X[i]); X[i + 1] = EX_(X[i + 1]); X[i + 2] = EX_(X[i + 2]); X[i + 3] = EX_(X[i + 3]); APIN(X); ASB(); } while (0)
    GAPB_(v3 = VFR_(3), o0 = MFMA32(v0, pb0, o0), C0, 0);
    GAPB_(v4 = VFR_(4), o1 = MFMA32(v1, pb0, o1), C0, 4);
    GAPB_(v5 = VFR_(5), o0 = MFMA32(v2, pb1, o0), C0, 8);
    GAPB_(v6 = VFR_(6), o1 = MFMA32(v3, pb1, o1), C0, 12);
    GAPB_(v7 = VFR_(7), o0 = MFMA32(v4, pb2, o0), C1, 0);
    GAPB_((void)0,      o1 = MFMA32(v5, pb2, o1), C1, 4);
    GAPB_((void)0,      o0 = MFMA32(v6, pb3, o0), C1, 8);
    GAPB_((void)0,      o1 = MFMA32(v7, pb3, o1), C1, 12);
#undef KFR_
#undef VFR_
#undef GAPA_
#undef EX_
#undef GAPB_
}
__device__ __forceinline__ void attn_far_drain(const LAS unsigned char* bufV, const f32x16& P0, const f32x16& P1, float& l_run, f32x16& o0, f32x16& o1, unsigned loff) {
    const LAS unsigned char* vp = bufV + TILE_K_BYTES + loff;
    float sacc = 0.f;
#pragma unroll
    for (int i = 0; i < 16; ++i) sacc += P0[i] + P1[i];
    l_run += sacc;
#pragma unroll
    for (int q = 0; q < 4; ++q) {
        const bf16x8 va = *(const LAS bf16x8*)(vp + 32 * q), vb = *(const LAS bf16x8*)(vp + 32 * VSTR + 32 * q);
        v4u bw;
        if (q < 2) { bw.x = cvtpk(P0[8 * q], P0[8 * q + 1]); bw.y = cvtpk(P0[8 * q + 2], P0[8 * q + 3]); bw.z = cvtpk(P0[8 * q + 4], P0[8 * q + 5]); bw.w = cvtpk(P0[8 * q + 6], P0[8 * q + 7]); }
        else { const int k2 = q - 2; bw.x = cvtpk(P1[8 * k2], P1[8 * k2 + 1]); bw.y = cvtpk(P1[8 * k2 + 2], P1[8 * k2 + 3]); bw.z = cvtpk(P1[8 * k2 + 4], P1[8 * k2 + 5]); bw.w = cvtpk(P1[8 * k2 + 6], P1[8 * k2 + 7]); }
        const bf16x8 pb = __builtin_bit_cast(bf16x8, bw);
        o0 = MFMA32(va, pb, o0); o1 = MFMA32(vb, pb, o1);
    }
}

template <bool F32SRC, int NRT>
__device__ __forceinline__ void compress_unit(const void* src, const int* pt, long token0, int blk0, const bf16* WCF, const bf16* WCFL, const float* PEB, bf16* dst  ,
                                              float* dst32  , LAS unsigned char* lds, int tid_, int wave, int lane_) {
    asm volatile("; MARK_compress_unit_BEGIN" ::: "memory");
    int tid = tid_, lane = lane_; asm volatile("" : "+v"(tid), "+v"(lane));
    const int r32 = lane & 31, h2 = lane >> 5;
    LAS float* red = (LAS float*)lds;
    LAS float* pebs = (LAS float*)(lds + 98304);
    if (tid < 128) { float sp = 0.f;
#pragma unroll
        for (int k = 0; k < 16; ++k) sp += PEB[k * 128 + tid];
        pebs[tid] = sp; }
    for (int c = 0; c < 2; ++c) {
        f32x16 acc[NRT][2];
#pragma unroll
        for (int a = 0; a < NRT; ++a)
#pragma unroll
            for (int e = 0; e < 2; ++e)
#pragma unroll
                for (int i = 0; i < 16; ++i) acc[a][e][i] = 0.f;
#pragma unroll 4
        for (int li = 0; li < 8; ++li) {
            const int lp = 8 * wave + li;
#pragma unroll
            for (int rt = 0; rt < NRT; ++rt) {
                const int nl = 8 * rt + (r32 >> 2), kvh = r32 & 3, blk = blk0 + nl;
                bf16x8 af[4], al[4];
                if (F32SRC) {
                    const int page = pt[blk >> 1];
                    const GAS f32x4* p = (const GAS f32x4*)((const float*)src + (((size_t)page * 128 + (blk & 1) * 64 + lp) * 4 + kvh) * 128 + c * 64 + 16 * h2);
#pragma unroll
                    for (int uu = 0; uu < 2; ++uu) { const f32x4 x0 = p[8 * uu], x1 = p[8 * uu + 1], x2 = p[8 * uu + 2], x3 = p[8 * uu + 3];
                        v4u w0, w1, l0, l1; split8(x0, x1, w0, l0); split8(x2, x3, w1, l1);
                        af[2 * uu] = __builtin_bit_cast(bf16x8, w0); af[2 * uu + 1] = __builtin_bit_cast(bf16x8, w1);
                        al[2 * uu] = __builtin_bit_cast(bf16x8, l0); al[2 * uu + 1] = __builtin_bit_cast(bf16x8, l1); }
                } else {
                    const GAS v4u* p = (const GAS v4u*)((const bf16*)src + ((size_t)(token0 + (size_t)blk * 64 + lp) * 4 + kvh) * 128 + c * 64 + 16 * h2);
#pragma unroll
                    for (int uu = 0; uu < 2; ++uu) { af[2 * uu] = __builtin_bit_cast(bf16x8, p[4 * uu]); af[2 * uu + 1] = __builtin_bit_cast(bf16x8, p[4 * uu + 1]); }
                }
#pragma unroll
                for (int kk = 0; kk < 4; ++kk) {
                    const int ks = lp * 4 + kk;
                    const GAS v4u* wp = (const GAS v4u*)(WCF + ((((size_t)c * 256 + ks) * 2) * 64 + lane) * 8);
                    const bf16x8 w0 = __builtin_bit_cast(bf16x8, wp[0]), w1 = __builtin_bit_cast(bf16x8, wp[64]);
                    acc[rt][0] = MFMA32(af[kk], w0, acc[rt][0]); acc[rt][1] = MFMA32(af[kk], w1, acc[rt][1]);
                    if (SPLIT_RANK && F32SRC && c == 0) {
                        const GAS v4u* wl = (const GAS v4u*)(WCFL + (((size_t)ks * 2) * 64 + lane) * 8);
                        const bf16x8 v0 = __builtin_bit_cast(bf16x8, wl[0]), v1 = __builtin_bit_cast(bf16x8, wl[64]);
                        acc[rt][0] = MFMA32(af[kk], v0, acc[rt][0]); acc[rt][1] = MFMA32(af[kk], v1, acc[rt][1]);
                        acc[rt][0] = MFMA32(al[kk], w0, acc[rt][0]); acc[rt][1] = MFMA32(al[kk], w1, acc[rt][1]);
                    }
                }
            }
        }
        wg_sync();
        LAS float* my = red + (wave & 3) * (NRT * 2048);
        if (wave < 4) {
#pragma unroll
            for (int rt = 0; rt < NRT; ++rt)
#pragma unroll
                for (int e = 0; e < 2; ++e)
#pragma unroll
                    for (int i = 0; i < 16; ++i) my[(32 * rt + crow(i, h2)) * 64 + 32 * e + r32] = acc[rt][e][i];
        }
        wg_sync();
        if (wave >= 4) {
#pragma unroll
            for (int rt = 0; rt < NRT; ++rt)
#pragma unroll
                for (int e = 0; e < 2; ++e)
#pragma unroll
                    for (int i = 0; i < 16; ++i) my[(32 * rt + crow(i, h2)) * 64 + 32 * e + r32] += acc[rt][e][i];
        }
        wg_sync();
        for (int idx = tid; idx < NRT * 2048; idx += NWAVES * 64) {
            const int row = idx >> 6, e = idx & 63, nl = row >> 2, kvh = row & 3;
            const float v = (red[idx] + red[NRT * 2048 + idx]) + (red[2 * NRT * 2048 + idx] + red[3 * NRT * 2048 + idx]) + pebs[c * 64 + e];
            dst[(((size_t)nl * 4 + kvh) * 2 + c) * 64 + e] = (bf16)f2bf(v);
            if (SPLIT_RANK && F32SRC && c == 0) dst32[((size_t)nl * 4 + kvh) * 64 + e] = v;
        }
    }
    wg_sync();
}

template <bool BF>
__device__ __forceinline__ void compress_sample_unit(const void* src_, const int* pt, int blk0, const bf16* WCF, const float* PEB, bf16* dst  ,
                                                     LAS unsigned char* lds, int tid_, int wave, int lane_) {
    const float* src = (const float*)src_;
    asm volatile("; MARK_compress_sample_BEGIN" ::: "memory");
    int tid = tid_, lane = lane_; asm volatile("" : "+v"(tid), "+v"(lane));
    constexpr int RSTR = 272;
    const int r32 = lane & 31, h2 = lane >> 5;
    LAS unsigned char* my = lds + wave * (32 * RSTR);
    LAS float* red = (LAS float*)lds;
    LAS float* pebs = (LAS float*)(lds + 98304);
    if (tid < 128) { float sp = 0.f;
#pragma unroll
        for (int k = 0; k < 16; ++k) sp += PEB[k * 128 + tid];
        pebs[tid] = sp; }
    int pg0 = 0, pg1 = 0, pg2 = 0, pg3 = 0;
    if (!BF) { pg0 = pt[(blk0 >> 1)]; pg1 = pt[(blk0 >> 1) + 1]; pg2 = pt[(blk0 >> 1) + 2]; pg3 = pt[(blk0 >> 1) + 3]; }
    const bf16* sb = (const bf16*)src_ + (size_t)blk0 * (64 * 512) + lane * 8;
    const float* rb0 = src + (size_t)pg0 * (128 * 512) + lane * 4; const float* rb1 = src + (size_t)pg1 * (128 * 512) + lane * 4;
    const float* rb2 = src + (size_t)pg2 * (128 * 512) + lane * 4; const float* rb3 = src + (size_t)pg3 * (128 * 512) + lane * 4;
    f32x16 acc00, acc01, acc10, acc11;
#pragma unroll
    for (int i = 0; i < 16; ++i) { acc00[i] = 0.f; acc01[i] = 0.f; acc10[i] = 0.f; acc11[i] = 0.f; }
    f32x4 st[16];
#define CS_ISSUE(lp) do { if (BF) { _Pragma("unroll") for (int q = 0; q < 8; ++q) st[q] = __builtin_bit_cast(f32x4, *(const GAS v4u*)(sb + (size_t)(q * 64 + (lp)) * 512)); } \
    else { _Pragma("unroll") for (int q = 0; q < 16; ++q) { const int bl = q >> 1; const float* rb = (bl >> 1) == 0 ? rb0 : ((bl >> 1) == 1 ? rb1 : ((bl >> 1) == 2 ? rb2 : rb3)); \
        st[q] = __builtin_nontemporal_load((const GAS f32x4*)(rb + (size_t)((bl & 1) * 64 + (lp)) * 512 + (q & 1) * 256)); } } } while (0)
    CS_ISSUE(8 * wave);
#pragma unroll 1
    for (int i = 0; i < 8; ++i) {
        const int lp = 8 * wave + i;
        v4u wf[16];
#pragma unroll
        for (int c = 0; c < 2; ++c)
#pragma unroll
            for (int kk = 0; kk < 4; ++kk) { const GAS v4u* wp = (const GAS v4u*)(WCF + ((((size_t)c * 256 + lp * 4 + kk) * 2) * 64 + lane) * 8);
                wf[(c * 4 + kk) * 2] = wp[0]; wf[(c * 4 + kk) * 2 + 1] = wp[64]; }
        if (BF) {
#pragma unroll
            for (int q = 0; q < 8; ++q) *(LAS v4u*)(my + (q * 4 + (lane >> 4)) * RSTR + (lane & 15) * 16) = __builtin_bit_cast(v4u, st[q]);
        } else
#pragma unroll
        for (int q = 0; q < 16; ++q) {
            const f32x4 x = st[q];
            typedef unsigned u32x2 __attribute__((ext_vector_type(2)));
            u32x2 o; o.x = cvtpk(x.x, x.y); o.y = cvtpk(x.z, x.w);
            *(LAS u32x2*)(my + ((q >> 1) * 4 + (q & 1) * 2 + h2) * RSTR + r32 * 8) = o;
        }
        if (i < 7) CS_ISSUE(lp + 1);
#pragma unroll
        for (int kk = 0; kk < 4; ++kk) {
            const LAS unsigned char* ap = my + r32 * RSTR + (32 * (kk >> 1) + 16 * h2 + 8 * (kk & 1)) * 2;
            const bf16x8 a0 = *(const LAS bf16x8*)ap, a1 = *(const LAS bf16x8*)(ap + 128);
            acc00 = MFMA32(a0, __builtin_bit_cast(bf16x8, wf[kk * 2]), acc00); acc01 = MFMA32(a0, __builtin_bit_cast(bf16x8, wf[kk * 2 + 1]), acc01);
            acc10 = MFMA32(a1, __builtin_bit_cast(bf16x8, wf[(4 + kk) * 2]), acc10); acc11 = MFMA32(a1, __builtin_bit_cast(bf16x8, wf[(4 + kk) * 2 + 1]), acc11);
        }
    }
#undef CS_ISSUE
#pragma unroll
    for (int c = 0; c < 2; ++c) {
        wg_sync();
        LAS float* mys = red + (wave & 3) * 2048;
        if (wave < 4) {
#pragma unroll
            for (int i = 0; i < 16; ++i) { mys[crow(i, h2) * 64 + r32] = c == 0 ? acc00[i] : acc10[i]; mys[crow(i, h2) * 64 + 32 + r32] = c == 0 ? acc01[i] : acc11[i]; }
        }
        wg_sync();
        if (wave >= 4) {
#pragma unroll
            for (int i = 0; i < 16; ++i) { mys[crow(i, h2) * 64 + r32] += c == 0 ? acc00[i] : acc10[i]; mys[crow(i, h2) * 64 + 32 + r32] += c == 0 ? acc01[i] : acc11[i]; }
        }
        wg_sync();
        for (int idx = tid; idx < 2048; idx += NWAVES * 64) {
            const int row = idx >> 6, e = idx & 63, nl = row >> 2, kvh = row & 3;
            const float v = (red[idx] + red[2048 + idx]) + (red[2 * 2048 + idx] + red[3 * 2048 + idx]) + pebs[c * 64 + e];
            dst[(((size_t)nl * 4 + kvh) * 2 + c) * 64 + e] = (bf16)f2bf(v);
        }
    }
    wg_sync();
}

constexpr int AP_TB0 = 0, AP_TB1 = TILE_BYTES, AP_IMP = 4 * TILE_BYTES, AP_LUT = AP_IMP + 4 * 64 * 64 * 4, AP_SEL = AP_LUT + 4 * LUT_STRIDE * 4, AP_TL = AP_SEL + 64 * 8, AP_CT = AP_TL + 96 * 4, AP_END = AP_CT + TILE_BYTES;
static_assert(AP_END <= MISC_OFF, "prompt attention LDS map");
__device__ __forceinline__ void attn_prompt_unit(bool fresh  , int b, int kvh, int qb, const bf16* QB, const bf16* KCP, const bf16* SKV, const bf16* WKV, const float* GATES, const float* rel_table,
                                                 const float* KMP, bf16* MIX, float* SSQA, LAS unsigned char* lds, int tid_, int wave, int lane_) {
    asm volatile("; MARK_attn_prompt_unit_BEGIN" ::: "memory");
    int tid = tid_, lane = lane_; asm volatile("" : "+v"(tid), "+v"(lane));
    const int g = wave >> 1, th = wave & 1, r32 = lane & 31, h2 = lane >> 5;
    const int tl = 32 * th + r32, t = 64 * qb + tl, m = b * SEQ + t, hh = kvh * 4 + g;
    LAS unsigned char* TB0 = lds + AP_TB0; LAS unsigned char* TB1 = lds + AP_TB1;
    LAS float* IMP = (LAS float*)(lds + AP_IMP); LAS float* LUT = (LAS float*)(lds + AP_LUT); LAS u64* SEL = (LAS u64*)(lds + AP_SEL); LAS int* TL = (LAS int*)(lds + AP_TL);
    bf16x8 qf[4];
#pragma unroll
    for (int ks = 0; ks < 4; ++ks) qf[ks] = __builtin_bit_cast(bf16x8, *(const GAS v4u*)(QB + (size_t)m * DM + hh * 64 + 16 * ks + 8 * h2));
    if (fresh) for (int idx = tid; idx < 4 * 129; idx += NWAVES * 64) { const int gg = idx / 129, d = idx % 129; LUT[gg * LUT_STRIDE + d] = rel_table[BKT[d] * 16 + kvh * 4 + gg] * LOG2E; }
    const float gate_c = sigmoid_f(GATES[(size_t)m * 48 + hh * 3 + 0]), gate_s = sigmoid_f(GATES[(size_t)m * 48 + hh * 3 + 1]), gate_w = sigmoid_f(GATES[(size_t)m * 48 + hh * 3 + 2]);
    const float bias_far = rel_table[31 * 16 + hh] * LOG2E;
    const LAS float* lut = LUT + g * LUT_STRIDE;
    if (fresh) stage_tile_bf16(KCP, (long)b * 64, 64, kvh, lds + AP_CT, tid);
    wg_sync();
    float mq_s, mq_w;
    {
        float qq = 0.f;
#pragma unroll
        for (int ks = 0; ks < 4; ++ks)
#pragma unroll
            for (int e = 0; e < 8; ++e) { const float x = bf2f((unsigned short)qf[ks][e]); qq += x * x; }
        qq += __shfl_xor(qq, 32);
        float lmx = fmaxf(fmaxf(lut[lane], lut[64 + lane]), lut[128]);
#pragma unroll
        for (int o = 1; o < 64; o <<= 1) lmx = fmaxf(lmx, __shfl_xor(lmx, o));
        const float qn = sqrtf(qq) * 1.002f;
        LAS float* kred = (LAS float*)(lds + AP_TL + 70 * 4);
        if (fresh) {
            float ks_ = KMP[((size_t)b * 256 + (tid & 255)) * 4 + kvh], kw_ = KMP[((size_t)(NPR / 16) + b * 256 + (tid & 255)) * 4 + kvh];
#pragma unroll
            for (int o = 1; o < 64; o <<= 1) { ks_ = fmaxf(ks_, __shfl_xor(ks_, o)); kw_ = fmaxf(kw_, __shfl_xor(kw_, o)); }
            if (lane == 0) { kred[wave] = ks_; kred[8 + wave] = kw_; }
        }
        wg_sync();
        float kms = kred[0], kmw = kred[8];
#pragma unroll
        for (int w = 1; w < 8; ++w) { kms = fmaxf(kms, kred[w]); kmw = fmaxf(kmw, kred[8 + w]); }
        mq_s = qn * sqrtf(kms) + lmx;
        mq_w = qn * sqrtf(kmw) + lmx;
#ifdef PROBE_CONSTMQ
        mq_s = 30.f; mq_w = 30.f;
#endif
    }
    f32x16 ot0, ot1, o0, o1, p0, p1;
    float m_run = NEG_BIG, l_run = 0.f;
#pragma unroll
    for (int i = 0; i < 16; ++i) { o0[i] = 0.f; o1[i] = 0.f; }
    attn_tile<3>(lds + AP_CT, qf, 0.f, t, 63, true, lut, m_run, l_run, o0, o1, p0, p1, lane);
    {
        const float lt = l_run + __shfl_xor(l_run, 32), inv = lt > 0.f ? 1.0f / lt : 0.f, sc = gate_c * inv;
#pragma unroll
        for (int i = 0; i < 16; ++i) { ot0[i] = o0[i] * sc; ot1[i] = o1[i] * sc; }
        LAS float* slab = IMP + (g * 64 + tl) * 64;
#pragma unroll
        for (int i = 0; i < 16; ++i) { slab[crow(i, h2)] = p0[i] * inv; slab[32 + crow(i, h2)] = p1[i] * inv; }
    }
    wg_sync();
    if (qb < 16) { if (tid < 64) SEL[tid] = (2ull << qb) - 1ull; }
    else {
        for (int i = 0; i < 8; ++i) {
            const int tk = 8 * wave + i;
            const bool cand = (lane >= 1 && lane <= qb - 2);
            const float v = cand ? (IMP[(0 * 64 + tk) * 64 + lane] + IMP[(1 * 64 + tk) * 64 + lane]) + (IMP[(2 * 64 + tk) * 64 + lane] + IMP[(3 * 64 + tk) * 64 + lane]) : -1.f;
            const u64 key = cand ? ((((u64)__float_as_uint(v)) << 6) | (u64)(unsigned)(63 - lane)) : 0ull;
            u64 T13 = 0ull;
#pragma unroll
            for (int bp = 36; bp >= 0; --bp) { const u64 trial = T13 | (1ull << bp); const u64 bm = __ballot(key >= trial); const int cnt = __builtin_popcount((unsigned)bm) + __builtin_popcount((unsigned)(bm >> 32)); T13 = cnt >= 13 ? trial : T13; }
            const bool selected = (lane == 0 || lane == qb || lane == qb - 1) || (cand && key >= T13);
            const u64 mask = __ballot(selected);
            if (lane == 0) SEL[tk] = mask;
        }
    }
    wg_sync();
    if (wave == 0) {
        const u64 mine = SEL[lane]; unsigned lo = (unsigned)mine, hi = (unsigned)(mine >> 32);
#pragma unroll
        for (int o = 1; o < 64; o <<= 1) { lo |= __shfl_xor(lo, o); hi |= __shfl_xor(hi, o); }
        const u64 any = ((u64)hi << 32) | lo;
        const bool on = ((any >> lane) & 1ull) && lane <= qb;
        const u64 bal = __ballot(on);
        if (on) TL[1 + __popcll(bal & ((1ull << lane) - 1ull))] = lane;
        if (lane == 0) { TL[0] = __popcll(bal); TL[68] = qb >= 3 ? __popcll(bal & ((1ull << (qb - 2)) - 1ull)) : 0; }
    }
    wg_sync();
    const u64 mysel = SEL[tl];
    if (wave >= 4) __builtin_amdgcn_s_setprio(1);
    unsigned loff = (unsigned)((lane & 31) * KSTR + (lane >> 5) * 16); APIN(loff);
    LAS float* park = IMP + tid;
#pragma unroll
    for (int i = 0; i < 16; ++i) { park[i * 512] = ot0[i]; park[(16 + i) * 512] = ot1[i]; }
    const int ntl = TL[0];
    m_run = NEG_BIG; l_run = 0.f;
#pragma unroll
    for (int i = 0; i < 16; ++i) { o0[i] = 0.f; o1[i] = 0.f; }
    {
        StageRegs s1;
        const StageOff so = stage_off(tid);
        int it0 = 0;
        const int nfar = TL[68];
#define FB_(k) (lds + AP_TB0 + ((k) & 3) * TILE_BYTES)
#define SROW_(i) (b * SEQ + 64 * TL[1 + (i)])
#define FCIN_(i) ((((mysel >> TL[1 + (i)]) & 1ull) != 0ull) ? bias_far - mq_s : -INFINITY)
        if (nfar >= 4) {
            stage_tile_full(SKV, SROW_(0), kvh, FB_(0), tid); stage_tile_full(SKV, SROW_(1), kvh, FB_(1), tid); stage_tile_full(SKV, SROW_(2), kvh, FB_(2), tid);
            wg_sync();
            f32x16 A0, A1, B0, B1;
            attn_far_first(FB_(0), qf, A0, A1, FCIN_(0), loff);
            int tt = 1;
            for (; tt + 1 < nfar; tt += 2) {
                if (tt + 2 < nfar) stage_issue_off(SKV, SROW_(tt + 2), kvh, so, s1);
                attn_far_step(FB_(tt), FB_(tt - 1), qf, B0, B1, A0, A1, FCIN_(tt), l_run, o0, o1, loff);
                if (tt + 2 < nfar) stage_commit_off(s1, FB_(tt + 2), so);
                wg_sync();
                if (tt + 3 < nfar) stage_issue_off(SKV, SROW_(tt + 3), kvh, so, s1);
                attn_far_step(FB_(tt + 1), FB_(tt), qf, A0, A1, B0, B1, FCIN_(tt + 1), l_run, o0, o1, loff);
                if (tt + 3 < nfar) stage_commit_off(s1, FB_(tt + 3), so);
                wg_sync();
            }
            if (tt < nfar) {
                attn_far_step(FB_(tt), FB_(tt - 1), qf, B0, B1, A0, A1, FCIN_(tt), l_run, o0, o1, loff);
                attn_far_drain(FB_(tt), B0, B1, l_run, o0, o1, loff);
            } else attn_far_drain(FB_(nfar - 1), A0, A1, l_run, o0, o1, loff);
            wg_sync();
            it0 = nfar;
        }
#undef FB_
#undef SROW_
#undef FCIN_
        if (it0 < ntl) {
            stage_tile_full(SKV, b * SEQ + 64 * TL[1 + it0], kvh, TB0, tid);
            wg_sync();
            for (int it = it0; it < ntl; ++it) {
                const int j = TL[1 + it];
                LAS unsigned char* cur = ((it - it0) & 1) ? TB1 : TB0; LAS unsigned char* nxt = ((it - it0) & 1) ? TB0 : TB1;
                if (it + 1 < ntl) stage_issue_off(SKV, b * SEQ + 64 * TL[2 + it], kvh, so, s1);
                const bool sel = (mysel >> j) & 1ull;
                if (j <= qb - 3) attn_tile_fixed<0>(cur, qf, sel ? bias_far - mq_s : -INFINITY, 0, 0, true, lut, mq_s, l_run, o0, o1, lane, loff);
                else attn_tile_fixed<1>(cur, qf, 0.f, t, 64 * j, sel, lut, mq_s, l_run, o0, o1, lane, loff);
                if (it + 1 < ntl) stage_commit_off(s1, nxt, so);
                wg_sync();
            }
        }
        const float lt = l_run + __shfl_xor(l_run, 32), sc = gate_s / lt;
#pragma unroll
        for (int i = 0; i < 16; ++i) { park[i * 512] += o0[i] * sc; park[(16 + i) * 512] += o1[i] * sc; }
    }
    m_run = NEG_BIG; l_run = 0.f;
#pragma unroll
    for (int i = 0; i < 16; ++i) { o0[i] = 0.f; o1[i] = 0.f; }
    {
        StageRegs s1;
        const StageOff so = stage_off(tid);
        const int j0 = qb >= 8 ? qb - 8 : 0, nw = qb - j0 + 1;
        stage_tile_full(WKV, b * SEQ + 64 * j0, kvh, TB0, tid);
        wg_sync();
        for (int it = 0; it < nw; ++it) {
            const int j = j0 + it;
            LAS unsigned char* cur = (it & 1) ? TB1 : TB0; LAS unsigned char* nxt = (it & 1) ? TB0 : TB1;
            if (it + 1 < nw) stage_issue_off(WKV, b * SEQ + 64 * (j + 1), kvh, so, s1);
            if (j >= qb - 7 && j <= qb - 3) attn_tile_fixed<0>(cur, qf, bias_far - mq_w, 0, 0, true, lut, mq_w, l_run, o0, o1, lane, loff);
            else attn_tile_fixed<2>(cur, qf, 0.f, t, 64 * j, true, lut, mq_w, l_run, o0, o1, lane, loff);
            if (it + 1 < nw) stage_commit_off(s1, nxt, so);
            wg_sync();
        }
        const float lt = l_run + __shfl_xor(l_run, 32), sc = gate_w / lt;
#pragma unroll
        for (int i = 0; i < 16; ++i) { ot0[i] = park[i * 512] + o0[i] * sc; ot1[i] = park[(16 + i) * 512] + o1[i] * sc; }
    }
    __builtin_amdgcn_s_setprio(0);
    float ssq = 0.f;
#pragma unroll
    for (int i = 0; i < 16; ++i) ssq += ot0[i] * ot0[i] + ot1[i] * ot1[i];
    ssq += __shfl_xor(ssq, 32);
    if (h2 == 0) SSQA[(size_t)m * 16 + hh] = ssq;
    bf16* op = MIX + (size_t)m * DMIX + hh * 64 + 4 * h2;
#pragma unroll
    for (int gq = 0; gq < 4; ++gq) {
        *(u64*)(op + 8 * gq) = (u64)pk2(ot0[4 * gq], ot0[4 * gq + 1]) | ((u64)pk2(ot0[4 * gq + 2], ot0[4 * gq + 3]) << 32);
        *(u64*)(op + 32 + 8 * gq) = (u64)pk2(ot1[4 * gq], ot1[4 * gq + 1]) | ((u64)pk2(ot1[4 * gq + 2], ot1[4 * gq + 3]) << 32);
    }
    wg_sync();
}

constexpr int AS_TB = 0, AS_MOC = 4 * TILE_BYTES, AS_SIMP = AS_MOC + 16384, AS_MO = 65536, AS_LUT = 8 * TILE_BYTES, AS_SG = AS_LUT + 4 * LUT_STRIDE * 4, AS_SEL = AS_SG + 32 * 4 * 4, AS_TL = AS_SEL + 8 * 16,
              AS_OT = AS_TL + 132 * 4, AS_ML = AS_OT + 32 * 64 * 4, AS_PT = AS_ML + 8 * 32 * 8, AS_END = AS_PT + 64 * 4;
static_assert(AS_END <= MISC_OFF && AS_SIMP + 32 * 128 * 4 <= AS_LUT && AS_MO + 65536 <= AS_LUT, "sample attention LDS map");
__device__ __forceinline__ void as_write_state(LAS unsigned char* lds, int mo_off, int wave, int lane, float m_run, float l_run, const f32x16& o0, const f32x16& o1) {
    const int r32 = lane & 31, h2 = lane >> 5;
    const float lt = l_run + __shfl_xor(l_run, 32);
    LAS float* mo = (LAS float*)(lds + mo_off) + (wave * 32 + r32) * 64 + 4 * h2;
#pragma unroll
    for (int gq = 0; gq < 4; ++gq) {
        *(LAS f32x4*)(mo + 8 * gq) = (f32x4){o0[4 * gq], o0[4 * gq + 1], o0[4 * gq + 2], o0[4 * gq + 3]};
        *(LAS f32x4*)(mo + 32 + 8 * gq) = (f32x4){o1[4 * gq], o1[4 * gq + 1], o1[4 * gq + 2], o1[4 * gq + 3]};
    }
    if (h2 == 0) { LAS float* ml = (LAS float*)(lds + AS_ML) + (wave * 32 + r32) * 2; ml[0] = m_run; ml[1] = lt; }
}
template <int NW> __device__ __forceinline__ void as_merge(LAS unsigned char* lds, int mo_off, int br, int tid) {
    const int q = tid >> 4, d = (tid & 15) * 4;
    const LAS float* ml = (const LAS float*)(lds + AS_ML); const LAS float* mo = (const LAS float*)(lds + mo_off);
    float M = NEG_BIG;
#pragma unroll
    for (int w = 0; w < NW; ++w) M = fmaxf(M, ml[(w * 32 + q) * 2]);
    float L = 0.f; f32x4 acc = (f32x4){0.f, 0.f, 0.f, 0.f};
#pragma unroll
    for (int w = 0; w < NW; ++w) { const float f = fast_exp2(ml[(w * 32 + q) * 2] - M); L += ml[(w * 32 + q) * 2 + 1] * f; acc += *(const LAS f32x4*)(mo + (w * 32 + q) * 64 + d) * f; }
    const float sc = ((const LAS float*)(lds + AS_SG))[q * 4 + br] / L;
    LAS f32x4* ot = (LAS f32x4*)((LAS float*)(lds + AS_OT) + q * 64 + d);
    *ot = *ot + acc * sc;
}
__device__ __forceinline__ void attn_sample_unit(int b, int kvh, const bf16* QB, const float* QS32, const bf16* KCS, const float* KCS32, const bf16* SKV, const bf16* WKV, const float* cache_slc, const float* cache_win,
                                                 const int* page_table, const float* GATES, const float* rel_table, bf16* MIX, float* SSQA, const float* OUTP, LAS unsigned char* lds, int tid_, int wave, int lane_) {
    asm volatile("; MARK_attn_sample_unit_BEGIN" ::: "memory");
    int tid = tid_, lane = lane_; asm volatile("" : "+v"(tid), "+v"(lane));
    const int r32 = lane & 31, h2 = lane >> 5, g = r32 >> 3, t = r32 & 7, m = NPR + b * STOK + t, hh = kvh * 4 + g, qpos = PAST + t;
    LAS float* LUT = (LAS float*)(lds + AS_LUT); LAS float* SG = (LAS float*)(lds + AS_SG); LAS u64* SEL = (LAS u64*)(lds + AS_SEL); LAS int* TL = (LAS int*)(lds + AS_TL);
    LAS float* SIMP = (LAS float*)(lds + AS_SIMP);
    LAS int* pt = (LAS int*)(lds + AS_PT);
    if (tid < NPAGES) pt[tid] = page_table[b * NPAGES + tid];
    bf16x8 qf[4];
#pragma unroll
    for (int ks = 0; ks < 4; ++ks) qf[ks] = __builtin_bit_cast(bf16x8, *(const GAS v4u*)(QB + (size_t)m * DM + hh * 64 + 16 * ks + 8 * h2));
    for (int idx = tid; idx < 4 * 129; idx += NWAVES * 64) { const int gg = idx / 129, d = idx % 129; LUT[gg * LUT_STRIDE + d] = rel_table[BKT[d] * 16 + kvh * 4 + gg] * LOG2E; }
    if (tid < 96) { const int q = tid / 3, br = tid % 3; SG[q * 4 + br] = sigmoid_f(GATES[(size_t)(NPR + b * STOK + (q & 7)) * 48 + (kvh * 4 + (q >> 3)) * 3 + br]); }
    for (int idx = tid; idx < 32 * 64; idx += NWAVES * 64) ((LAS float*)(lds + AS_OT))[idx] = 0.f;
    const float bias_far = rel_table[31 * 16 + hh] * LOG2E;
    const LAS float* lut = LUT + g * LUT_STRIDE;
    f32x16 o0, o1, p0, p1; float m_run, l_run;
#define AS_RESET() do { m_run = NEG_BIG; l_run = 0.f; _Pragma("unroll") for (int i = 0; i < 16; ++i) { o0[i] = 0.f; o1[i] = 0.f; } } while (0)
    stage_tile_bf16(KCS, (long)b * 128, 64, kvh, lds + AS_TB, tid);
    stage_tile_bf16(KCS, (long)b * 128 + 64, 64, kvh, lds + AS_TB + TILE_BYTES, tid);
    wg_sync();
#if SPLIT_RANK
    stage_k_hilo(KCS32, (long)b * 128, kvh, lds + AS_TB, lds + AS_TB + 2 * TILE_BYTES, tid);
    stage_k_hilo(KCS32, (long)b * 128 + 64, kvh, lds + AS_TB + TILE_BYTES, lds + AS_TB + 3 * TILE_BYTES, tid);
    wg_sync();
#endif
    AS_RESET();
    if (wave < 2) {
#if SPLIT_RANK
        bf16x8 qh[4], ql[4];
#pragma unroll
        for (int ks = 0; ks < 4; ++ks) { const GAS f32x4* qp = (const GAS f32x4*)(QS32 + (size_t)(b * STOK + t) * DM + hh * 64 + 16 * ks + 8 * h2);
            v4u h_, l_; split8(qp[0], qp[1], h_, l_); qh[ks] = __builtin_bit_cast(bf16x8, h_); ql[ks] = __builtin_bit_cast(bf16x8, l_); }
        attn_tile<3, true>(lds + AS_TB + wave * TILE_BYTES, qh, 0.f, qpos, 64 * 64 * wave + 63, true, lut, m_run, l_run, o0, o1, p0, p1, lane, lds + AS_TB + (2 + wave) * TILE_BYTES, ql);
#else
        attn_tile<3>(lds + AS_TB + wave * TILE_BYTES, qf, 0.f, qpos, 64 * 64 * wave + 63, true, lut, m_run, l_run, o0, o1, p0, p1, lane);
#endif
        LAS float* sp = SIMP + r32 * 128 + 64 * wave;
#pragma unroll
        for (int i = 0; i < 16; ++i) { sp[crow(i, h2)] = p0[i]; sp[32 + crow(i, h2)] = p1[i]; }
    }
    if (wave < 2) as_write_state(lds, AS_MOC, wave, lane, m_run, l_run, o0, o1);
    wg_sync();
    as_merge<2>(lds, AS_MOC, 0, tid);
    {
        const int tk = wave;
        const LAS float* ml = (const LAS float*)(lds + AS_ML);
        float v0 = 0.f, v1 = 0.f;
#pragma unroll
        for (int gg = 0; gg < 4; ++gg) { const int q = gg * 8 + tk;
            const float m0 = ml[(0 * 32 + q) * 2], l0 = ml[(0 * 32 + q) * 2 + 1], m1 = ml[(1 * 32 + q) * 2], l1 = ml[(1 * 32 + q) * 2 + 1];
            const float M = fmaxf(m0, m1), f0 = fast_exp2(m0 - M), f1 = fast_exp2(m1 - M), inv = 1.0f / (l0 * f0 + l1 * f1);
            v0 += SIMP[q * 128 + lane] * (f0 * inv); v1 += SIMP[q * 128 + 64 + lane] * (f1 * inv); }
        const bool c0 = lane >= 1, c1 = lane <= 62;
#ifdef PROBE_COARSE
        v0 = __uint_as_float(f2bf(v0) << 16); v1 = __uint_as_float(f2bf(v1) << 16);
#endif
        if (!c0) v0 = -1.f; if (!c1) v1 = -1.f;
        int rk0 = 0, rk1 = 0;
#pragma unroll
        for (int jj = 0; jj < 64; ++jj) {
            const float a = __builtin_bit_cast(float, __builtin_amdgcn_readlane(__builtin_bit_cast(int, v0), jj)), bb = __builtin_bit_cast(float, __builtin_amdgcn_readlane(__builtin_bit_cast(int, v1), jj));
            rk0 += (a > v0 || (a == v0 && jj < lane)) ? 1 : 0; rk0 += (bb > v0) ? 1 : 0;
            rk1 += (a > v1 || a == v1) ? 1 : 0; rk1 += (bb > v1 || (bb == v1 && jj < lane)) ? 1 : 0;
        }
        const bool s0 = (lane == 0) || (c0 && rk0 < 13), s1 = (lane == 63) || (c1 && rk1 < 13);
        const u64 mk0 = __ballot(s0), mk1 = __ballot(s1);
        if (lane == 0) { SEL[tk * 2] = mk0; SEL[tk * 2 + 1] = mk1; }
    }
    wg_sync();
    if (tid == 0) { u64 a0 = 0ull, a1 = 0ull; for (int i = 0; i < 8; ++i) { a0 |= SEL[2 * i]; a1 |= SEL[2 * i + 1]; }
        int n = 0; for (int j = 0; j < 64; ++j) if ((a0 >> j) & 1ull) TL[1 + n++] = j; for (int j = 0; j < 64; ++j) if ((a1 >> j) & 1ull) TL[1 + n++] = 64 + j; TL[1 + n++] = 128; TL[0] = n; }
    wg_sync();
#ifdef SAMPLE_BRUTE
    {
        const int q = tid >> 4, part = tid & 15, gq = q >> 3, tq = q & 7, hq = kvh * 4 + gq, qp = PAST + tq;
        float qv[64];
#pragma unroll
        for (int d = 0; d < 64; ++d) qv[d] = QS32[(size_t)(b * STOK + tq) * DM + hq * 64 + d];
        for (int br = 1; br <= 2; ++br) {
            float mrun = NEG_BIG, lrun = 0.f, ov[64];
#pragma unroll
            for (int d = 0; d < 64; ++d) ov[d] = 0.f;
            int nkeys, jblk = -1;
            if (br == 1) { const u64 a0 = SEL[tq * 2], a1 = SEL[tq * 2 + 1]; int cnt = 0; jblk = 128;
                for (int j = 0; j < 128; ++j) { const bool on = j < 64 ? ((a0 >> j) & 1ull) : ((a1 >> (j - 64)) & 1ull); if (on) { if (cnt == part) jblk = j; ++cnt; } }
                nkeys = 64; }
            else nkeys = 33;
            for (int kk = 0; kk < nkeys; ++kk) {
                int kpos; const float* krow;
                if (br == 1) { kpos = 64 * jblk + kk;
                    if (jblk < 128) krow = cache_slc + (((size_t)pt[jblk >> 1] * 128 + (jblk & 1) * 64 + kk) * 4 + kvh) * 128;
                    else krow = (kk < STOK) ? OUTP + O_SSLC + ((size_t)(b * STOK + kk) * 4 + kvh) * 128 : nullptr; }
                else { const int widx = part + 16 * kk; if (widx >= 520) continue; kpos = PAST - 512 + widx;
                    krow = widx < 512 ? cache_win + (((size_t)b * 512 + widx) * 4 + kvh) * 128 : OUTP + O_SWIN + (((size_t)b * 512 + 504 + (widx - 512)) * 4 + kvh) * 128; }
                const int dist = qp - kpos;
                const bool ok = krow != nullptr && dist >= 0 && (br == 1 || dist < 512);
                if (!ok) continue;
                float sdot = 0.f;
#pragma unroll
                for (int d = 0; d < 64; ++d) sdot += qv[d] * krow[d];
                sdot += rel_table[BKT[min(dist, 128)] * 16 + hq] * LOG2E;
                const float mn = fmaxf(mrun, sdot), al = fast_exp2(mrun - mn), pp = fast_exp2(sdot - mn);
                mrun = mn; lrun = lrun * al + pp;
#pragma unroll
                for (int d = 0; d < 64; ++d) ov[d] = ov[d] * al + pp * krow[64 + d];
            }
            float M = mrun;
#pragma unroll
            for (int o = 1; o < 16; o <<= 1) M = fmaxf(M, __shfl_xor(M, o));
            const float f = fast_exp2(mrun - M);
            float L = lrun * f;
#pragma unroll
            for (int o = 1; o < 16; o <<= 1) L += __shfl_xor(L, o);
            const float sc = SG[q * 4 + br] / L;
#pragma unroll
            for (int d = 0; d < 64; ++d) { float v = ov[d] * f;
#pragma unroll
                for (int o = 1; o < 16; o <<= 1) v += __shfl_xor(v, o);
                if (part == (d & 15)) ((LAS float*)(lds + AS_OT))[q * 64 + d] += v * sc; }
        }
    }
    wg_sync();
#else
    {
        const int ntl = TL[0];
        const u64 ms0 = SEL[t * 2], ms1 = SEL[t * 2 + 1];
        AS_RESET();
        const int nh = (ntl + 3) >> 2;
        StageRegsF rf[4];
        const StageOffF sof = stage_off_f32(tid);
#define SEL_ISSUE(h_) do { _Pragma("unroll") for (int s4 = 0; s4 < 4; ++s4) { const int idx = 4 * (h_) + s4; if (idx < ntl) { const int j = TL[1 + idx]; \
            if (j < 128) stage_f32_issue_off(cache_slc, pt[j >> 1] * 128 + (j & 1) * 64, kvh, sof, rf[s4]); \
            else stage_tile_bf16(SKV, (long)NPR + b * STOK, STOK, kvh, lds + AS_TB + ((((h_) & 1) << 2) + s4) * TILE_BYTES, tid); } } } while (0)
#define SEL_COMMIT(h_) do { _Pragma("unroll") for (int s4 = 0; s4 < 4; ++s4) { const int idx = 4 * (h_) + s4; \
            if (idx < ntl && TL[1 + idx] < 128) stage_f32_commit_off(rf[s4], lds + AS_TB + ((((h_) & 1) << 2) + s4) * TILE_BYTES, sof); } } while (0)
        SEL_ISSUE(0); SEL_COMMIT(0);
        wg_sync();
        for (int h = 0; h < nh; ++h) {
            if (h + 1 < nh) SEL_ISSUE(h + 1);
            if ((wave >> 2) == (h & 1)) { const int idx = 4 * h + (wave & 3);
                if (idx < ntl) { const int j = TL[1 + idx];
                    const bool sel = j >= 128 ? true : (j < 64 ? ((ms0 >> j) & 1ull) : ((ms1 >> (j - 64)) & 1ull));
                    if (j <= 125) attn_tile<0>(lds + AS_TB + wave * TILE_BYTES, qf, sel ? bias_far : -INFINITY, 0, 0, true, lut, m_run, l_run, o0, o1, p0, p1, lane);
                    else attn_tile<1>(lds + AS_TB + wave * TILE_BYTES, qf, 0.f, qpos, 64 * j, sel, lut, m_run, l_run, o0, o1, p0, p1, lane); } }
            if (h + 1 < nh) SEL_COMMIT(h + 1);
            wg_sync();
        }
#undef SEL_ISSUE
#undef SEL_COMMIT
        as_write_state(lds, AS_MO, wave, lane, m_run, l_run, o0, o1);
        wg_sync();
        as_merge<8>(lds, AS_MO, 1, tid);
        wg_sync();
    }
    {
#ifdef PROBE_DELAY
        for (int dly = 0; dly < 4000; ++dly) __builtin_amdgcn_s_sleep(127);
#endif
        AS_RESET();
        StageRegsF rf[4];
        const StageOffF sof = stage_off_f32(tid);
#define WIN_ISSUE(h_) do { _Pragma("unroll") for (int s4 = 0; s4 < 4; ++s4) { const int wt = 4 * (h_) + s4; if (wt < 9) { \
            if (wt < 8) stage_f32_issue_off(cache_win, b * 512 + 64 * wt, kvh, sof, rf[s4]); \
            else stage_tile_bf16(WKV, (long)NPR + b * STOK, STOK, kvh, lds + AS_TB + ((((h_) & 1) << 2) + s4) * TILE_BYTES, tid); } } } while (0)
#define WIN_COMMIT(h_) do { _Pragma("unroll") for (int s4 = 0; s4 < 4; ++s4) { const int wt = 4 * (h_) + s4; \
            if (wt < 8) stage_f32_commit_off(rf[s4], lds + AS_TB + ((((h_) & 1) << 2) + s4) * TILE_BYTES, sof); } } while (0)
        WIN_ISSUE(0); WIN_COMMIT(0);
        wg_sync();
        for (int h = 0; h < 3; ++h) {
            if (h + 1 < 3) WIN_ISSUE(h + 1);
            if ((wave >> 2) == (h & 1)) { const int wt = 4 * h + (wave & 3);
                if (wt < 9) attn_tile<2>(lds + AS_TB + wave * TILE_BYTES, qf, 0.f, qpos, PAST - 512 + 64 * wt, true, lut, m_run, l_run, o0, o1, p0, p1, lane); }
            if (h + 1 < 3) WIN_COMMIT(h + 1);
            wg_sync();
        }
#undef WIN_ISSUE
#undef WIN_COMMIT
        as_write_state(lds, AS_MO, wave, lane, m_run, l_run, o0, o1);
        wg_sync();
        as_merge<8>(lds, AS_MO, 2, tid);
        wg_sync();
    }
#endif
    {
        const int q = tid >> 4, d = (tid & 15) * 4, gq = q >> 3, tq = q & 7, mq = NPR + b * STOK + tq, hq = kvh * 4 + gq;
        const f32x4 v = *(const LAS f32x4*)((const LAS float*)(lds + AS_OT) + q * 64 + d);
        float ssq = (v.x * v.x + v.y * v.y) + (v.z * v.z + v.w * v.w);
        ssq += __shfl_xor(ssq, 1); ssq += __shfl_xor(ssq, 2); ssq += __shfl_xor(ssq, 4); ssq += __shfl_xor(ssq, 8);
        *(u64*)(MIX + (size_t)mq * DMIX + hq * 64 + d) = (u64)pk2(v.x, v.y) | ((u64)pk2(v.z, v.w) << 32);
        if ((tid & 15) == 0) SSQA[(size_t)mq * 16 + hq] = ssq;
    }
    wg_sync();
#undef AS_RESET
}

__device__ __forceinline__ void sample_q_unit(int unit, const float* X1, const float* mix_pre, const float* w_in, float* QS32, LAS unsigned char* lds, int tid, int wave, int lane) {
    const int r0 = (unit >> 4) * 16, c0 = (unit & 15) * 64;
    LAS float* xs = (LAS float*)lds;
    for (int rr = 2 * wave; rr < 2 * wave + 2; ++rr) {
        const GAS f32x4* xr = (const GAS f32x4*)(X1 + (size_t)(NPR + r0 + rr) * DM) + lane; const GAS f32x4* gr = (const GAS f32x4*)mix_pre + lane;
        f32x4 v[4]; float ss = 0.f;
#pragma unroll
        for (int j = 0; j < 4; ++j) { v[j] = xr[64 * j]; ss += (v[j].x * v[j].x + v[j].y * v[j].y) + (v[j].z * v[j].z + v[j].w * v[j].w); }
        const float rs = 1.0f / sqrtf(wave_sum(ss) * (1.f / DM) + EPS);
#pragma unroll
        for (int j = 0; j < 4; ++j) { const f32x4 gg = gr[64 * j]; *(LAS f32x4*)(xs + rr * 1024 + 4 * lane + 256 * j) = (f32x4){v[j].x * rs * gg.x, v[j].y * rs * gg.y, v[j].z * rs * gg.z, v[j].w * rs * gg.w}; }
    }
    wg_sync();
    {
        const int kq = tid >> 5, cp = tid & 31, c = c0 + 2 * cp;
        float acc[16][2];
#pragma unroll
        for (int r = 0; r < 16; ++r) { acc[r][0] = 0.f; acc[r][1] = 0.f; }
        const float* wp = w_in + (size_t)(64 * kq) * DIN + c;
#pragma unroll 4
        for (int k8 = 0; k8 < 8; ++k8) {
            float2 w[8];
#pragma unroll
            for (int i = 0; i < 8; ++i) w[i] = *(const float2*)(wp + (size_t)(8 * k8 + i) * DIN);
#pragma unroll
            for (int r = 0; r < 16; ++r) {
                const f32x4 xa = *(const LAS f32x4*)(xs + r * 1024 + 64 * kq + 8 * k8), xb = *(const LAS f32x4*)(xs + r * 1024 + 64 * kq + 8 * k8 + 4);
                acc[r][0] += xa.x * w[0].x + xa.y * w[1].x + xa.z * w[2].x + xa.w * w[3].x + xb.x * w[4].x + xb.y * w[5].x + xb.z * w[6].x + xb.w * w[7].x;
                acc[r][1] += xa.x * w[0].y + xa.y * w[1].y + xa.z * w[2].y + xa.w * w[3].y + xb.x * w[4].y + xb.y * w[5].y + xb.z * w[6].y + xb.w * w[7].y;
            }
        }
        LAS float* red = (LAS float*)(lds + 65536);
#pragma unroll
        for (int r = 0; r < 16; ++r) { typedef float f32x2v __attribute__((ext_vector_type(2))); *(LAS f32x2v*)(red + (kq * 16 + r) * 64 + 2 * cp) = (f32x2v){acc[r][0], acc[r][1]}; }
        wg_sync();
        for (int idx = tid; idx < 1024; idx += NWAVES * 64) { const int r = idx >> 6, cc = idx & 63; float sum = 0.f;
#pragma unroll
            for (int q = 0; q < 16; ++q) sum += red[(q * 16 + r) * 64 + cc];
            QS32[(size_t)(r0 + r) * DM + c0 + cc] = sum * C2; }
    }
    wg_sync();
}

constexpr int REP_0 = 1, REP_3 = 1, REP_13 = 1, REP_1 = 1, REP_2 = 1, REP_4 = 1, REP_5A = 1, REP_5B = 1, REP_6 = 1, REP_7A = 1, REP_7B = 1, REP_7C = 1, REP_9 = 1, REP_11 = 1, REP_12 = 1;
struct Args { const float* in[30]; float* out; unsigned char* ws; int ph_lo, ph_hi; };
constexpr int N_PHASES = 14;

#define x_prompt (args.in[0])
#define x_sample (args.in[1])
#define cache_cmp (args.in[2])
#define cache_slc (args.in[3])
#define cache_win (args.in[4])
#define state_ssm (args.in[5])
#define state_conv (args.in[6])
#define page_table ((const int*)args.in[7])
#define rel_table (args.in[8])
#define ffn1_pre (args.in[9])
#define ffn1_post (args.in[10])
#define ffn1_w_in (args.in[11])
#define ffn1_w_out (args.in[12])
#define mix_pre (args.in[13])
#define mix_post (args.in[14])
#define w_in (args.in[15])
#define w_out (args.in[16])
#define att_out_norm (args.in[17])
#define cmp_pe (args.in[18])
#define w_cmp (args.in[19])
#define conv_w (args.in[20])
#define conv_b (args.in[21])
#define dt_bias (args.in[22])
#define a_log (args.in[23])
#define d_skip (args.in[24])
#define ssd_norm (args.in[25])
#define ffn2_pre (args.in[26])
#define ffn2_post (args.in[27])
#define ffn2_w_in (args.in[28])
#define ffn2_w_out (args.in[29])
#define W1A ((bf16*)(args.ws + WS_W1A))
#define W1B ((bf16*)(args.ws + WS_W1B))
#define WIN ((bf16*)(args.ws + WS_WIN))
#define WOUT ((bf16*)(args.ws + WS_WOUT))
#define W2A ((bf16*)(args.ws + WS_W2A))
#define W2B ((bf16*)(args.ws + WS_W2B))
#define WCF ((bf16*)(args.ws + WS_WCF))
#define PEB ((float*)(args.ws + WS_PEB))
#define WCFL ((bf16*)(args.ws + WS_WCFL))
#define QS32 ((float*)(args.ws + WS_QS32))
#define KCS32 ((float*)(args.ws + WS_KCS32))
#define GATES ((float*)(args.ws + WS_GATES))
#define DTR ((float*)(args.ws + WS_DT))
#define SSQA ((float*)(args.ws + WS_SSQA))
#define SSQY ((float*)(args.ws + WS_SSQY))
#define DC ((float*)(args.ws + WS_DC))
#define KCP ((bf16*)(args.ws + WS_KCP))
#define KCS ((bf16*)(args.ws + WS_KCS))
#define XN ((bf16*)(args.ws + WS_XN))
#define QB ((bf16*)(args.ws + WS_Q))
#define CKV ((bf16*)(args.ws + WS_CKV))
#define SKV ((bf16*)(args.ws + WS_SKV))
#define WKV ((bf16*)(args.ws + WS_WKV))
#define ZB ((bf16*)(args.ws + WS_Z))
#define XBC ((bf16*)(args.ws + WS_XBC))
#define ACT ((bf16*)(args.ws + WS_ACT))
#define O32 ((float*)(args.ws + WS_O32))
#define X1 ((float*)(args.ws + WS_X1))
#define MIX ((bf16*)(args.ws + WS_MIX))
#define STB ((bf16*)(args.ws + WS_ST))
#define PART ((float*)(args.ws + WS_PART))
#define KMP ((float*)(args.ws + WS_KMP))
#define XCV (args.ws + WS_XCV)
#define BCV (args.ws + WS_BCV)
#define CCV (args.ws + WS_CCV)
#define SCV ((float*)(args.ws + WS_SCV))
__global__ void __launch_bounds__(NWAVES * 64, 2) mk_fwd(Args args) {
    extern __shared__ __attribute__((aligned(16))) unsigned char lds_raw[];
    LAS unsigned char* lds = (LAS unsigned char*)lds_raw;
    volatile LAS unsigned* MISC = (volatile LAS unsigned*)(lds + MISC_OFF);
    const int tid = threadIdx.x, lane = tid & 63, wave = __builtin_amdgcn_readfirstlane(tid >> 6);
    const int G = gridDim.x, bx = blockIdx.x;
    const int vcu = (G % 8 == 0) ? (bx % 8) * (G / 8) + bx / 8 : bx;
    const int gw = vcu * NWAVES + wave, NGW = G * NWAVES;
    unsigned char* ws = args.ws;
    gu32* ctl = (gu32*)(ws + WS_CTL);
    float* out = args.out;
    for (int u = tid; u < 64; u += NWAVES * 64) ((LAS unsigned*)(lds + MISC_OFF))[u] = 0u;
    __syncthreads();
    XcdBarrier bar = xcd_barrier_post((unsigned*)(ctl + CW_BAR), MISC + 8);
    const int lo = args.ph_lo, hi = args.ph_hi;
#define IN(k) (lo <= (k) && (k) < hi)
#define SEAM(k) do { if (IN(k) && IN((k) + 1)) xcd_barrier(bar); } while (0)

    if (IN(0)) {
    _Pragma("unroll 1") for (int rep0_ = 0; rep0_ < REP_0; ++rep0_) {
        int ln = lane; asm volatile("" : "+v"(ln));
        LAS float* scr = (LAS float*)(lds + wave * 16896);
        constexpr int I_A = 16 * (2 * DFF / 64), I_B = (DFF / 64) * (DM / 64), I_IN = 16 * (DINP / 64), I_OUT = (DMIX / 64) * (DM / 64);
        constexpr int NITEMS = I_A + I_B + I_IN + I_OUT;
        for (int it = gw; it < NITEMS; it += NGW) {
            int r = it;
            if (r < I_A) { transpose_item64<0>(ffn1_w_in, DM, 2 * DFF, W1A, nullptr, nullptr, scr, r, 2 * DFF / 64, ln); continue; } r -= I_A;
            if (r < I_B) { transpose_item64<1>(ffn1_w_out, DFF, DM, W1B, nullptr, nullptr, scr, r, DM / 64, ln); continue; } r -= I_B;
            if (r < I_IN) { transpose_item64<2>(w_in, DM, DIN, WIN, nullptr, nullptr, scr, r, DINP / 64, ln); continue; } r -= I_IN;
            transpose_item64<3>(w_out, DMIX, DM, WOUT, att_out_norm, ssd_norm, scr, r, DM / 64, ln);
        }
        for (int m = gw; m < NPR; m += 4 * NGW) {
            const int m1 = m + NGW < NPR ? m + NGW : m, m2 = m + 2 * NGW < NPR ? m + 2 * NGW : m, m3 = m + 3 * NGW < NPR ? m + 3 * NGW : m;
            rms_rows4_to_bf16(x_prompt + (size_t)m * DM, x_prompt + (size_t)m1 * DM, x_prompt + (size_t)m2 * DM, x_prompt + (size_t)m3 * DM, ffn1_pre,
                              XN + (size_t)m * DM, XN + (size_t)m1 * DM, XN + (size_t)m2 * DM, XN + (size_t)m3 * DM, ln);
        }
        for (int m = NPR + gw; m < MT; m += NGW) rms_row_to_bf16(x_sample + (size_t)(m - NPR) * DM, ffn1_pre, XN + (size_t)m * DM, ln);
#if 0
        for (int r = gw; r < SBAT * 504; r += NGW) {
            const int b = r / 504, j = r % 504;
            const GAS f32x4* s = (const GAS f32x4*)(cache_win + ((size_t)b * 512 + j + 8) * KVW) + ln;
            GAS f32x4* d = (GAS f32x4*)(out + O_SWIN + ((size_t)b * 512 + j) * KVW) + ln;
            d[0] = s[0]; d[64] = s[64];
        }
#endif
        for (int f = bx * (NWAVES * 64) + tid; f < 2 * 256 * 2 * 64; f += G * NWAVES * 64) {
            const int ln = f & 63, et = (f >> 6) & 1, ks = (f >> 7) & 255, c = f >> 15;
            const int l = ks >> 2, d0 = 32 * ((ks & 3) >> 1) + 16 * (ln >> 5) + 8 * (ks & 1), e = 32 * et + (ln & 31);
            const float* src = w_cmp + (((size_t)l * 2 + c) * 64 + d0) * 64 + e;
            v4u o; o.x = pk2(src[0], src[64]); o.y = pk2(src[128], src[192]); o.z = pk2(src[256], src[320]); o.w = pk2(src[384], src[448]);
            *(GAS v4u*)(WCF + (size_t)f * 8) = o;
            if (SPLIT_RANK && c == 0) {
                unsigned lw[8];
#pragma unroll
                for (int j = 0; j < 8; ++j) { const float x = src[64 * j]; lw[j] = f2bf(x - __uint_as_float(f2bf(x) << 16)); }
                v4u ol; ol.x = lw[0] | (lw[1] << 16); ol.y = lw[2] | (lw[3] << 16); ol.z = lw[4] | (lw[5] << 16); ol.w = lw[6] | (lw[7] << 16);
                *(GAS v4u*)(WCFL + (size_t)f * 8) = ol;
            }
        }
        if (bx < 16) {
            LAS float* red = (LAS float*)(lds + 140032);
            const int sub = tid >> 7, ce = tid & 127, c = ce >> 6, e = ce & 63, l = 4 * bx + sub;
            float s0 = 0.f, s1 = 0.f;
#pragma unroll 8
            for (int d = 0; d < 64; d += 2) { s0 += cmp_pe[(l * 2 + c) * 64 + d] * w_cmp[(((size_t)l * 2 + c) * 64 + d) * 64 + e]; s1 += cmp_pe[(l * 2 + c) * 64 + d + 1] * w_cmp[(((size_t)l * 2 + c) * 64 + d + 1) * 64 + e]; }
            red[tid] = s0 + s1;
            __syncthreads();
            if (tid < 128) PEB[bx * 128 + tid] = (red[tid] + red[tid + 128]) + (red[tid + 256] + red[tid + 384]);
        }
    }}
    SEAM(0);

    if (IN(1)) {
    _Pragma("unroll") for (int rep_ = 0; rep_ < REP_1; ++rep_) {
        pg8::Gemm g{XN, W1A, MT, 2 * DFF, DM}; pg8::StaticOrder S; S.init(MT, 2 * DFF, G, bx, DM);
        EpiSwiglu E{ACT};
        if (G == 256 && bx >= (65 * 22) % 256 && (bx & 1)) { const int hu = bx - (65 * 22) % 256, b = hu >> 4, b0 = (hu & 15) * 8;
            compress_sample_unit<false>(cache_cmp, page_table + b * NPAGES, b0, WCF, PEB, KCS + ((size_t)b * 128 + b0) * KVW, lds, tid, wave, lane); }
        pg8::gemm_phase<EpiSwiglu, pg8::StaticOrder, true, true>(lds, g, S, E);
        if (G == 256 && bx >= (65 * 22) % 256 && !(bx & 1)) { const int hu = bx - (65 * 22) % 256, b = hu >> 4, b0 = (hu & 15) * 8;
            compress_sample_unit<false>(cache_cmp, page_table + b * NPAGES, b0, WCF, PEB, KCS + ((size_t)b * 128 + b0) * KVW, lds, tid, wave, lane); }
    }}
    SEAM(1);
    if (IN(2)) {
    _Pragma("unroll") for (int rep_ = 0; rep_ < REP_2; ++rep_) {
        pg8::Gemm g{ACT, W1B, MT, DM, DFF}; MixedOrder S; S.S.init(NPR, DM, G, bx, DFF); S.nks = DFF / 256; EpiF32Mixed E{(bf16*)O32, PART};
        pg8::gemm_phase<EpiF32Mixed, MixedOrder, true, true>(lds, g, S, E);
        {
            int ln = lane; asm volatile("" : "+v"(ln));
            LAS float* scr = (LAS float*)(lds + wave * 16896);
            const int first = (G == 256) ? 4 * (DFF / 256) : 0;
            if (bx >= first) for (int it = (bx - first) * NWAVES + wave; it < 16 * (2 * DFF / 64); it += (G - first) * NWAVES)
                transpose_item64<0>(ffn2_w_in, DM, 2 * DFF, W2A, nullptr, nullptr, scr, it, 2 * DFF / 64, ln);
        }
    }}
    SEAM(2);
    if (IN(3)) {
    _Pragma("unroll 1") for (int rep3_ = 0; rep3_ < REP_3; ++rep3_) {
        int ln = lane; asm volatile("" : "+v"(ln));
        for (int m = gw; m < NPR; m += 2 * NGW) {
            RowRegs ra, rb; const int m2 = (m + NGW < NPR) ? m + NGW : m;
            row_load(ra, x_prompt + (size_t)m * DM, (const bf16*)O32 + (size_t)m * DM, ln); row_load(rb, x_prompt + (size_t)m2 * DM, (const bf16*)O32 + (size_t)m2 * DM, ln);
            row_finish(ra, ffn1_post, 0.5f, X1 + (size_t)m * DM, mix_pre, XN + (size_t)m * DM, ln);
            row_finish(rb, ffn1_post, 0.5f, X1 + (size_t)m2 * DM, mix_pre, XN + (size_t)m2 * DM, ln);
        }
        for (int m = NPR + gw; m < MT; m += NGW)
            row_post<false>(x_sample + (size_t)(m - NPR) * DM, PART + (size_t)(m - NPR) * DM, DFF / 256, (size_t)NSA * DM, ffn1_post, 0.5f, X1 + (size_t)m * DM, mix_pre, XN + (size_t)m * DM, ln);
    }}
    SEAM(3);
    if (IN(4)) {
    _Pragma("unroll") for (int rep_ = 0; rep_ < REP_4; ++rep_) {
        pg8::Gemm g{XN, WIN, MT, DINP, DM}; pg8::StaticOrder S; S.init(MT, DINP, G, bx, DM);
        EpiInProj E{QB, CKV, ZB, XBC, GATES, DTR, out};
        if (G == 256 && bx >= (65 * 21) % 256 && (bx & 1)) { const int hu = 106 + bx - (65 * 21) % 256, b = hu >> 4, b0 = (hu & 15) * 8;
            compress_sample_unit<false>(cache_cmp, page_table + b * NPAGES, b0, WCF, PEB, KCS + ((size_t)b * 128 + b0) * KVW, lds, tid, wave, lane); }
        pg8::gemm_phase<EpiInProj, pg8::StaticOrder, true, true>(lds, g, S, E);
        if (G == 256 && bx >= (65 * 21) % 256 && !(bx & 1)) { const int hu = 106 + bx - (65 * 21) % 256, b = hu >> 4, b0 = (hu & 15) * 8;
            compress_sample_unit<false>(cache_cmp, page_table + b * NPAGES, b0, WCF, PEB, KCS + ((size_t)b * 128 + b0) * KVW, lds, tid, wave, lane); }
    }}
    SEAM(4);

    if (IN(5)) {
    {
        if (SPLIT_RANK) for (int u = vcu; u < 256; u += G) sample_q_unit(u, X1, mix_pre, w_in, QS32, lds, tid, wave, lane);
        for (int e = vcu * (NWAVES * 64) + tid; e < 2 * NPR * 4; e += G * NWAVES * 64) {
            const int br = e >= NPR * 4, r = (e - br * NPR * 4) >> 2, kv = e & 3;
            const GAS v4u* kp = (const GAS v4u*)((br ? WKV : SKV) + (size_t)r * KVW + kv * 128);
            float ss = 0.f;
#pragma unroll
            for (int q = 0; q < 8; ++q) { const v4u w = kp[q];
                const float a0 = __uint_as_float(w.x << 16), a1 = __uint_as_float(w.x & 0xffff0000u), a2 = __uint_as_float(w.y << 16), a3 = __uint_as_float(w.y & 0xffff0000u);
                const float a4 = __uint_as_float(w.z << 16), a5 = __uint_as_float(w.z & 0xffff0000u), a6 = __uint_as_float(w.w << 16), a7 = __uint_as_float(w.w & 0xffff0000u);
                ss += (a0 * a0 + a1 * a1) + (a2 * a2 + a3 * a3) + (a4 * a4 + a5 * a5) + (a6 * a6 + a7 * a7); }
#pragma unroll
            for (int o = 4; o < 64; o <<= 1) ss = fmaxf(ss, __shfl_xor(ss, o));
            if (lane < 4) KMP[((size_t)br * (NPR / 16) + (r >> 4)) * 4 + kv] = ss;
        }
        _Pragma("unroll 1") for (int pass = 0; pass < 2; ++pass) {
        if (((pass ^ vcu) & 1) == 0) {
        _Pragma("unroll 1") for (int rep_ = 0; rep_ < REP_5A; ++rep_)
        for (int hu = (G == 256 ? 277 : 0) + vcu; hu < SBAT * 16; hu += G) { const int b = hu >> 4, b0 = (hu & 15) * 8;
            compress_sample_unit<false>(cache_cmp, page_table + b * NPAGES, b0, WCF, PEB, KCS + ((size_t)b * 128 + b0) * KVW, lds, tid, wave, lane); }
        _Pragma("unroll 1") for (int rep_ = 0; rep_ < REP_5A; ++rep_) {
            const int p0 = (G == 256) ? (vcu >= 235 ? vcu - 235 : NB * 8) : vcu, pst = (G == 256) ? 21 : G;
            for (int u = p0; u < NB * 8; u += pst) { const int b = u >> 3, b0 = (u & 7) * 8;
                compress_sample_unit<true>(CKV + (size_t)b * SEQ * KVW, nullptr, b0, WCF, PEB, KCP + ((size_t)b * 64 + b0) * KVW, lds, tid, wave, lane); }
        }
        } else {
        _Pragma("unroll 1") for (int rep_ = 0; rep_ < REP_5B; ++rep_)
            for (int gi = vcu; gi < NB * 32 * 2; gi += G) ssd_a_item<8>(8 * gi, XBC, DTR, dt_bias, a_log, conv_w, conv_b, STB, DC, XCV, BCV, CCV, SCV, lds, tid, wave, lane);
        }
        }
    }}
    SEAM(5);
    if (IN(6)) {
        ssd_scan(STB, DC, out + O_PSSM, vcu * (NWAVES * 64) + tid, G * NWAVES * 64);
        asm volatile("s_waitcnt vmcnt(0)" ::: "memory"); __syncthreads();
        if (tid == 0) { __builtin_amdgcn_fence(__ATOMIC_RELEASE, "agent"); asm volatile("s_waitcnt vmcnt(0)" ::: "memory"); (void)xb_add((unsigned*)(ctl + CW_SCAN), 1u); }
        _Pragma("unroll 1") for (int rep_ = 0; rep_ < REP_6; ++rep_) {
            const int npu = (1024 - vcu + G - 1) / G, nsu = IN(7) ? ((G == 256) ? ((vcu & 1) ? 0 : 1) : (SBAT * 4 - vcu + G - 1) / G) : 0;
            const int spos = (G == 256) ? ((vcu >> 1) & 3) : npu;
            bool fresh = true;
            for (int st = 0; st < npu + nsu; ++st) {
                if (st >= spos && st < spos + nsu) {
                    const int su = (G == 256) ? (vcu >> 1) : vcu + (st - spos) * G;
                    attn_sample_unit(su >> 2, su & 3, QB, QS32, KCS, KCS32, SKV, WKV, cache_slc, cache_win, page_table, GATES, rel_table, MIX, SSQA, out, lds, tid, wave, lane);
                    fresh = true;
                } else {
                    const int u = vcu + (st < spos ? st : st - nsu) * G;
                    const int slot = u >> 8, w = u & 255, bk = w >> 4, jj = w & 15;
                    const int ih = jj >> 1, od = jj & 1;
                    const int qb = (G != 256) ? (slot == 0 ? jj : (slot == 1 ? 31 - jj : (slot == 2 ? 32 + jj : 63 - jj)))
                                 : (slot == 0 ? jj : (slot == 1 ? 31 - jj : (slot == 2 ? 32 + 8 * od + ih : 55 + 8 * od - ih)));
                    attn_prompt_unit(fresh || G != 256, bk >> 2, bk & 3, qb, QB, KCP, SKV, WKV, GATES, rel_table, KMP, MIX, SSQA, lds, tid, wave, lane);
                    fresh = false;
                }
            }
        }
    }
    if (IN(6) != IN(7)) SEAM(6);
    if (IN(7)) {
    {
        const int c_lo = (G == 256) ? (vcu >> 1) * 8 : vcu, c_n = (G == 256) ? ((vcu & 1) ? 8 : 0) : (1024 - vcu + G - 1) / G, c_st = (G == 256) ? 1 : G;
        if (c_n > 0 && IN(6)) {
            if (tid == 0) { unsigned* bw_ = (unsigned*)(ctl + CW_BAR); XB_SPIN(xb_ld((unsigned*)(ctl + CW_SCAN)) < (unsigned)G, bw_);
                __builtin_amdgcn_fence(__ATOMIC_ACQUIRE, "agent"); asm volatile("s_waitcnt vmcnt(0)" ::: "memory"); }
            __syncthreads();
        }
        _Pragma("unroll 1") for (int rep_ = 0; rep_ < REP_7B; ++rep_) {
            if (c_st == 1) ssd_c_pair_run(c_lo, c_n, XCV, BCV, CCV, SCV, d_skip, STB, ZB, MIX, SSQY, lds, tid, wave, lane);
            else for (int k = 0, u = c_lo; k < c_n; ++k, u += c_st) ssd_c_pair_run(u, 1, XCV, BCV, CCV, SCV, d_skip, STB, ZB, MIX, SSQY, lds, tid, wave, lane);
        }
        _Pragma("unroll 1") for (int rep_ = 0; rep_ < REP_7C; ++rep_) {
            const int s0 = (G == 256) ? ((vcu & 1) ? vcu >> 1 : SBAT * 16) : vcu, sst = (G == 256) ? 128 : G;
            for (int u = s0; u < SBAT * 16; u += sst) ssd_sample_unit(u, XBC, DTR, dt_bias, a_log, conv_w, conv_b, d_skip, state_ssm, state_conv, ZB, MIX, SSQY, out + O_SSSM, lds, tid);
        }
    }}
    SEAM(7);
    if (IN(9)) {
    _Pragma("unroll") for (int rep_ = 0; rep_ < REP_9; ++rep_) {
        pg8::Gemm g{MIX, WOUT, MT, DM, DMIX}; MixedOrder S; S.S.init(NPR, DM, G, bx, DMIX); S.nks = DMIX / 256;
        {
            pg8::Unit u0, u1; const bool h0_ = S.next(0, u0), h1_ = S.next(1, u1);
            if (h0_) rs_fill((LAS float*)(lds + 131072), u0.pm, SSQA, SSQY, tid);
            if (h1_) rs_fill((LAS float*)(lds + 131072), u1.pm, SSQA, SSQY, tid);
            __syncthreads();
        }
        EpiOutProj E{(bf16*)O32, PART, (const LAS float*)(lds + 131072)};
        pg8::gemm_phase<EpiOutProj, MixedOrder, true, true>(lds, g, S, E);
        {
            int ln = lane; asm volatile("" : "+v"(ln));
            LAS float* scr = (LAS float*)(lds + wave * 16896);
            const int first = (G == 256) ? 4 * (DMIX / 256) : 0;
            if (bx >= first) for (int it = (bx - first) * NWAVES + wave; it < (DFF / 64) * (DM / 64); it += (G - first) * NWAVES)
                transpose_item64<1>(ffn2_w_out, DFF, DM, W2B, nullptr, nullptr, scr, it, DM / 64, ln);
        }
    }}
    SEAM(9);
    if (IN(10)) {
        int ln = lane; asm volatile("" : "+v"(ln));
        for (int m = gw; m < NPR; m += 2 * NGW) {
            RowRegs ra, rb; const int m2 = (m + NGW < NPR) ? m + NGW : m;
            row_load(ra, X1 + (size_t)m * DM, (const bf16*)O32 + (size_t)m * DM, ln); row_load(rb, X1 + (size_t)m2 * DM, (const bf16*)O32 + (size_t)m2 * DM, ln);
            row_finish(ra, mix_post, 1.0f, X1 + (size_t)m * DM, ffn2_pre, XN + (size_t)m * DM, ln, false);
            row_finish(rb, mix_post, 1.0f, X1 + (size_t)m2 * DM, ffn2_pre, XN + (size_t)m2 * DM, ln, false);
        }
        for (int m = NPR + gw; m < MT; m += NGW)
            row_post<false>(X1 + (size_t)m * DM, PART + (size_t)(m - NPR) * DM, DMIX / 256, (size_t)NSA * DM, mix_post, 1.0f, X1 + (size_t)m * DM, ffn2_pre, XN + (size_t)m * DM, ln);
    }
    SEAM(10);
    if (IN(11)) {
    _Pragma("unroll") for (int rep_ = 0; rep_ < REP_11; ++rep_) {
        pg8::Gemm g{XN, W2A, MT, 2 * DFF, DM}; pg8::StaticOrder S; S.init(MT, 2 * DFF, G, bx, DM);
        EpiSwiglu E{ACT};
        pg8::gemm_phase<EpiSwiglu, pg8::StaticOrder, true, true>(lds, g, S, E);
        {
            const int first = (G == 256) ? (65 * 22) % 256 : 0, nw_ = (G - first) * NWAVES, w0 = (bx - first) * NWAVES + wave;
            if (bx >= first) for (int r = w0; r < SBAT * 504; r += nw_) {
                const int b = r / 504, j = r % 504;
                const GAS f32x4* s_ = (const GAS f32x4*)(cache_win + ((size_t)b * 512 + j + 8) * KVW) + lane;
                GAS f32x4* d_ = (GAS f32x4*)(out + O_SWIN + ((size_t)b * 512 + j) * KVW) + lane;
                __builtin_nontemporal_store(s_[0], d_); __builtin_nontemporal_store(s_[64], d_ + 64);
            }
        }
    }}
    SEAM(11);
    if (IN(12)) {
    _Pragma("unroll") for (int rep_ = 0; rep_ < REP_12; ++rep_) {
        pg8::Gemm g{ACT, W2B, MT, DM, DFF}; MixedOrder S; S.S.init(NPR, DM, G, bx, DFF); S.nks = DFF / 256; EpiF32Mixed E{XN  , PART};
        pg8::gemm_phase<EpiF32Mixed, MixedOrder, true, true>(lds, g, S, E);
    }}
    SEAM(12);
    if (IN(13)) {
    _Pragma("unroll 1") for (int rep13_ = 0; rep13_ < REP_13; ++rep13_) {
        int ln = lane; asm volatile("" : "+v"(ln));
        for (int m = gw; m < NPR; m += 2 * NGW) {
            RowRegs2 ra, rb; const int m2 = (m + NGW < NPR) ? m + NGW : m;
            row_load2(ra, X1 + (size_t)m * DM, (const bf16*)O32 + (size_t)m * DM, XN + (size_t)m * DM, ln); row_load2(rb, X1 + (size_t)m2 * DM, (const bf16*)O32 + (size_t)m2 * DM, XN + (size_t)m2 * DM, ln);
            row_finish2(ra, mix_post, ffn2_post, 0.5f, out + (size_t)m * DM, ln);
            row_finish2(rb, mix_post, ffn2_post, 0.5f, out + (size_t)m2 * DM, ln);
        }
        for (int m = NPR + gw; m < MT; m += NGW)
            row_post<false>(X1 + (size_t)m * DM, PART + (size_t)(m - NPR) * DM, DFF / 256, (size_t)NSA * DM, ffn2_post, 0.5f, out + (size_t)m * DM, nullptr, nullptr, ln);
    }}

#undef IN
#undef SEAM
}

#undef x_prompt
#undef x_sample
#undef cache_cmp
#undef cache_slc
#undef cache_win
#undef state_ssm
#undef state_conv
#undef page_table
#undef rel_table
#undef ffn1_pre
#undef ffn1_post
#undef ffn1_w_in
#undef ffn1_w_out
#undef mix_pre
#undef mix_post
#undef w_in
#undef w_out
#undef att_out_norm
#undef cmp_pe
#undef w_cmp
#undef conv_w
#undef conv_b
#undef dt_bias
#undef a_log
#undef d_skip
#undef ssd_norm
#undef ffn2_pre
#undef ffn2_post
#undef ffn2_w_in
#undef ffn2_w_out
#undef W1A
#undef W1B
#undef WIN
#undef WOUT
#undef W2A
#undef W2B
#undef WCF
#undef PEB
#undef WCFL
#undef QS32
#undef KCS32
#undef GATES
#undef DTR
#undef SSQA
#undef SSQY
#undef DC
#undef KCP
#undef KCS
#undef XN
#undef QB
#undef CKV
#undef SKV
#undef WKV
#undef ZB
#undef XBC
#undef ACT
#undef O32
#undef X1
#undef MIX
#undef STB
#undef PART
#undef KMP
#undef XCV
#undef BCV
#undef CCV
#undef SCV
extern "C" void kernel_launch(void* const* d_in, const int* in_sizes, int n_in, void* d_out, int out_size, void* d_ws, size_t ws_size, hipStream_t stream) {
    static int grid = 0;
    if (grid == 0) {
        if (n_in != 30 || out_size != (int)O_END || ws_size < WS_END) { fprintf(stderr, "kernel_launch: unexpected shapes n_in %d out %d ws %zu\n", n_in, out_size, ws_size); grid = -1; return; }
        int dev = 0, cus = 0, per_cu = 0;
        if (hipGetDevice(&dev) != hipSuccess || hipDeviceGetAttribute(&cus, hipDeviceAttributeMultiprocessorCount, dev) != hipSuccess) { grid = -1; return; }
        if (hipFuncSetAttribute((const void*)mk_fwd, hipFuncAttributeMaxDynamicSharedMemorySize, LDS_BYTES) != hipSuccess) { fprintf(stderr, "kernel_launch: hipFuncSetAttribute failed\n"); grid = -1; return; }
        if (hipOccupancyMaxActiveBlocksPerMultiprocessor(&per_cu, (const void*)mk_fwd, NWAVES * 64, LDS_BYTES) != hipSuccess || per_cu < 1) { fprintf(stderr, "kernel_launch: occupancy query says %d\n", per_cu); }
        (void)hipGetLastError();
        grid = cus;
    }
    if (grid < 0) return;
    if (hipMemsetAsync((char*)d_ws + WS_CTL, 0, CTL_ZERO_BYTES, stream) != hipSuccess) return;
    Args a{};
    for (int i = 0; i < 30; ++i) a.in[i] = (const float*)d_in[i];
    a.out = (float*)d_out; a.ws = (unsigned char*)d_ws; a.ph_lo = 0; a.ph_hi = N_PHASES;
    hipLaunchKernelGGL(mk_fwd, dim3(grid), dim3(NWAVES * 64), LDS_BYTES, stream, a);
}
```

```cpp
#include <hip/hip_runtime.h>
#include <cstdio>
#include <cstdint>
namespace pg8 {
#define PG8_LAS __attribute__((address_space(3)))
typedef unsigned short bf16_t;
typedef short bf16x8 __attribute__((ext_vector_type(8)));
typedef float f32x4 __attribute__((ext_vector_type(4)));
typedef unsigned u32x4 __attribute__((ext_vector_type(4)));
constexpr int BM = 256, BK = 64, HALF = 128, HTB = HALF * BK * 2  , STAGE_BYTES = 8 * HTB, NXCD = 8, WGM = 8;

__host__ __device__ __forceinline__ int lds_byte(int r, int c) { const int st = (r >> 4) * 2 + (c >> 5), rr = r & 15, cc = c & 31, ob = rr * 64 + cc * 2; return st * 1024 + (ob ^ (((ob >> 9) & 1) << 5)); }
__host__ __device__ __forceinline__ void stage_rc(int b, int& R, int& C) { const int st = b / 1024, sb = b % 1024, swz = sb ^ (((sb >> 9) & 1) << 5); R = (st >> 1) * 16 + swz / 64; C = (st & 1) * 32 + (swz % 64) / 2; }
__host__ __device__ __forceinline__ int perm32(int rho) { const int n = rho >> 4, i = rho & 15; return 8 * (i >> 2) + 4 * n + (i & 3); }

struct Unit { int pm, pn, ko, kl; };
struct Gemm { const bf16_t* A; const bf16_t* Bt; int M, N, K; };

struct StaticOrder {
    int nM, nN, nwg, G, c, kfull;
    __host__ __device__ void init(int M, int N, int G_, int c_, int K_) { nM = M / BM; nN = N / BM; nwg = nM * nN; G = G_; c = c_; kfull = K_; }
    __host__ __device__ __forceinline__ bool next(int i, Unit& u) const {
        const long L = (long)i * G + c; if (L >= nwg) return false;
        int wgid = (int)L; { const int q = nwg / NXCD, r = nwg % NXCD, xcd = wgid % NXCD, off = wgid / NXCD; wgid = (xcd < r ? xcd * (q + 1) : r * (q + 1) + (xcd - r) * q) + off; }
        const int nig = WGM * nN, gid = wgid / nig, fm = gid * WGM, gsz = (nM - fm) < WGM ? (nM - fm) : WGM;
        u.pm = fm + ((wgid % nig) % gsz); u.pn = (wgid % nig) / gsz; u.ko = 0; u.kl = kfull; return true;
    }
    __device__ __forceinline__ void a_ready(const Unit&) const {}
    __device__ __forceinline__ void done(const Unit&) const {}
};

__device__ __forceinline__ unsigned cvt_pk_bf16(float lo, float hi) { unsigned r; asm volatile("v_cvt_pk_bf16_f32 %0, %1, %2" : "=v"(r) : "v"(lo), "v"(hi)); return r; }
template <class Epi, class Sched, bool ALIGN_EPI = false, bool SP2 = false>
__device__ __forceinline__ void gemm_phase(PG8_LAS unsigned char* lds, const Gemm g, const Sched& S, const Epi& E) {
    int tid_ = threadIdx.x; asm volatile("" : "+v"(tid_));
    const int tid = tid_, wid = __builtin_amdgcn_readfirstlane(tid >> 6), lane = tid & 63, wr = wid >> 2, wc = wid & 3, fr = lane & 15, fq = lane >> 4;
    const int K = g.K; int nt;
    unsigned voffA[2], voffB[2];
#pragma unroll
    for (int i = 0; i < 2; ++i) { int R, C; stage_rc(tid * 16 + i * 8192, R, C); const int Rb = Epi::PERM ? ((R & ~31) + perm32(R & 31)) : R;
        voffA[i] = (unsigned)(R * K + C) * 2u; voffB[i] = (unsigned)(Rb * K + C) * 2u; }
    const size_t kstep = (size_t)(BK * 2);
    const size_t hstep = (size_t)HALF * K * 2;
    const size_t tstep = 2 * hstep;
    const unsigned ldsw = (unsigned)wid * 1024u;
    const int aoff = lds_byte(wr * 64 + fr, fq * 8), boff = lds_byte(wc * 32 + fr, fq * 8);
#define PG8_SA(b, h) (((b) * 2 + (h)) * HTB)
#define PG8_SB(b, h) ((4 + (b) * 2 + (h)) * HTB)
#define PG8_STAGE(bufoff, gbase, voff) do { _Pragma("unroll") for (int _i = 0; _i < 2; ++_i) \
        __builtin_amdgcn_global_load_lds((const unsigned*)((const char*)(gbase) + (voff)[_i]), (PG8_LAS unsigned*)(lds + (bufoff) + ldsw + _i * 8192), 16, 0, 0); } while (0)
#define PG8_LDA(dst, b, h) do { _Pragma("unroll") for (int m = 0; m < 4; ++m) _Pragma("unroll") for (int k = 0; k < 2; ++k) dst[m][k] = *(const PG8_LAS bf16x8*)(lds + PG8_SA(b, h) + aoff + m * 2048 + k * 1024); } while (0)
#define PG8_LDB(dst, b, h) do { _Pragma("unroll") for (int n = 0; n < 2; ++n) _Pragma("unroll") for (int k = 0; k < 2; ++k) dst[n][k] = *(const PG8_LAS bf16x8*)(lds + PG8_SB(b, h) + boff + n * 2048 + k * 1024); } while (0)
#define PG8_MMA(ai, bj, At, Bt) do { __builtin_amdgcn_s_setprio(1); _Pragma("unroll") for (int m = 0; m < 4; ++m) _Pragma("unroll") for (int n = 0; n < 2; ++n) _Pragma("unroll") for (int k = 0; k < 2; ++k) \
        acc[ai][bj][m][n] = __builtin_amdgcn_mfma_f32_16x16x32_bf16(Bt[n][k], At[m][k], acc[ai][bj][m][n], 0, 0, 0); __builtin_amdgcn_s_setprio(0); } while (0)
#define PG8_WAIT_V(n) asm volatile("s_waitcnt vmcnt(" #n ")" ::: "memory")
#define PG8_WAIT_L(n) asm volatile("s_waitcnt lgkmcnt(" #n ")" ::: "memory")
#define PG8_BAR __builtin_amdgcn_s_barrier()
#define PG8_SCHED __builtin_amdgcn_sched_barrier(0)
    Unit cur, nxt; int ui = 0;
    if (!S.next(0, cur)) return;
    nt = cur.kl / BK;
    f32x4 acc[2][2][4][2];
#pragma unroll
    for (int a = 0; a < 2; ++a)
#pragma unroll
        for (int b = 0; b < 2; ++b)
#pragma unroll
            for (int m = 0; m < 4; ++m)
#pragma unroll
                for (int n = 0; n < 2; ++n) acc[a][b][m][n] = (f32x4){0.f, 0.f, 0.f, 0.f};
    bf16x8 At[4][2], B0[2][2], B1[2][2];
    const char* cA = (const char*)g.A + (size_t)cur.pm * tstep + (size_t)cur.ko * 2; const char* cB = (const char*)g.Bt + (size_t)cur.pn * tstep + (size_t)cur.ko * 2;
    S.a_ready(cur);
    if constexpr (SP2) {
        PG8_STAGE(PG8_SB(0, 0), cB, voffB); PG8_STAGE(PG8_SB(0, 1), cB + hstep, voffB); PG8_STAGE(PG8_SA(0, 0), cA, voffA); PG8_STAGE(PG8_SA(0, 1), cA + hstep, voffA);
        if (wr == 1) PG8_BAR;
        PG8_WAIT_V(2); PG8_BAR;
        PG8_STAGE(PG8_SB(1, 0), cB + kstep, voffB); PG8_STAGE(PG8_SA(1, 0), cA + kstep, voffA); PG8_STAGE(PG8_SB(1, 1), cB + hstep + kstep, voffB);
        PG8_WAIT_V(6); PG8_BAR;
    } else {
        PG8_STAGE(PG8_SB(0, 0), cB, voffB); PG8_STAGE(PG8_SA(0, 0), cA, voffA); PG8_STAGE(PG8_SB(0, 1), cB + hstep, voffB); PG8_STAGE(PG8_SA(0, 1), cA + hstep, voffA);
        if (wr == 1) PG8_BAR;
        PG8_WAIT_V(4); PG8_BAR;
        PG8_STAGE(PG8_SB(1, 0), cB + kstep, voffB); PG8_STAGE(PG8_SA(1, 0), cA + kstep, voffA); PG8_STAGE(PG8_SB(1, 1), cB + hstep + kstep, voffB);
        PG8_WAIT_V(6); PG8_BAR;
    }
    for (;;) {
        const bool has_next = S.next(ui + 1, nxt);
        const char* nA = has_next ? (const char*)g.A + (size_t)nxt.pm * tstep + (size_t)nxt.ko * 2 : cA; const char* nB = has_next ? (const char*)g.Bt + (size_t)nxt.pn * tstep + (size_t)nxt.ko * 2 : cB;
        for (int t = 0; t < nt; t += 2) {
            if constexpr (Epi::KHOOK) { if ((t == 16 || t == 24) && cur.pm != 64) E.khook(t, acc, wr, fr); }
            const bool last = (t == nt - 2);
            const char* a1 = cA + (size_t)(t + 1) * kstep;
            const char* a2 = last ? nA : cA + (size_t)(t + 2) * kstep; const char* b2 = last ? nB : cB + (size_t)(t + 2) * kstep;
            const char* a3 = a2 + kstep; const char* b3 = b2 + kstep;
            if (last && has_next) S.a_ready(nxt);
            if constexpr (SP2) {
            PG8_LDB(B0, 0, 0); PG8_LDB(B1, 0, 1); PG8_SCHED; PG8_LDA(At, 0, 0); PG8_STAGE(PG8_SA(1, 1), a1 + hstep, voffA);
            PG8_WAIT_V(8); PG8_WAIT_L(0); PG8_BAR; PG8_MMA(0, 0, At, B0); PG8_MMA(0, 1, At, B1); PG8_BAR; PG8_SCHED;
            PG8_LDA(At, 0, 1); PG8_STAGE(PG8_SB(0, 0), b2, voffB); PG8_STAGE(PG8_SB(0, 1), b2 + hstep, voffB); PG8_STAGE(PG8_SA(0, 0), a2, voffA);
            PG8_WAIT_V(8); PG8_WAIT_L(0); PG8_BAR; PG8_MMA(1, 0, At, B0); PG8_MMA(1, 1, At, B1); PG8_BAR; PG8_SCHED;
            PG8_LDB(B0, 1, 0); PG8_LDB(B1, 1, 1); PG8_SCHED; PG8_LDA(At, 1, 0); PG8_STAGE(PG8_SA(0, 1), a2 + hstep, voffA);
            PG8_WAIT_V(8); PG8_WAIT_L(0); PG8_BAR; PG8_MMA(0, 0, At, B0); PG8_MMA(0, 1, At, B1); PG8_BAR; PG8_SCHED;
            PG8_LDA(At, 1, 1); PG8_STAGE(PG8_SB(1, 0), b3, voffB); PG8_STAGE(PG8_SB(1, 1), b3 + hstep, voffB); PG8_STAGE(PG8_SA(1, 0), a3, voffA);
            PG8_WAIT_V(8); PG8_WAIT_L(0); PG8_BAR; PG8_MMA(1, 0, At, B0); PG8_MMA(1, 1, At, B1); PG8_BAR; PG8_SCHED;
            } else {
            PG8_LDB(B0, 0, 0); PG8_SCHED; PG8_LDA(At, 0, 0); PG8_STAGE(PG8_SA(1, 1), a1 + hstep, voffA);
            PG8_WAIT_L(8); PG8_BAR; PG8_WAIT_L(0); PG8_MMA(0, 0, At, B0); PG8_BAR; PG8_SCHED;
            PG8_LDB(B1, 0, 1); PG8_STAGE(PG8_SB(0, 0), b2, voffB);
            PG8_BAR; PG8_WAIT_L(0); PG8_MMA(0, 1, At, B1); PG8_BAR;
            PG8_LDA(At, 0, 1); PG8_STAGE(PG8_SA(0, 0), a2, voffA);
            PG8_BAR; PG8_WAIT_L(0); PG8_MMA(1, 0, At, B0); PG8_BAR; PG8_SCHED;
            PG8_STAGE(PG8_SB(0, 1), b2 + hstep, voffB);
            PG8_WAIT_V(6); PG8_BAR; PG8_MMA(1, 1, At, B1); PG8_BAR;
            PG8_LDB(B0, 1, 0); PG8_SCHED; PG8_LDA(At, 1, 0); PG8_STAGE(PG8_SA(0, 1), a2 + hstep, voffA);
            PG8_WAIT_L(8); PG8_BAR; PG8_WAIT_L(0); PG8_MMA(0, 0, At, B0); PG8_BAR; PG8_SCHED;
            PG8_LDB(B1, 1, 1); PG8_STAGE(PG8_SB(1, 0), b3, voffB);
            PG8_BAR; PG8_WAIT_L(0); PG8_MMA(0, 1, At, B1); PG8_BAR;
            PG8_LDA(At, 1, 1); PG8_STAGE(PG8_SA(1, 0), a3, voffA);
            PG8_BAR; PG8_WAIT_L(0); PG8_MMA(1, 0, At, B0); PG8_BAR; PG8_SCHED;
            PG8_STAGE(PG8_SB(1, 1), b3 + hstep, voffB);
            PG8_WAIT_V(6); PG8_BAR; PG8_MMA(1, 1, At, B1); PG8_BAR;
            }
        }
        if constexpr (ALIGN_EPI) { if (wr == 0) PG8_BAR; }
        if constexpr (!Epi::AFTER_DRAIN) { E(acc, cur, wr, wc, fr, fq); S.done(cur); }
        if (!has_next) break;
#pragma unroll
        for (int a = 0; a < 2; ++a)
#pragma unroll
            for (int b = 0; b < 2; ++b)
#pragma unroll
                for (int m = 0; m < 4; ++m)
#pragma unroll
                    for (int n = 0; n < 2; ++n) acc[a][b][m][n] = (f32x4){0.f, 0.f, 0.f, 0.f};
        cur = nxt; cA = nA; cB = nB; ++ui; nt = cur.kl / BK;
        if constexpr (ALIGN_EPI) { if (wr == 1) PG8_BAR; }
    }
    PG8_WAIT_V(0);
    if constexpr (!ALIGN_EPI) { if (wr == 0) PG8_BAR; }
    PG8_BAR;
    if constexpr (Epi::AFTER_DRAIN) { E.fused(acc, cur, wr, wc, fr, fq, lds, wid, lane); S.done(cur); }
#undef PG8_SA
#undef PG8_SB
#undef PG8_STAGE
#undef PG8_LDA
#undef PG8_LDB
#undef PG8_MMA
#undef PG8_WAIT_V
#undef PG8_WAIT_L
#undef PG8_BAR
#undef PG8_SCHED
}
}
#define GAS __attribute__((address_space(1)))
#define LAS __attribute__((address_space(3)))
typedef unsigned short bf16;
typedef unsigned v4u __attribute__((ext_vector_type(4)));
typedef float f32x4 __attribute__((ext_vector_type(4)));
typedef short bf16x8 __attribute__((ext_vector_type(8)));
typedef GAS unsigned gu32;
typedef GAS unsigned long long gu64;
#define RLX_AGENT __ATOMIC_RELAXED, __HIP_MEMORY_SCOPE_AGENT
#define LDS_WAIT() asm volatile("s_waitcnt lgkmcnt(0)" ::: "memory")
#define VM_WAIT() asm volatile("s_waitcnt vmcnt(0)" ::: "memory")
__device__ __forceinline__ unsigned long long rt() { return __builtin_amdgcn_s_memrealtime(); }
__device__ __forceinline__ unsigned f2bf(float f) { unsigned u = __builtin_bit_cast(unsigned, f); return (u + 0x7fffu + ((u >> 16) & 1u)) >> 16; }
typedef float pk2_f32x2_t __attribute__((ext_vector_type(2))); typedef __bf16 pk2_bf16x2_t __attribute__((ext_vector_type(2)));
__device__ __forceinline__ unsigned pk2(float lo, float hi) { pk2_f32x2_t v = {lo, hi}; pk2_bf16x2_t b = __builtin_convertvector(v, pk2_bf16x2_t); return __builtin_bit_cast(unsigned, b); }
#define XB_TMO      128
#define XB_XCNT(j)  (256  + 64 * (j))
#define XB_XSUB(j)  (1280 + 64 * (j))
#define XB_XGEN(j)  (2304 + 64 * (j))
#define XB_TOP      3328
#define XB_TOPGEN   3392
#define XCD_BAR_WORDS 3456
#define XB_SPIN_CAP (1u << 18)

__device__ __forceinline__ unsigned xb_ld(unsigned* p)              { return __hip_atomic_load(p, __ATOMIC_RELAXED, __HIP_MEMORY_SCOPE_AGENT); }
__device__ __forceinline__ unsigned xb_add(unsigned* p, unsigned v) { return __hip_atomic_fetch_add(p, v, __ATOMIC_RELAXED, __HIP_MEMORY_SCOPE_AGENT); }
__device__ __forceinline__ unsigned xb_xcc_id() { return (unsigned)__builtin_amdgcn_s_getreg((3 << 11) | 20) & 0xFu; }
#define XB_SPIN(cond, bar) do { unsigned _sp = 0; while (cond) { __builtin_amdgcn_s_sleep(1); \
    if ((++_sp & 255u) == 0u) { if (xb_ld(&(bar)[XB_TMO])) break; if (_sp > XB_SPIN_CAP) { atomicAdd(&(bar)[XB_TMO], 1u); break; } } } } while (0)

struct XcdBarrier {
    unsigned* bar; unsigned x;
    volatile LAS unsigned* st;
};

__device__ __forceinline__ XcdBarrier xcd_barrier_post(unsigned* bar, volatile LAS unsigned* st) {
    XcdBarrier b; b.bar = bar; b.x = xb_xcc_id(); b.st = st;
    if (threadIdx.x == 0) (void)xb_add(&bar[XB_XCNT(b.x)], 1u);
    return b;
}
__device__ __forceinline__ void xcd_barrier_complete(unsigned* bar, unsigned x, unsigned& nloc, unsigned& nx) {
    const unsigned G = gridDim.x * gridDim.y * gridDim.z;
    unsigned sum, cnt, mine, sp = 0u;
    for (;;) {
        sum = 0u; cnt = 0u; mine = 0u;
#pragma unroll
        for (unsigned j = 0; j < 16; ++j) { const unsigned c = xb_ld(&bar[XB_XCNT(j)]); sum += c; cnt += (c > 0u) ? 1u : 0u; mine = (j == x) ? c : mine; }
        if (sum == G) break;
        __builtin_amdgcn_s_sleep(1);
        if ((++sp & 255u) == 0u) { if (xb_ld(&bar[XB_TMO])) break; if (sp > XB_SPIN_CAP) { atomicAdd(&bar[XB_TMO], 1u); break; } }
    }
    nloc = mine > 0u ? mine : 1u; nx = cnt > 0u ? cnt : 1u;
}

__device__ __forceinline__ void xcd_barrier(const XcdBarrier& b) {
    asm volatile("s_waitcnt vmcnt(0)" ::: "memory");
    __syncthreads();
    if (threadIdx.x == 0) {
        unsigned* bar = b.bar;
        __builtin_amdgcn_s_waitcnt(0);
        unsigned nloc = b.st[0], nx = b.st[1];
        if (nloc == 0u) { xcd_barrier_complete(bar, b.x, nloc, nx); b.st[0] = nloc; b.st[1] = nx; }
        const unsigned old = xb_add(&bar[XB_XSUB(b.x)], 1u);
        const unsigned gen = old / nloc;
        if (old + 1u == (gen + 1u) * nloc) {
            __builtin_amdgcn_fence(__ATOMIC_RELEASE, "agent");
            asm volatile("s_waitcnt vmcnt(0)" ::: "memory");
            const unsigned og = xb_add(&bar[XB_TOP], 1u);
            const unsigned tg = og / nx;
            if (og + 1u == (tg + 1u) * nx) xb_add(&bar[XB_TOPGEN], 1u);
            else XB_SPIN(xb_ld(&bar[XB_TOPGEN]) == tg, bar);
            __builtin_amdgcn_fence(__ATOMIC_ACQUIRE, "agent");
            xb_add(&bar[XB_XGEN(b.x)], 1u);
            asm volatile("s_waitcnt vmcnt(0)" ::: "memory");
        } else {
            XB_SPIN(xb_ld(&bar[XB_XGEN(b.x)]) == gen, bar);
            __builtin_amdgcn_fence(__ATOMIC_ACQUIRE, "agent");
            asm volatile("s_waitcnt vmcnt(0)" ::: "memory");
        }
    }
    __syncthreads();
}

constexpr int NWAVES = 8;
constexpr int DM = 1024, NB = 4, SEQ = 4096, NPR = NB * SEQ, SBAT = 32, STOK = 8, NSA = SBAT * STOK, MT = NPR + NSA;
constexpr int DFF = 2816, DIN = 5184, DINP = 5376, DMIX = 2048, KVW = 512, CONVD = 1536;
constexpr int PAST = 8192, NPAGES = 64, NPB = 128;
constexpr float EPS = 1e-6f;
constexpr float C2 = 0.125f * 1.4426950408889634f;
constexpr float LOG2E = 1.4426950408889634f;

constexpr size_t O_YP = 0, O_YS = 16777216, O_PCMP = 17039360, O_PSLC = 25427968, O_PWIN = 33816576, O_PSSM = 34865152, O_PCONV = 35389440,
                 O_SCMP = 35407872, O_SSLC = 35538944, O_SWIN = 35670016, O_SSSM = 44058624, O_SCONV = 48252928, O_END = 48400384;

constexpr size_t MiB = 1u << 20;
constexpr size_t WS_CTL = 0, CTL_ZERO_BYTES = 1 * MiB;
constexpr size_t WS_W1A = 2 * MiB, WS_W1B = 13 * MiB, WS_WIN = 19 * MiB, WS_WOUT = 30 * MiB, WS_W2A = 34 * MiB, WS_W2B = 45 * MiB, WS_WCF = 51 * MiB, WS_PEB = 52 * MiB, WS_KMP = 52 * MiB + 655360, WS_WCFL = 52 * MiB + 65536, WS_QS32 = 69 * MiB, WS_KCS32 = 618 * MiB, WS_PART = 624 * MiB;
constexpr size_t WS_GATES = 53 * MiB, WS_DT = 57 * MiB, WS_SSQA = 59 * MiB, WS_SSQY = 61 * MiB, WS_DC = 63 * MiB, WS_KCP = 64 * MiB, WS_KCS = 65 * MiB;
constexpr size_t WS_XN = 70 * MiB, WS_Q = 103 * MiB, WS_CKV = 136 * MiB, WS_SKV = 153 * MiB, WS_WKV = 170 * MiB, WS_Z = 187 * MiB, WS_XBC = 220 * MiB;
constexpr size_t WS_XCV = 269 * MiB, WS_BCV = 301 * MiB, WS_CCV = 309 * MiB, WS_SCV = 317 * MiB;
constexpr size_t WS_ACT = 269 * MiB, WS_O32 = 359 * MiB, WS_X1 = 424 * MiB, WS_MIX = 489 * MiB, WS_ST = 554 * MiB, WS_END = 636 * MiB;
constexpr int CW_BAR = 4096, CW_KMAX = 8192, CW_SCAN = 12288;

constexpr int LDS_BYTES = 163840;
constexpr int MISC_OFF = LDS_BYTES - 256;

__device__ __forceinline__ float wave_sum(float v) {
#pragma unroll
    for (int o = 1; o < 64; o <<= 1) v += __shfl_xor(v, o);
    return v;
}
__device__ __forceinline__ float fast_exp2(float x) { return __builtin_amdgcn_exp2f(x); }
__device__ __forceinline__ float fast_rcp(float x) { return __builtin_amdgcn_rcpf(x); }
__device__ __forceinline__ float silu_f(float x) { return x * fast_rcp(1.0f + fast_exp2(-x * LOG2E)); }
__device__ __forceinline__ float sigmoid_f(float x) { return fast_rcp(1.0f + fast_exp2(-x * LOG2E)); }
typedef float f32x2_t __attribute__((ext_vector_type(2))); typedef __bf16 bf16x2_t __attribute__((ext_vector_type(2)));
__device__ __forceinline__ unsigned cvtpk(float lo, float hi) { f32x2_t v = {lo, hi}; bf16x2_t b = __builtin_convertvector(v, bf16x2_t); return __builtin_bit_cast(unsigned, b); }
__device__ __forceinline__ float bf2f(unsigned short h) { return __uint_as_float(((unsigned)h) << 16); }

struct EpiSwiglu {
    static constexpr bool PERM = true, AFTER_DRAIN = false, KHOOK = false;
    bf16* O;
    __device__ __forceinline__ void operator()(const pg8::f32x4 (&acc)[2][2][4][2], const pg8::Unit& u, int wr, int wc, int fr, int fq) const {
        const int row0 = u.pm * 256 + wr * 64 + fr, col0 = u.pn * 128 + wc * 32 + 8 * fq;
#pragma unroll
        for (int ai = 0; ai < 2; ++ai)
#pragma unroll
            for (int m = 0; m < 4; ++m) {
                bf16* rowp = O + (size_t)(row0 + ai * 128 + m * 16) * DFF + col0;
                const pg8::f32x4 g0 = acc[ai][0][m][0], g1 = acc[ai][0][m][1], u0 = acc[ai][1][m][0], u1 = acc[ai][1][m][1];
                pg8::u32x4 w;
                w.x = cvtpk(silu_f(g0[0]) * u0[0], silu_f(g0[1]) * u0[1]); w.y = cvtpk(silu_f(g0[2]) * u0[2], silu_f(g0[3]) * u0[3]);
                w.z = cvtpk(silu_f(g1[0]) * u1[0], silu_f(g1[1]) * u1[1]); w.w = cvtpk(silu_f(g1[2]) * u1[2], silu_f(g1[3]) * u1[3]);
                *(pg8::u32x4*)rowp = w;
            }
    }
};
struct EpiF32 {
    static constexpr bool PERM = false, AFTER_DRAIN = false, KHOOK = false;
    float* C;
    __device__ __forceinline__ void operator()(const pg8::f32x4 (&acc)[2][2][4][2], const pg8::Unit& u, int wr, int wc, int fr, int fq) const {
        const int row0 = u.pm * 256 + wr * 64 + fr, col0 = u.pn * 256 + wc * 32 + 4 * fq;
#pragma unroll
        for (int ai = 0; ai < 2; ++ai)
#pragma unroll
            for (int m = 0; m < 4; ++m) { float* rowp = C + (size_t)(row0 + ai * 128 + m * 16) * DM + col0;
#pragma unroll
                for (int bj = 0; bj < 2; ++bj)
#pragma unroll
                    for (int n = 0; n < 2; ++n) *(pg8::f32x4*)(rowp + bj * 128 + n * 16) = acc[ai][bj][m][n]; }
    }
};
struct MixedOrder {
    pg8::StaticOrder S; int nks;
    __device__ __forceinline__ bool next(int i, pg8::Unit& u) const {
        if (i * S.G + S.c < S.nwg) return S.next(i, u);
        const int L = i * S.G + S.c - S.nwg; if (L >= 4 * nks) return false;
        u.pm = 64; u.pn = L & 3; u.ko = (L >> 2) * 256; u.kl = 256; return true; }
    __device__ __forceinline__ void a_ready(const pg8::Unit&) const {}
    __device__ __forceinline__ void done(const pg8::Unit&) const {}
};
struct EpiF32Mixed {
    static constexpr bool PERM = true, AFTER_DRAIN = false, KHOOK = false;
    bf16* C; float* P;
    __device__ __forceinline__ void operator()(const pg8::f32x4 (&acc)[2][2][4][2], const pg8::Unit& u, int wr, int wc, int fr, int fq) const {
        const int col0 = u.pn * 256 + wc * 32 + 8 * fq;
        if (u.pm == 64) {
            float* base = P + (size_t)(u.ko >> 8) * (NSA * DM) + (size_t)(wr * 64 + fr) * DM + col0;
#pragma unroll
            for (int ai = 0; ai < 2; ++ai)
#pragma unroll
                for (int m = 0; m < 4; ++m) { float* rowp = base + (size_t)(ai * 128 + m * 16) * DM;
#pragma unroll
                    for (int bj = 0; bj < 2; ++bj) { *(pg8::f32x4*)(rowp + bj * 128) = acc[ai][bj][m][0]; *(pg8::f32x4*)(rowp + bj * 128 + 4) = acc[ai][bj][m][1]; } }
        } else {
            bf16* base = C + (size_t)(u.pm * 256 + wr * 64 + fr) * DM + col0;
#pragma unroll
            for (int ai = 0; ai < 2; ++ai)
#pragma unroll
                for (int m = 0; m < 4; ++m) { bf16* rowp = base + (size_t)(ai * 128 + m * 16) * DM;
#pragma unroll
                    for (int bj = 0; bj < 2; ++bj) { const pg8::f32x4 v0 = acc[ai][bj][m][0], v1 = acc[ai][bj][m][1];
                        pg8::u32x4 w; w.x = cvtpk(v0[0], v0[1]); w.y = cvtpk(v0[2], v0[3]); w.z = cvtpk(v1[0], v1[1]); w.w = cvtpk(v1[2], v1[3]);
                        *(pg8::u32x4*)(rowp + bj * 128) = w; } }
        }
    }
};
__device__ __forceinline__ void rs_fill(LAS float* RS, int pm, const float* SSQA, const float* SSQY, int tid) {
    if (tid < 256) {
        const size_t row = (size_t)pm * 256 + tid; float sa = 0.f, s0 = 0.f, s1 = 0.f;
        const GAS f32x4* a4 = (const GAS f32x4*)(SSQA + row * 16); const GAS f32x4* y4 = (const GAS f32x4*)(SSQY + row * 16);
#pragma unroll
        for (int q = 0; q < 4; ++q) { const f32x4 v = a4[q]; sa += (v.x + v.y) + (v.z + v.w); }
        { const f32x4 v = y4[0], w = y4[1]; s0 = ((v.x + v.y) + (v.z + v.w)) + ((w.x + w.y) + (w.z + w.w)); }
        { const f32x4 v = y4[2], w = y4[3]; s1 = ((v.x + v.y) + (v.z + v.w)) + ((w.x + w.y) + (w.z + w.w)); }
        const float ra = 1.0f / sqrtf(sa * (1.f / 1024.f) + EPS), r0 = 1.0f / sqrtf(s0 * (1.f / 512.f) + EPS), r1 = 1.0f / sqrtf(s1 * (1.f / 512.f) + EPS);
        LAS f32x4* r = (LAS f32x4*)(RS + ((pm == 64 ? 1 : 0) * 256 + tid) * 4);
        *r = (pm == 64) ? (f32x4){ra, r0, r1, 0.f} : (f32x4){ra / r0, r0 / r1, r1, 0.f};
    }
}
struct EpiOutProj {
    static constexpr bool PERM = true, AFTER_DRAIN = false, KHOOK = true;
    bf16* C; float* P; const LAS float* RS;
    __device__ __forceinline__ void khook(int t, pg8::f32x4 (&acc)[2][2][4][2], int wr, int fr) const {
        const LAS float* r0 = RS + (wr * 64 + fr) * 4 + (t == 16 ? 0 : 1);
#pragma unroll
        for (int ai = 0; ai < 2; ++ai)
#pragma unroll
            for (int m = 0; m < 4; ++m) { const float f = r0[(ai * 128 + m * 16) * 4];
#pragma unroll
                for (int bj = 0; bj < 2; ++bj)
#pragma unroll
                    for (int n = 0; n < 2; ++n) acc[ai][bj][m][n] = acc[ai][bj][m][n] * f; }
    }
    __device__ __forceinline__ void operator()(const pg8::f32x4 (&acc)[2][2][4][2], const pg8::Unit& u, int wr, int wc, int fr, int fq) const {
        asm volatile("" : "+v"(fr), "+v"(fq));
        const int col0 = u.pn * 256 + wc * 32 + 8 * fq;
        const int ui = (u.pm == 64) ? 1 : 0, seg = u.ko < 1024 ? 0 : (u.ko < 1536 ? 1 : 2);
#pragma unroll
        for (int ai = 0; ai < 2; ++ai)
#pragma unroll
            for (int m = 0; m < 4; ++m) {
                const int rl = ai * 128 + wr * 64 + m * 16 + fr;
                const LAS float* r = RS + (ui * 256 + rl) * 4;
                if (u.pm == 64) {
                    const float f = r[seg];
                    float* rowp = P + (size_t)(u.ko >> 8) * (NSA * DM) + (size_t)rl * DM + col0;
#pragma unroll
                    for (int bj = 0; bj < 2; ++bj) { *(pg8::f32x4*)(rowp + bj * 128) = acc[ai][bj][m][0] * f; *(pg8::f32x4*)(rowp + bj * 128 + 4) = acc[ai][bj][m][1] * f; }
                } else {
                    const float f = r[2];
                    bf16* rowp = C + (size_t)(u.pm * 256 + rl) * DM + col0;
#pragma unroll
                    for (int bj = 0; bj < 2; ++bj) { const pg8::f32x4 v0 = acc[ai][bj][m][0] * f, v1 = acc[ai][bj][m][1] * f;
                        pg8::u32x4 w; w.x = cvtpk(v0[0], v0[1]); w.y = cvtpk(v0[2], v0[3]); w.z = cvtpk(v1[0], v1[1]); w.w = cvtpk(v1[2], v1[3]);
                        *(pg8::u32x4*)(rowp + bj * 128) = w; }
                }
            }
    }
};
struct EpiInProj {
    static constexpr bool PERM = true, AFTER_DRAIN = false, KHOOK = false;
    bf16 *Q, *CKV, *Z, *XBC; float *GATES, *DT, *out;
    __device__ __forceinline__ void operator()(const pg8::f32x4 (&acc)[2][2][4][2], const pg8::Unit& u, int wr, int wc, int fr, int fq) const {
        const int pn = u.pn;
        const bool samp = (u.pm == 64);
#pragma unroll
        for (int ai = 0; ai < 2; ++ai)
#pragma unroll
            for (int m = 0; m < 4; ++m) {
                const int row = u.pm * 256 + ai * 128 + wr * 64 + m * 16 + fr;
                const int pb = row >> 12, pt = row & 4095;
                const int sr = row - NPR, sb = sr >> 3, st = sr & 7;
#pragma unroll
                for (int bj = 0; bj < 2; ++bj) {
                    const int cb = bj * 128 + wc * 32 + 8 * fq;
                    const pg8::f32x4 v0 = acc[ai][bj][m][0], v1 = acc[ai][bj][m][1];
                    if (pn < 4) {
                        pg8::u32x4 w; w.x = cvtpk(v0[0] * C2, v0[1] * C2); w.y = cvtpk(v0[2] * C2, v0[3] * C2); w.z = cvtpk(v1[0] * C2, v1[1] * C2); w.w = cvtpk(v1[2] * C2, v1[3] * C2);
                        *(pg8::u32x4*)(Q + (size_t)row * DM + pn * 256 + cb) = w;
                    } else if (pn < 10) {
                        const int which = (pn - 4) >> 1, col = ((pn - 4) & 1) * 256 + cb;
                        pg8::u32x4 w; w.x = cvtpk(v0[0], v0[1]); w.y = cvtpk(v0[2], v0[3]); w.z = cvtpk(v1[0], v1[1]); w.w = cvtpk(v1[2], v1[3]);
                        *(pg8::u32x4*)(CKV + (size_t)which * ((WS_SKV - WS_CKV) / 2) + (size_t)row * KVW + col) = w;
                        size_t fo; bool st_ok = true;
                        if (!samp) {
                            if (which < 2) fo = O_PCMP + (size_t)which * (O_PSLC - O_PCMP) + (size_t)row * KVW + col;
                            else { st_ok = (pt >= SEQ - 512); fo = O_PWIN + ((size_t)pb * 512 + (pt - (SEQ - 512))) * KVW + col; }
                        } else {
                            if (which < 2) fo = O_SCMP + (size_t)which * (O_SSLC - O_SCMP) + (size_t)sr * KVW + col;
                            else fo = O_SWIN + ((size_t)sb * 512 + 504 + st) * KVW + col;
                        }
                        if (st_ok) { __builtin_nontemporal_store(v0, (GAS pg8::f32x4*)(out + fo)); __builtin_nontemporal_store(v1, (GAS pg8::f32x4*)(out + fo + 4)); }
                    } else if (pn < 14) {
                        pg8::u32x4 w; w.x = cvtpk(v0[0], v0[1]); w.y = cvtpk(v0[2], v0[3]); w.z = cvtpk(v1[0], v1[1]); w.w = cvtpk(v1[2], v1[3]);
                        *(pg8::u32x4*)(Z + (size_t)row * DM + (pn - 10) * 256 + cb) = w;
                    } else if (pn < 20) {
                        const int col = (pn - 14) * 256 + cb;
                        pg8::u32x4 w; w.x = cvtpk(v0[0], v0[1]); w.y = cvtpk(v0[2], v0[3]); w.z = cvtpk(v1[0], v1[1]); w.w = cvtpk(v1[2], v1[3]);
                        *(pg8::u32x4*)(XBC + (size_t)row * CONVD + col) = w;
                        size_t fo; bool st_ok;
                        if (!samp) { st_ok = (pt >= SEQ - 3); fo = O_PCONV + ((size_t)pb * 3 + (pt - (SEQ - 3))) * CONVD + col; }
                        else { st_ok = (st >= STOK - 3); fo = O_SCONV + ((size_t)sb * 3 + (st - (STOK - 3))) * CONVD + col; }
                        if (st_ok) { __builtin_nontemporal_store(v0, (GAS pg8::f32x4*)(out + fo)); __builtin_nontemporal_store(v1, (GAS pg8::f32x4*)(out + fo + 4)); }
                    } else {
                        if (cb < 48) { float* fo = GATES + (size_t)row * 48 + cb; *(pg8::f32x4*)fo = v0; *(pg8::f32x4*)(fo + 4) = v1; }
                        else if (cb < 64) { float* fo = DT + (size_t)row * 16 + (cb - 48); *(pg8::f32x4*)fo = v0; *(pg8::f32x4*)(fo + 4) = v1; }
                    }
                }
            }
    }
};

template <int MODE> __device__ __forceinline__ int src_col(int n) {
    if (MODE == 0) return ((n >> 7) & 1 ? DFF : 0) + (n >> 8) * 128 + (n & 127);
    if (MODE == 2) {
        if (n < 2560) return n;
        if (n < 3584) return n + 48;
        if (n < 5120) return n + 48;
        if (n < 5168) return n - 2560;
        if (n < 5184) return n;
        return -1;
    }
    return n;
}
template <int MODE> __device__ __forceinline__ void transpose_item64(const float* W, int K, int ldw, bf16* WT, const float* g1, const float* g2, LAS float* scr, int item, int nblk, int lane) {
    const int kb = item / nblk, nb = item % nblk, k0 = 64 * kb, n0 = 64 * nb, kr = lane >> 4, nq = lane & 15;
    const int sc = src_col<MODE>(n0 + 4 * nq);
    f32x4 v[16];
#pragma unroll
    for (int i = 0; i < 16; ++i) v[i] = sc >= 0 ? __builtin_nontemporal_load((const GAS f32x4*)(W + (size_t)(k0 + 4 * i + kr) * ldw + sc)) : (f32x4){0.f, 0.f, 0.f, 0.f};
#pragma unroll
    for (int i = 0; i < 16; ++i) { const int k = 4 * i + kr; f32x4 x = v[i];
        if (MODE == 3) { const int kg = k0 + k; const float gs = (kg < 1024) ? g1[kg] : g2[kg - 1024]; x = x * gs; }
        LAS float* d = scr + k * 65 + 4 * nq; d[0] = x.x; d[1] = x.y; d[2] = x.z; d[3] = x.w; }
    LDS_WAIT(); asm volatile("" ::: "memory");
    const int c = lane & 7;
#pragma unroll
    for (int j = 0; j < 8; ++j) { const int n = (lane >> 3) + 8 * j; const LAS float* s_ = scr + (8 * c) * 65 + n;
        v4u o; o.x = pk2(s_[0 * 65], s_[1 * 65]); o.y = pk2(s_[2 * 65], s_[3 * 65]); o.z = pk2(s_[4 * 65], s_[5 * 65]); o.w = pk2(s_[6 * 65], s_[7 * 65]);
        *(GAS v4u*)(WT + (size_t)(n0 + n) * K + k0 + 8 * c) = o; }
    LDS_WAIT(); asm volatile("" ::: "memory");
}
template <int MODE> __device__ __forceinline__ void transpose_item(const float* W, int K, int ldw, bf16* WT, const float* g1, const float* g2, LAS float* scr, int item, int nblk, int lane) {
    const int kb = item / nblk, nb = item % nblk, k0 = 64 * kb, n0 = 32 * nb;
    const int sc = src_col<MODE>(n0 + (lane & 31));
#pragma unroll 8
    for (int i = 0; i < 32; ++i) { const int kk = 2 * i + (lane >> 5); float v = sc >= 0 ? W[(size_t)(k0 + kk) * ldw + sc] : 0.f;
        if (MODE == 3) { const int k = k0 + kk; v *= (k < 1024) ? g1[k] : g2[k - 1024]; }
        scr[kk * 33 + (lane & 31)] = v; }
    LDS_WAIT(); asm volatile("" ::: "memory");
    const int c = lane & 7;
#pragma unroll
    for (int j = 0; j < 4; ++j) { const int n = (lane >> 3) + 8 * j; const LAS float* s = scr + (8 * c) * 33 + n;
        v4u o; o.x = pk2(s[0 * 33], s[1 * 33]); o.y = pk2(s[2 * 33], s[3 * 33]); o.z = pk2(s[4 * 33], s[5 * 33]); o.w = pk2(s[6 * 33], s[7 * 33]);
        *(GAS v4u*)(WT + (size_t)(n0 + n) * K + k0 + 8 * c) = o; }
    LDS_WAIT(); asm volatile("" ::: "memory");
}
__device__ __forceinline__ void rms_row_to_bf16(const float* xrow, const float* g, bf16* orow, int lane) {
    const GAS f32x4* xr = (const GAS f32x4*)xrow + lane; const GAS f32x4* gr = (const GAS f32x4*)g + lane;
    f32x4 v[4]; float s = 0.f;
#pragma unroll
    for (int j = 0; j < 4; ++j) { v[j] = __builtin_nontemporal_load(xr + 64 * j); s += (v[j].x * v[j].x + v[j].y * v[j].y) + (v[j].z * v[j].z + v[j].w * v[j].w); }
    const float rs = 1.0f / sqrtf(wave_sum(s) * (1.f / DM) + EPS);
    GAS unsigned long long* o8 = (GAS unsigned long long*)orow + lane;
#pragma unroll
    for (int j = 0; j < 4; ++j) { const f32x4 gg = gr[64 * j];
        o8[64 * j] = (unsigned long long)pk2(v[j].x * rs * gg.x, v[j].y * rs * gg.y) | ((unsigned long long)pk2(v[j].z * rs * gg.z, v[j].w * rs * gg.w) << 32); }
}
__device__ __forceinline__ void rms_rows4_to_bf16(const float* x0, const float* x1, const float* x2, const float* x3, const float* g, bf16* o0, bf16* o1, bf16* o2, bf16* o3, int lane) {
    const float* xs[4] = {x0, x1, x2, x3}; bf16* os[4] = {o0, o1, o2, o3};
    f32x4 v[4][4];
#pragma unroll
    for (int r = 0; r < 4; ++r) { const GAS f32x4* xr = (const GAS f32x4*)xs[r] + lane;
#pragma unroll
        for (int j = 0; j < 4; ++j) v[r][j] = __builtin_nontemporal_load(xr + 64 * j); }
    const GAS f32x4* gr = (const GAS f32x4*)g + lane;
    f32x4 gg[4];
#pragma unroll
    for (int j = 0; j < 4; ++j) gg[j] = gr[64 * j];
#pragma unroll
    for (int r = 0; r < 4; ++r) { float s = 0.f;
#pragma unroll
        for (int j = 0; j < 4; ++j) s += (v[r][j].x * v[r][j].x + v[r][j].y * v[r][j].y) + (v[r][j].z * v[r][j].z + v[r][j].w * v[r][j].w);
        const float rs = 1.0f / sqrtf(wave_sum(s) * (1.f / DM) + EPS);
        GAS unsigned long long* o8 = (GAS unsigned long long*)os[r] + lane;
#pragma unroll
        for (int j = 0; j < 4; ++j)
            o8[64 * j] = (unsigned long long)pk2(v[r][j].x * rs * gg[j].x, v[r][j].y * rs * gg[j].y) | ((unsigned long long)pk2(v[r][j].z * rs * gg[j].z, v[r][j].w * rs * gg[j].w) << 32); }
}
struct RowRegs { f32x4 x[4]; unsigned long long o[4]; };
template <bool NTX = false, bool NTO = false>
__device__ __forceinline__ void row_load(RowRegs& r, const float* xin, const bf16* orow, int lane) {
    const GAS f32x4* xr = (const GAS f32x4*)xin + lane; const GAS unsigned long long* ob = (const GAS unsigned long long*)orow + lane;
#pragma unroll
    for (int j = 0; j < 4; ++j) { r.x[j] = NTX ? __builtin_nontemporal_load(xr + 64 * j) : xr[64 * j]; r.o[j] = NTO ? __builtin_nontemporal_load(ob + 64 * j) : ob[64 * j]; }
}
__device__ __forceinline__ void row_finish(RowRegs& r, const float* gpost, float coef, float* x1row, const float* gpre, bf16* xnrow, int lane, bool wx = true) {
    const GAS f32x4* gp = (const GAS f32x4*)gpost + lane;
    f32x4 o[4]; float s = 0.f;
#pragma unroll
    for (int j = 0; j < 4; ++j) { const unsigned lo = (unsigned)r.o[j], hi = (unsigned)(r.o[j] >> 32);
        o[j] = (f32x4){__uint_as_float(lo << 16), __uint_as_float(lo & 0xffff0000u), __uint_as_float(hi << 16), __uint_as_float(hi & 0xffff0000u)};
        s += (o[j].x * o[j].x + o[j].y * o[j].y) + (o[j].z * o[j].z + o[j].w * o[j].w); }
    const float rs = coef / sqrtf(wave_sum(s) * (1.f / DM) + EPS);
    float s2 = 0.f;
    GAS f32x4* xo = (GAS f32x4*)x1row + lane;
#pragma unroll
    for (int j = 0; j < 4; ++j) { const f32x4 gg = gp[64 * j]; f32x4 x = r.x[j];
        x.x += o[j].x * rs * gg.x; x.y += o[j].y * rs * gg.y; x.z += o[j].z * rs * gg.z; x.w += o[j].w * rs * gg.w;
        if (wx) __builtin_nontemporal_store(x, xo + 64 * j);
        r.x[j] = x;
        s2 += (x.x * x.x + x.y * x.y) + (x.z * x.z + x.w * x.w); }
    if (gpre) {
        const float rs2 = 1.0f / sqrtf(wave_sum(s2) * (1.f / DM) + EPS);
        const GAS f32x4* gq = (const GAS f32x4*)gpre + lane;
        GAS unsigned long long* o8 = (GAS unsigned long long*)xnrow + lane;
#pragma unroll
        for (int j = 0; j < 4; ++j) { const f32x4 gg = gq[64 * j]; const f32x4 x = r.x[j];
            o8[64 * j] = (unsigned long long)pk2(x.x * rs2 * gg.x, x.y * rs2 * gg.y) | ((unsigned long long)pk2(x.z * rs2 * gg.z, x.w * rs2 * gg.w) << 32); }
    }
}
struct RowRegs2 { f32x4 x[4]; unsigned long long o1[4], o2[4]; };
__device__ __forceinline__ void row_load2(RowRegs2& r, const float* xin, const bf16* o1row, const bf16* o2row, int lane) {
    const GAS f32x4* xr = (const GAS f32x4*)xin + lane; const GAS unsigned long long* a = (const GAS unsigned long long*)o1row + lane; const GAS unsigned long long* b = (const GAS unsigned long long*)o2row + lane;
#pragma unroll
    for (int j = 0; j < 4; ++j) { r.x[j] = __builtin_nontemporal_load(xr + 64 * j); r.o1[j] = __builtin_nontemporal_load(a + 64 * j); r.o2[j] = __builtin_nontemporal_load(b + 64 * j); }
}
__device__ __forceinline__ void row_finish2(RowRegs2& r, const float* g1, const float* g2, float c2, float* yrow, int lane) {
    f32x4 a[4], b[4]; float s1 = 0.f, s2 = 0.f;
#pragma unroll
    for (int j = 0; j < 4; ++j) { const unsigned l1 = (unsigned)r.o1[j], h1 = (unsigned)(r.o1[j] >> 32), l2 = (unsigned)r.o2[j], h2 = (unsigned)(r.o2[j] >> 32);
        a[j] = (f32x4){__uint_as_float(l1 << 16), __uint_as_float(l1 & 0xffff0000u), __uint_as_float(h1 << 16), __uint_as_float(h1 & 0xffff0000u)};
        b[j] = (f32x4){__uint_as_float(l2 << 16), __uint_as_float(l2 & 0xffff0000u), __uint_as_float(h2 << 16), __uint_as_float(h2 & 0xffff0000u)};
        s1 += (a[j].x * a[j].x + a[j].y * a[j].y) + (a[j].z * a[j].z + a[j].w * a[j].w);
        s2 += (b[j].x * b[j].x + b[j].y * b[j].y) + (b[j].z * b[j].z + b[j].w * b[j].w); }
    const float rs1 = 1.0f / sqrtf(wave_sum(s1) * (1.f / DM) + EPS), rs2 = c2 / sqrtf(wave_sum(s2) * (1.f / DM) + EPS);
    const GAS f32x4* p1 = (const GAS f32x4*)g1 + lane; const GAS f32x4* p2 = (const GAS f32x4*)g2 + lane;
    GAS f32x4* yo = (GAS f32x4*)yrow + lane;
#pragma unroll
    for (int j = 0; j < 4; ++j) { const f32x4 u = p1[64 * j], v = p2[64 * j]; f32x4 x = r.x[j];
        x.x += a[j].x * rs1 * u.x; x.y += a[j].y * rs1 * u.y; x.z += a[j].z * rs1 * u.z; x.w += a[j].w * rs1 * u.w;
        x.x += b[j].x * rs2 * v.x; x.y += b[j].y * rs2 * v.y; x.z += b[j].z * rs2 * v.z; x.w += b[j].w * rs2 * v.w;
        __builtin_nontemporal_store(x, yo + 64 * j); }
}
template <bool OBF> __device__ __forceinline__ void row_post(const float* xin, const void* orow_, int nparts, size_t pstride, const float* gpost, float coef, float* x1row, const float* gpre, bf16* xnrow, int lane) {
    const float* orow = (const float*)orow_;
    const GAS f32x4* xr = (const GAS f32x4*)xin + lane; const GAS f32x4* orr = (const GAS f32x4*)orow + lane; const GAS f32x4* gp = (const GAS f32x4*)gpost + lane;
    f32x4 x[4], o[4]; float s = 0.f;
#pragma unroll
    for (int j = 0; j < 4; ++j) x[j] = xr[64 * j];
    if (OBF) {
        const GAS unsigned long long* ob = (const GAS unsigned long long*)orow_ + lane;
#pragma unroll
        for (int j = 0; j < 4; ++j) { const unsigned long long w = ob[64 * j]; const unsigned lo = (unsigned)w, hi = (unsigned)(w >> 32);
            o[j] = (f32x4){__uint_as_float(lo << 16), __uint_as_float(lo & 0xffff0000u), __uint_as_float(hi << 16), __uint_as_float(hi & 0xffff0000u)}; }
    } else {
#pragma unroll
        for (int j = 0; j < 4; ++j) o[j] = orr[64 * j];
    }
    for (int q = 1; q < nparts; ++q) {
        const GAS f32x4* pr = (const GAS f32x4*)(orow + q * pstride) + lane;
#pragma unroll
        for (int j = 0; j < 4; ++j) o[j] = o[j] + pr[64 * j]; }
#pragma unroll
    for (int j = 0; j < 4; ++j) s += (o[j].x * o[j].x + o[j].y * o[j].y) + (o[j].z * o[j].z + o[j].w * o[j].w);
    const float rs = coef / sqrtf(wave_sum(s) * (1.f / DM) + EPS);
    float s2 = 0.f;
    GAS f32x4* xo = (GAS f32x4*)x1row + lane;
#pragma unroll
    for (int j = 0; j < 4; ++j) { const f32x4 gg = gp[64 * j];
        x[j].x += o[j].x * rs * gg.x; x[j].y += o[j].y * rs * gg.y; x[j].z += o[j].z * rs * gg.z; x[j].w += o[j].w * rs * gg.w;
        xo[64 * j] = x[j];
        s2 += (x[j].x * x[j].x + x[j].y * x[j].y) + (x[j].z * x[j].z + x[j].w * x[j].w); }
    if (gpre) {
        const float rs2 = 1.0f / sqrtf(wave_sum(s2) * (1.f / DM) + EPS);
        const GAS f32x4* gq = (const GAS f32x4*)gpre + lane;
        GAS unsigned long long* o8 = (GAS unsigned long long*)xnrow + lane;
#pragma unroll
        for (int j = 0; j < 4; ++j) { const f32x4 gg = gq[64 * j];
            o8[64 * j] = (unsigned long long)pk2(x[j].x * rs2 * gg.x, x[j].y * rs2 * gg.y) | ((unsigned long long)pk2(x[j].z * rs2 * gg.z, x[j].w * rs2 * gg.w) << 32); }
    }
}

typedef float f32x16 __attribute__((ext_vector_type(16)));
#define MFMA32(a, b, c) __builtin_amdgcn_mfma_f32_32x32x16_bf16((a), (b), (c), 0, 0, 0)
__device__ __forceinline__ int crow(int r, int hi) { return (r & 3) + 8 * (r >> 2) + 4 * hi; }
constexpr int SSTR = 272;
__device__ __forceinline__ float softplus_f(float x) { return x > 20.f ? x : log1pf(__expf(x)); }
__device__ __forceinline__ void wg_sync() { __syncthreads(); }

__device__ __forceinline__ void ssd_chunk_scalars(const float* DTR, const float* dt_bias, const float* a_log, int m0, int h, LAS float* dts, LAS float* css, int wave, int lane) {
    if (wave == 0) {
        const float bias = dt_bias[h], a = -__expf(a_log[h]);
        const float d0 = softplus_f(DTR[(size_t)(m0 + 2 * lane) * 16 + h] + bias), d1 = softplus_f(DTR[(size_t)(m0 + 2 * lane + 1) * 16 + h] + bias);
        const float l0 = d0 * a, l1 = d1 * a;
        float s = l0 + l1;
#pragma unroll
        for (int o = 1; o < 64; o <<= 1) { const float t = __shfl_up(s, o); if (lane >= o) s += t; }
        dts[2 * lane] = d0; dts[2 * lane + 1] = d1; css[2 * lane] = s - l1; css[2 * lane + 1] = s;
    }
}
template <int NCP, bool TR> __device__ __forceinline__ void conv_tile(const bf16* XBC, int m0, bool has_hist, int ch0, const float* conv_w, const float* conv_b,
                                                                     LAS unsigned char* dst, const LAS float* rowscale, int tid_, int toff = 0) {
    const int tid = (tid_ - toff) & (NWAVES * 64 - 1);
    constexpr int NG = NCP / 4;
    for (int task = tid; task < NG * 16; task += NWAVES * 64) {
        const int cg = task % NG, seg = task / NG, ch = ch0 + 8 * cg, l0 = 8 * seg;
        v4u xr[11];
#pragma unroll
        for (int r = 0; r < 11; ++r) {
            const int l = l0 - 3 + r;
            xr[r] = (v4u){0u, 0u, 0u, 0u};
            if (l >= 0 || has_hist) xr[r] = *(const GAS v4u*)(XBC + (size_t)(m0 + l) * CONVD + ch);
        }
        f32x4 w[4][2], bia[2];
#pragma unroll
        for (int k = 0; k < 4; ++k) { w[k][0] = *(const GAS f32x4*)(conv_w + k * CONVD + ch); w[k][1] = *(const GAS f32x4*)(conv_w + k * CONVD + ch + 4); }
        bia[0] = *(const GAS f32x4*)(conv_b + ch); bia[1] = *(const GAS f32x4*)(conv_b + ch + 4);
#define CONV_X(r, c) (((c) & 1) ? __uint_as_float(xr[r][(c) >> 1] & 0xffff0000u) : __uint_as_float(xr[r][(c) >> 1] << 16))
#define CONV_W(k, c) (w[k][(c) >> 2][(c) & 3])
        if (TR) {
#pragma unroll
            for (int c = 0; c < 8; ++c) {
                float y[8];
#pragma unroll
                for (int i = 0; i < 8; ++i) { float s0 = bia[c >> 2][c & 3];
#pragma unroll
                    for (int k = 0; k < 4; ++k) s0 += CONV_W(k, c) * CONV_X(i + k, c);
                    y[i] = silu_f(s0); if (rowscale) y[i] *= rowscale[l0 + i]; }
                v4u o; o.x = pk2(y[0], y[1]); o.y = pk2(y[2], y[3]); o.z = pk2(y[4], y[5]); o.w = pk2(y[6], y[7]);
                *(LAS v4u*)(dst + (8 * cg + c) * SSTR + l0 * 2) = o;
            }
        } else {
#pragma unroll
            for (int i = 0; i < 8; ++i) {
                float y[8];
#pragma unroll
                for (int c = 0; c < 8; ++c) { float s0 = bia[c >> 2][c & 3];
#pragma unroll
                    for (int k = 0; k < 4; ++k) s0 += CONV_W(k, c) * CONV_X(i + k, c);
                    y[c] = silu_f(s0); }
                v4u o; o.x = pk2(y[0], y[1]); o.y = pk2(y[2], y[3]); o.z = pk2(y[4], y[5]); o.w = pk2(y[6], y[7]);
                *(LAS v4u*)(dst + (l0 + i) * SSTR + (8 * cg) * 2) = o;
            }
        }
#undef CONV_X
#undef CONV_W
    }
}

template <int NCP, bool LT, bool GN>
__device__ __forceinline__ void conv_multi(const bf16* XBC, int m0, bool has_hist, int ch0, const float* conv_w, const float* conv_b,
                                           LAS unsigned char* lt, const LAS float* rowscale, unsigned char* gt, unsigned char* gn, int tid_, int toff) {
    const int tid = (tid_ - toff) & (NWAVES * 64 - 1);
    constexpr int NG = NCP / 4;
    for (int task = tid; task < NG * 16; task += NWAVES * 64) {
        const int cg = task % NG, seg = task / NG, ch = ch0 + 8 * cg, l0 = 8 * seg;
        v4u xr[11];
#pragma unroll
        for (int r = 0; r < 11; ++r) {
            const int l = l0 - 3 + r;
            xr[r] = (v4u){0u, 0u, 0u, 0u};
            if (l >= 0 || has_hist) xr[r] = __builtin_nontemporal_load((const GAS v4u*)(XBC + (size_t)(m0 + l) * CONVD + ch));
        }
        f32x4 w[4][2], bia[2];
#pragma unroll
        for (int k = 0; k < 4; ++k) { w[k][0] = *(const GAS f32x4*)(conv_w + k * CONVD + ch); w[k][1] = *(const GAS f32x4*)(conv_w + k * CONVD + ch + 4); }
        bia[0] = *(const GAS f32x4*)(conv_b + ch); bia[1] = *(const GAS f32x4*)(conv_b + ch + 4);
#define CONV_X(r, c) (((c) & 1) ? __uint_as_float(xr[r][(c) >> 1] & 0xffff0000u) : __uint_as_float(xr[r][(c) >> 1] << 16))
#define CONV_W(k, c) (w[k][(c) >> 2][(c) & 3])
#define CONV_Y(i, c) silu_f(bia[(c) >> 2][(c) & 3] + CONV_W(0, c) * CONV_X((i), c) + CONV_W(1, c) * CONV_X((i) + 1, c) + CONV_W(2, c) * CONV_X((i) + 2, c) + CONV_W(3, c) * CONV_X((i) + 3, c))
        if (!GN) {
#pragma unroll
            for (int c = 0; c < 8; ++c) {
                float y[8];
#pragma unroll
                for (int i = 0; i < 8; ++i) y[i] = CONV_Y(i, c);
                if (gt) { v4u o; o.x = cvtpk(y[0], y[1]); o.y = cvtpk(y[2], y[3]); o.z = cvtpk(y[4], y[5]); o.w = cvtpk(y[6], y[7]);
                    *(GAS v4u*)(gt + (8 * cg + c) * 256 + l0 * 2) = o; }
                if (LT) {
                    if (rowscale) { const LAS float* rsp = rowscale + (cg >> 3) * 128 + l0;
#pragma unroll
                        for (int i = 0; i < 8; ++i) y[i] *= rsp[i]; }
                    v4u o; o.x = cvtpk(y[0], y[1]); o.y = cvtpk(y[2], y[3]); o.z = cvtpk(y[4], y[5]); o.w = cvtpk(y[6], y[7]);
                    *(LAS v4u*)(lt + (8 * cg + c) * SSTR + l0 * 2) = o; }
            }
        } else if (LT) {
            float y[8][8];
#pragma unroll
            for (int c = 0; c < 8; ++c) {
#pragma unroll
                for (int i = 0; i < 8; ++i) y[c][i] = CONV_Y(i, c);
                v4u o; o.x = cvtpk(y[c][0], y[c][1]); o.y = cvtpk(y[c][2], y[c][3]); o.z = cvtpk(y[c][4], y[c][5]); o.w = cvtpk(y[c][6], y[c][7]);
                *(LAS v4u*)(lt + (8 * cg + c) * SSTR + l0 * 2) = o;
            }
            if (gn) {
#pragma unroll
                for (int i = 0; i < 8; ++i) { v4u o; o.x = cvtpk(y[0][i], y[1][i]); o.y = cvtpk(y[2][i], y[3][i]); o.z = cvtpk(y[4][i], y[5][i]); o.w = cvtpk(y[6][i], y[7][i]);
                    *(GAS v4u*)(gn + (l0 + i) * (NCP * 4) + cg * 16) = o; }
            }
        } else {
#pragma unroll
            for (int i = 0; i < 8; ++i) {
                float y[8];
#pragma unroll
                for (int c = 0; c < 8; ++c) y[c] = CONV_Y(i, c);
                v4u o; o.x = cvtpk(y[0], y[1]); o.y = cvtpk(y[2], y[3]); o.z = cvtpk(y[4], y[5]); o.w = cvtpk(y[6], y[7]);
                *(GAS v4u*)(gn + (l0 + i) * (NCP * 4) + cg * 16) = o;
            }
        }
#undef CONV_X
#undef CONV_W
#undef CONV_Y
    }
}

template <int NH>
__device__ __forceinline__ void ssd_a_item(int unit0, const bf16* XBC, const float* DTR, const float* dt_bias, const float* a_log, const float* conv_w, const float* conv_b,
                                           bf16* STB, float* DC, unsigned char* XCV, unsigned char* BCV, unsigned char* CCV, float* SCV, LAS unsigned char* lds, int tid_, int wave, int lane_) {
    asm volatile("; MARK_ssd_a_item_BEGIN" ::: "memory");
    int tid = tid_, lane = lane_; asm volatile("" : "+v"(tid), "+v"(lane));
    const int hf = unit0 & 15, c = (unit0 >> 4) & 31, b = unit0 >> 9, m0 = b * SEQ + c * 128, g = hf >> 3;
    const bool ex = (hf & 7) == 0;
    LAS unsigned char* BT = lds;
    LAS unsigned char* XT = lds + 128 * SSTR;
    LAS float* wsc = (LAS float*)(lds + 384 * SSTR);
    if (wave < NH) {
        const int h = hf + wave;
        const float bias = dt_bias[h], a = -__expf(a_log[h]);
        const float d0 = softplus_f(DTR[(size_t)(m0 + 2 * lane) * 16 + h] + bias), d1 = softplus_f(DTR[(size_t)(m0 + 2 * lane + 1) * 16 + h] + bias);
        const float l0 = d0 * a, l1 = d1 * a;
        float s = l0 + l1;
#pragma unroll
        for (int o = 1; o < 64; o <<= 1) { const float t = __shfl_up(s, o); if (lane >= o) s += t; }
        const float tot = __shfl(s, 63);
        wsc[wave * 128 + 2 * lane] = d0 * __expf(tot - (s - l1)); wsc[wave * 128 + 2 * lane + 1] = d1 * __expf(tot - s);
        float* sc = SCV + (size_t)(unit0 + wave) * 256;
        sc[2 * lane] = d0; sc[2 * lane + 1] = d1; sc[128 + 2 * lane] = s - l1; sc[128 + 2 * lane + 1] = s;
        if (lane == 63) DC[unit0 + wave] = __expf(s);
    }
    wg_sync();
    const size_t grp = (size_t)((b * 32 + c) * 2 + g);
    conv_multi<64, true, true>(XBC, m0, c > 0, 1024 + g * 128, conv_w, conv_b, BT, nullptr, nullptr, ex ? BCV + grp * 32768 : nullptr, tid, 0);
    if (ex) conv_multi<64, false, true>(XBC, m0, c > 0, 1280 + g * 128, conv_w, conv_b, nullptr, nullptr, nullptr, CCV + grp * 32768, tid, 256);
    constexpr int NR = NH < 4 ? NH : 4;
    const int pt = wave >> 2, nt = wave & 3, r32 = lane & 31, h2 = lane >> 5;
#pragma unroll 1
    for (int r = 0; r < (NH + 3) / 4; ++r) {
        if (r) wg_sync();
        conv_multi<32 * NR, true, false>(XBC, m0, c > 0, (hf + 4 * r) * 64, conv_w, conv_b, XT, wsc + 4 * r * 128, XCV + (size_t)(unit0 + 4 * r) * 16384, nullptr, tid, NH == 8 ? 0 : 256);
        wg_sync();
        bf16x8 bfr[8];
#pragma unroll
        for (int ks = 0; ks < 8; ++ks) bfr[ks] = *(const LAS bf16x8*)(BT + (32 * nt + r32) * SSTR + (16 * ks + 8 * h2) * 2);
#pragma unroll
        for (int k = 0; k < NR; ++k) {
            f32x16 acc;
#pragma unroll
            for (int i = 0; i < 16; ++i) acc[i] = 0.f;
#pragma unroll
            for (int ks = 0; ks < 8; ++ks) {
                const bf16x8 a = *(const LAS bf16x8*)(XT + (64 * k + 32 * pt + r32) * SSTR + (16 * ks + 8 * h2) * 2);
                acc = MFMA32(a, bfr[ks], acc);
            }
            bf16* dstp = STB + (size_t)(unit0 + 4 * r + k) * 8192 + 32 * nt + r32;
#pragma unroll
            for (int i = 0; i < 16; ++i) dstp[(32 * pt + crow(i, h2)) * 128] = (bf16)f2bf(acc[i]);
        }
    }
    wg_sync();
}

__device__ __forceinline__ void ssd_a_unit(int unit, const bf16* XBC, const float* DTR, const float* dt_bias, const float* a_log, const float* conv_w, const float* conv_b,
                                           bf16* STB, float* DC, LAS unsigned char* lds, int tid, int wave, int lane) {
    asm volatile("; MARK_ssd_a_unit_BEGIN" ::: "memory");
    const int h = unit & 15, c = (unit >> 4) & 31, b = unit >> 9, m0 = b * SEQ + c * 128, g = h >> 3;
    LAS unsigned char* XT = lds;
    LAS unsigned char* BT = lds + 64 * SSTR;
    LAS float* dts = (LAS float*)(lds + 192 * SSTR);
    LAS float* css = dts + 128;
    LAS float* wsc = css + 128;
    ssd_chunk_scalars(DTR, dt_bias, a_log, m0, h, dts, css, wave, lane);
    wg_sync();
    if (tid < 128) wsc[tid] = dts[tid] * __expf(css[127] - css[tid]);
    if (tid == 0) DC[unit] = __expf(css[127]);
    wg_sync();
    conv_tile<32, true>(XBC, m0, c > 0, h * 64, conv_w, conv_b, XT, wsc, tid, 256);
    conv_tile<64, true>(XBC, m0, c > 0, 1024 + g * 128, conv_w, conv_b, BT, nullptr, tid);
    wg_sync();
    const int pt = wave >> 2, nt = wave & 3, r32 = lane & 31, h2 = lane >> 5;
    f32x16 acc;
#pragma unroll
    for (int i = 0; i < 16; ++i) acc[i] = 0.f;
#pragma unroll
    for (int ks = 0; ks < 8; ++ks) {
        const bf16x8 a = *(const LAS bf16x8*)(XT + (32 * pt + r32) * SSTR + (16 * ks + 8 * h2) * 2);
        const bf16x8 bb = *(const LAS bf16x8*)(BT + (32 * nt + r32) * SSTR + (16 * ks + 8 * h2) * 2);
        acc = MFMA32(a, bb, acc);
    }
    bf16* dstp = STB + (size_t)unit * 8192 + 32 * nt + r32;
#pragma unroll
    for (int i = 0; i < 16; ++i) dstp[(32 * pt + crow(i, h2)) * 128] = (bf16)f2bf(acc[i]);
    wg_sync();
}

__device__ __forceinline__ void ssd_scan(bf16* STB, const float* DC, float* pssm, int gthread, int nthreads) {
    asm volatile("; MARK_ssd_scan_BEGIN" ::: "memory");
    typedef unsigned long long u64s;
    for (int e4 = gthread; e4 < NB * 16 * 2048; e4 += nthreads) {
        const int bh = e4 >> 11, w4 = e4 & 2047, b = bh >> 4, h = bh & 15;
        float hs[4] = {0.f, 0.f, 0.f, 0.f};
        GAS u64s* p = (GAS u64s*)(STB + ((size_t)(b * 32) * 16 + h) * 8192) + w4;
#pragma unroll 16
        for (int c = 0; c < 32; ++c) {
            const u64s st = p[(size_t)c * 16 * 2048];
            const float dc = DC[(b * 32 + c) * 16 + h];
            p[(size_t)c * 16 * 2048] = (u64s)pk2(hs[0], hs[1]) | ((u64s)pk2(hs[2], hs[3]) << 32);
            const unsigned lo = (unsigned)st, hi = (unsigned)(st >> 32);
            hs[0] = hs[0] * dc + __uint_as_float(lo << 16); hs[1] = hs[1] * dc + __uint_as_float(lo & 0xffff0000u);
            hs[2] = hs[2] * dc + __uint_as_float(hi << 16); hs[3] = hs[3] * dc + __uint_as_float(hi & 0xffff0000u);
        }
        *((GAS f32x4*)(pssm + (size_t)bh * 8192) + w4) = (f32x4){hs[0], hs[1], hs[2], hs[3]};
    }
}

__device__ __forceinline__ void ssd_c_unit(int unit, const bf16* XBC, const float* DTR, const float* dt_bias, const float* a_log, const float* conv_w, const float* conv_b,
                                           const float* d_skip, const bf16* STB, const bf16* ZB, bf16* MIX, float* SSQY, LAS unsigned char* lds, int tid, int wave, int lane) {
    asm volatile("; MARK_ssd_c_unit_BEGIN" ::: "memory");
    const int h = unit & 15, c = (unit >> 4) & 31, b = unit >> 9, m0 = b * SEQ + c * 128, g = h >> 3;
    LAS unsigned char* CL = lds;
    LAS unsigned char* BL = lds + 128 * SSTR;
    LAS unsigned char* XT = lds + 256 * SSTR;
    LAS unsigned char* HL = lds + 320 * SSTR;
    LAS float* dts = (LAS float*)(lds + 384 * SSTR);
    LAS float* css = dts + 128;
    LAS float* ssp = css + 128;
    ssd_chunk_scalars(DTR, dt_bias, a_log, m0, h, dts, css, wave, lane);
    conv_tile<64, false>(XBC, m0, c > 0, 1024 + 256 + g * 128, conv_w, conv_b, CL, nullptr, tid);
    conv_tile<64, false>(XBC, m0, c > 0, 1024 + g * 128, conv_w, conv_b, BL, nullptr, tid);
    conv_tile<32, true>(XBC, m0, c > 0, h * 64, conv_w, conv_b, XT, nullptr, tid);
    {
        const GAS v4u* src = (const GAS v4u*)(STB + (size_t)unit * 8192);
#pragma unroll
        for (int j = 0; j < 2; ++j) { const int e8 = tid + 512 * j, p = e8 >> 4, n = (e8 & 15) * 8; *(LAS v4u*)(HL + p * SSTR + n * 2) = src[e8]; }
    }
    wg_sync();
    const int pt = wave >> 2, ls = wave & 3, r32 = lane & 31, h2 = lane >> 5;
    const int l = 32 * ls + r32;
    const float csl = css[l];
    bf16x8 cf[8];
#pragma unroll
    for (int ks = 0; ks < 8; ++ks) cf[ks] = *(const LAS bf16x8*)(CL + l * SSTR + (16 * ks + 8 * h2) * 2);
    f32x16 acc;
#pragma unroll
    for (int i = 0; i < 16; ++i) acc[i] = 0.f;
#pragma unroll
    for (int ks = 0; ks < 8; ++ks) {
        const bf16x8 a = *(const LAS bf16x8*)(HL + (32 * pt + r32) * SSTR + (16 * ks + 8 * h2) * 2);
        acc = MFMA32(a, cf[ks], acc);
    }
    { const float el = __expf(csl);
#pragma unroll
      for (int i = 0; i < 16; ++i) acc[i] *= el; }
    for (int st = 0; st <= ls; ++st) {
        f32x16 mt;
#pragma unroll
        for (int i = 0; i < 16; ++i) mt[i] = 0.f;
#pragma unroll
        for (int ks = 0; ks < 8; ++ks) {
            const bf16x8 a = *(const LAS bf16x8*)(BL + (32 * st + r32) * SSTR + (16 * ks + 8 * h2) * 2);
            mt = MFMA32(a, cf[ks], mt);
        }
        unsigned pk[8];
#pragma unroll
        for (int i = 0; i < 16; i += 2) {
            const int s0 = 32 * st + crow(i, h2), s1 = s0 + 1;
            const float v0 = (l >= s0) ? mt[i] * __expf(csl - css[s0]) * dts[s0] : 0.f;
            const float v1 = (l >= s1) ? mt[i + 1] * __expf(csl - css[s1]) * dts[s1] : 0.f;
            pk[i >> 1] = pk2(v0, v1);
        }
#pragma unroll
        for (int k2 = 0; k2 < 2; ++k2) {
            v4u bw; bw.x = pk[4 * k2]; bw.y = pk[4 * k2 + 1]; bw.z = pk[4 * k2 + 2]; bw.w = pk[4 * k2 + 3];
            const bf16x8 bfrag = __builtin_bit_cast(bf16x8, bw);
            const LAS unsigned char* xp = XT + (32 * pt + r32) * SSTR + (32 * st + 16 * k2 + 4 * h2) * 2;
            const unsigned long long a_lo = *(const LAS unsigned long long*)xp, a_hi = *(const LAS unsigned long long*)(xp + 16);
            typedef unsigned long long u64x2 __attribute__((ext_vector_type(2)));
            u64x2 aw; aw.x = a_lo; aw.y = a_hi;
            acc = MFMA32(__builtin_bit_cast(bf16x8, aw), bfrag, acc);
        }
    }
    const float Dh = d_skip[h];
    const int m = m0 + l;
    float ssq = 0.f;
#pragma unroll
    for (int gq = 0; gq < 4; ++gq) {
        const int p0 = 32 * pt + 8 * gq + 4 * h2;
        const unsigned long long zz = *(const unsigned long long*)(ZB + (size_t)m * DM + h * 64 + p0);
        float y[4];
#pragma unroll
        for (int j = 0; j < 4; ++j) {
            const float xv = bf2f(*(const LAS unsigned short*)(XT + (p0 + j) * SSTR + l * 2));
            const float zv = bf2f((unsigned short)(zz >> (16 * j)));
            y[j] = (acc[4 * gq + j] + Dh * xv) * silu_f(zv);
            ssq += y[j] * y[j];
        }
        *(unsigned long long*)(MIX + (size_t)m * DMIX + 1024 + h * 64 + p0) = (unsigned long long)pk2(y[0], y[1]) | ((unsigned long long)pk2(y[2], y[3]) << 32);
    }
    ssq += __shfl_xor(ssq, 32);
    if (h2 == 0) ssp[pt * 128 + l] = ssq;
    wg_sync();
    if (tid < 128) SSQY[(size_t)(m0 + tid) * 16 + h] = ssp[tid] + ssp[128 + tid];
    wg_sync();
}

#ifdef PROBE_SSDCOARSE
#define PROBE_MASK 0xfffe
#else
#define PROBE_MASK 0xffff
#endif
__device__ __forceinline__ void ssd_sample_unit(int unit, const bf16* XBC, const float* DTR, const float* dt_bias, const float* a_log, const float* conv_w, const float* conv_b,
                                                const float* d_skip, const float* state_ssm, const float* state_conv, const bf16* ZB, bf16* MIX, float* SSQY, float* sssm,
                                                LAS unsigned char* lds, int tid_) {
    asm volatile("; MARK_ssd_sample_unit_BEGIN" ::: "memory");
    int tid = tid_; asm volatile("" : "+v"(tid));
    const int h = unit & 15, b = unit >> 4, g = h >> 3, m0 = NPR + b * 8;
    LAS float* xs = (LAS float*)lds;
    LAS float* Bs = xs + 512;
    LAS float* Cs = Bs + 1024;
    LAS float* cbd = Cs + 1024;
    LAS float* ysq = cbd + 64;
    LAS float* yo = ysq + 512;
    LAS float* dtl = yo + 512;
    LAS float* csl = dtl + 8;
    const int p = tid >> 3, nq = tid & 7;
    const GAS f32x4* hp = (const GAS f32x4*)(state_ssm + ((size_t)(b * 16 + h) * 64 + p) * 128 + nq * 16);
    GAS f32x4* ho = (GAS f32x4*)(sssm + ((size_t)(b * 16 + h) * 64 + p) * 128 + nq * 16);
    f32x4 hv[4];
#pragma unroll
    for (int j = 0; j < 4; ++j) hv[j] = hp[j];
    const unsigned short zraw = ZB[(size_t)(m0 + nq) * DM + h * 64 + p];
    if (tid >= 448 && tid < 456) {
        const int t = tid - 448;
        const float d = softplus_f(DTR[(size_t)(m0 + t) * 16 + h] + dt_bias[h]), a = -__expf(a_log[h]);
        float run = d * a;
#pragma unroll
        for (int o = 1; o < 8; o <<= 1) { const float tmp = __shfl_up(run, o); if (t >= o) run += tmp; }
        dtl[t] = d; csl[t] = run;
    }
    if (tid < 320) {
        const int cc = tid;
        const int ch = cc < 64 ? h * 64 + cc : (cc < 192 ? 1024 + g * 128 + (cc - 64) : 1280 + g * 128 + (cc - 192));
        float xv[11], w[4];
#pragma unroll
        for (int r = 0; r < 3; ++r) xv[r] = state_conv[((size_t)b * 3 + r) * CONVD + ch];
#pragma unroll
        for (int r = 3; r < 11; ++r) xv[r] = bf2f(XBC[(size_t)(m0 + r - 3) * CONVD + ch]);
#pragma unroll
        for (int k = 0; k < 4; ++k) w[k] = conv_w[k * CONVD + ch];
        const float cb = conv_b[ch];
        LAS float* dst = cc < 64 ? xs + cc : (cc < 192 ? Bs + (cc - 64) : Cs + (cc - 192));
        const int dstr = cc < 64 ? 64 : 128;
#pragma unroll
        for (int t = 0; t < 8; ++t) { float s = cb;
#pragma unroll
            for (int k = 0; k < 4; ++k) s += w[k] * xv[t + k];
            dst[t * dstr] = silu_f(s); }
    }
    wg_sync();
    {
        const int pr = tid >> 3, l = pr >> 3, s = pr & 7, part = tid & 7;
        float d = 0.f;
#pragma unroll
        for (int n = 0; n < 16; ++n) d += Cs[l * 128 + part * 16 + n] * Bs[s * 128 + part * 16 + n];
        d += __shfl_xor(d, 1); d += __shfl_xor(d, 2); d += __shfl_xor(d, 4);
        if (part == 0) cbd[l * 8 + s] = (s <= l) ? d * __expf(csl[l] - csl[s]) * dtl[s] : 0.f;
    }
#pragma unroll
    for (int l = 0; l < 8; ++l) { float s = 0.f;
#pragma unroll
        for (int j = 0; j < 4; ++j) { const LAS float* cp = Cs + l * 128 + nq * 16 + 4 * j; s += (hv[j].x * cp[0] + hv[j].y * cp[1]) + (hv[j].z * cp[2] + hv[j].w * cp[3]); }
        s += __shfl_xor(s, 1); s += __shfl_xor(s, 2); s += __shfl_xor(s, 4);
        if (nq == 0) yo[l * 64 + p] = s; }
    { const float c7 = csl[7], e7 = __expf(c7);
#pragma unroll
      for (int j = 0; j < 4; ++j) hv[j] = hv[j] * e7;
#pragma unroll
      for (int l = 0; l < 8; ++l) { const float wl = dtl[l] * __expf(c7 - csl[l]) * xs[l * 64 + p];
#pragma unroll
          for (int j = 0; j < 4; ++j) { const LAS float* bp = Bs + l * 128 + nq * 16 + 4 * j; hv[j].x += wl * bp[0]; hv[j].y += wl * bp[1]; hv[j].z += wl * bp[2]; hv[j].w += wl * bp[3]; } }
#pragma unroll
      for (int j = 0; j < 4; ++j) __builtin_nontemporal_store(hv[j], ho + j); }
    wg_sync();
    {
        const int l = nq;
        float y = __expf(csl[l]) * yo[l * 64 + p] + d_skip[h] * xs[l * 64 + p];
#pragma unroll
        for (int s = 0; s < 8; ++s) y += cbd[l * 8 + s] * xs[s * 64 + p];
        y *= silu_f(bf2f(zraw));
        MIX[(size_t)(m0 + l) * DMIX + 1024 + h * 64 + p] = (bf16)f2bf(y);
        ysq[l * 64 + p] = y * y;
    }
    wg_sync();
    { const int l = tid >> 6; const float v = wave_sum(ysq[l * 64 + (tid & 63)]); if ((tid & 63) == 0) SSQY[(size_t)(m0 + l) * 16 + h] = v; }
    wg_sync();
}

struct PairRegs { v4u rc[4], rb[4], rx[4], rh[4]; float sv; };
__device__ __forceinline__ void pair_issue(int pu, bool full  , const unsigned char* XCV, const unsigned char* BCV, const unsigned char* CCV, const float* SCV, const bf16* STB, int tid, PairRegs& R) {
    const int hp = pu & 3, g = (pu >> 2) & 1, c = (pu >> 3) & 31, b = pu >> 8, h0 = g * 8 + 2 * hp;
    const size_t grp = (size_t)((b * 32 + c) * 2 + g), unit0 = (size_t)(b * 32 + c) * 16 + h0;
    const GAS v4u* sC = (const GAS v4u*)(CCV + grp * 32768); const GAS v4u* sB = (const GAS v4u*)(BCV + grp * 32768);
    const GAS v4u* sX = (const GAS v4u*)(XCV + unit0 * 16384); const GAS v4u* sH = (const GAS v4u*)(STB + unit0 * 8192);
#pragma unroll
    for (int j = 0; j < 4; ++j) { R.rx[j] = __builtin_nontemporal_load(sX + tid + 512 * j); R.rh[j] = __builtin_nontemporal_load(sH + tid + 512 * j); }
    if (full) {
#pragma unroll
        for (int j = 0; j < 4; ++j) { R.rc[j] = __builtin_nontemporal_load(sC + tid + 512 * j); R.rb[j] = __builtin_nontemporal_load(sB + tid + 512 * j); }
    }
    R.sv = SCV[(unit0 + (tid >> 8)) * 256 + (tid & 255)];
}
__device__ __forceinline__ void ssd_c_pair_run(int pu0, int n, const unsigned char* XCV, const unsigned char* BCV, const unsigned char* CCV, const float* SCV,
                                               const float* d_skip, const bf16* STB, const bf16* ZB, bf16* MIX, float* SSQY, LAS unsigned char* lds, int tid_, int wave, int lane_) {
    asm volatile("; MARK_ssd_c_pair_BEGIN" ::: "memory");
    int tid = tid_, lane = lane_; asm volatile("" : "+v"(tid), "+v"(lane));
    LAS unsigned char* CL = lds;
    LAS unsigned char* BL = lds + 128 * SSTR;
    LAS unsigned char* XT = lds + 256 * SSTR;
    LAS unsigned char* HL = lds + 384 * SSTR;
    LAS float* dts = (LAS float*)(lds + 512 * SSTR);
    LAS float* css = dts + 256;
    LAS float* ssp = css + 256;
    PairRegs R;
    if (n > 0) pair_issue(pu0, true, XCV, BCV, CCV, SCV, STB, tid, R);
#pragma unroll 1
    for (int k = 0; k < n; ++k) {
    const int pu = pu0 + k;
    const int hp = pu & 3, g = (pu >> 2) & 1, c = (pu >> 3) & 31, b = pu >> 8, m0 = b * SEQ + c * 128, h0 = g * 8 + 2 * hp;
    const int hsel = wave >> 2, h = h0 + hsel;
    {
#pragma unroll
        for (int j = 0; j < 4; ++j) { const int e8 = tid + 512 * j, off = (e8 >> 4) * SSTR + (e8 & 15) * 16;
            *(LAS v4u*)(XT + off) = R.rx[j]; *(LAS v4u*)(HL + off) = R.rh[j]; }
        if (k == 0 || hp == 0) {
#pragma unroll
            for (int j = 0; j < 4; ++j) { const int e8 = tid + 512 * j, off = (e8 >> 4) * SSTR + (e8 & 15) * 16;
                *(LAS v4u*)(CL + off) = R.rc[j]; *(LAS v4u*)(BL + off) = R.rb[j]; }
        }
        if ((tid & 255) < 128) dts[(tid >> 8) * 128 + (tid & 127)] = R.sv; else css[(tid >> 8) * 128 + (tid & 127)] = R.sv;
    }
    if (k + 1 < n) pair_issue(pu + 1, ((pu + 1) & 3) == 0, XCV, BCV, CCV, SCV, STB, tid, R);
    wg_sync();
    const int ls = wave & 3, r32 = lane & 31, h2 = lane >> 5;
    const int l = 32 * ls + r32;
    const LAS float* csh = css + hsel * 128; const LAS float* dth = dts + hsel * 128;
    const LAS unsigned char* XTh = XT + hsel * 64 * SSTR; const LAS unsigned char* HLh = HL + hsel * 64 * SSTR;
    const float csl = csh[l];
    bf16x8 cf[8];
#pragma unroll
    for (int ks = 0; ks < 8; ++ks) cf[ks] = *(const LAS bf16x8*)(CL + l * SSTR + (16 * ks + 8 * h2) * 2);
    f32x16 acc0, acc1;
#pragma unroll
    for (int i = 0; i < 16; ++i) { acc0[i] = 0.f; acc1[i] = 0.f; }
#pragma unroll
    for (int ks = 0; ks < 8; ++ks) {
        const bf16x8 a0 = *(const LAS bf16x8*)(HLh + r32 * SSTR + (16 * ks + 8 * h2) * 2);
        const bf16x8 a1 = *(const LAS bf16x8*)(HLh + (32 + r32) * SSTR + (16 * ks + 8 * h2) * 2);
        acc0 = MFMA32(a0, cf[ks], acc0); acc1 = MFMA32(a1, cf[ks], acc1);
    }
    { const float el = __expf(csl);
#pragma unroll
      for (int i = 0; i < 16; ++i) { acc0[i] *= el; acc1[i] *= el; } }
    for (int st = 0; st <= ls; ++st) {
        f32x16 mt;
#pragma unroll
        for (int i = 0; i < 16; ++i) mt[i] = 0.f;
#pragma unroll
        for (int ks = 0; ks < 8; ++ks) {
            const bf16x8 a = *(const LAS bf16x8*)(BL + (32 * st + r32) * SSTR + (16 * ks + 8 * h2) * 2);
            mt = MFMA32(a, cf[ks], mt);
        }
        unsigned pk[8];
#pragma unroll
        for (int i = 0; i < 16; i += 2) {
            const int s0 = 32 * st + crow(i, h2), s1 = s0 + 1;
            const float v0 = (l >= s0) ? mt[i] * __expf(csl - csh[s0]) * dth[s0] : 0.f;
            const float v1 = (l >= s1) ? mt[i + 1] * __expf(csl - csh[s1]) * dth[s1] : 0.f;
            pk[i >> 1] = pk2(v0, v1);
        }
#pragma unroll
        for (int k2 = 0; k2 < 2; ++k2) {
            v4u bw; bw.x = pk[4 * k2]; bw.y = pk[4 * k2 + 1]; bw.z = pk[4 * k2 + 2]; bw.w = pk[4 * k2 + 3];
            const bf16x8 bfrag = __builtin_bit_cast(bf16x8, bw);
            typedef unsigned long long u64x2 __attribute__((ext_vector_type(2)));
            const LAS unsigned char* xp = XTh + r32 * SSTR + (32 * st + 16 * k2 + 4 * h2) * 2;
            u64x2 aw0; aw0.x = *(const LAS unsigned long long*)xp; aw0.y = *(const LAS unsigned long long*)(xp + 16);
            u64x2 aw1; aw1.x = *(const LAS unsigned long long*)(xp + 32 * SSTR); aw1.y = *(const LAS unsigned long long*)(xp + 32 * SSTR + 16);
            acc0 = MFMA32(__builtin_bit_cast(bf16x8, aw0), bfrag, acc0);
            acc1 = MFMA32(__builtin_bit_cast(bf16x8, aw1), bfrag, acc1);
        }
    }
    const float Dh = d_skip[h];
    const int m = m0 + l;
    float ssq = 0.f;
#pragma unroll
    for (int pt = 0; pt < 2; ++pt)
#pragma unroll
        for (int gq = 0; gq < 4; ++gq) {
            const int p0 = 32 * pt + 8 * gq + 4 * h2;
            const unsigned long long zz = *(const unsigned long long*)(ZB + (size_t)m * DM + h * 64 + p0);
            float y[4];
#pragma unroll
            for (int j = 0; j < 4; ++j) {
                const float xv = bf2f(*(const LAS unsigned short*)(XTh + (p0 + j) * SSTR + l * 2));
                const float zv = bf2f((unsigned short)(zz >> (16 * j)));
                const float av = pt == 0 ? acc0[4 * gq + j] : acc1[4 * gq + j];
                y[j] = (av + Dh * xv) * silu_f(zv);
                ssq += y[j] * y[j];
            }
            *(unsigned long long*)(MIX + (size_t)m * DMIX + 1024 + h * 64 + p0) = (unsigned long long)pk2(y[0], y[1]) | ((unsigned long long)pk2(y[2], y[3]) << 32);
        }
    ssq += __shfl_xor(ssq, 32);
    if (h2 == 0) ssp[hsel * 128 + l] = ssq;
    wg_sync();
    if (tid < 256) SSQY[(size_t)(m0 + (tid & 127)) * 16 + h0 + (tid >> 7)] = ssp[tid];
    wg_sync();
    }
}

__device__ const unsigned char BKT[129] = {0, 1, 2, 3, 4, 5, 6, 7, 8, 9, 10, 11, 12, 13, 14, 15, 16, 16, 16, 17, 17, 18, 18, 18, 19, 19, 19, 20, 20, 20, 20, 21, 21, 21, 21, 22, 22, 22, 22, 22, 23, 23, 23, 23, 23, 23, 24, 24, 24, 24, 24, 24, 25, 25, 25, 25, 25, 25, 25, 26, 26, 26, 26, 26, 26, 26, 26, 27, 27, 27, 27, 27, 27, 27, 27, 27, 27, 28, 28, 28, 28, 28, 28, 28, 28, 28, 28, 29, 29, 29, 29, 29, 29, 29, 29, 29, 29, 29, 29, 30, 30, 30, 30, 30, 30, 30, 30, 30, 30, 30, 30, 30, 30, 31, 31, 31, 31, 31, 31, 31, 31, 31, 31, 31, 31, 31, 31, 31, 31};
#define PROBE_KN 1
#ifndef SPLIT_RANK
#define SPLIT_RANK 0
#endif
constexpr int KSTR = 144, VSTR = 144;
__device__ __forceinline__ int vpos(int key) { return (key & ~12) | ((key & 8) >> 1) | ((key & 4) << 1); }
constexpr int TILE_K_BYTES = 64 * KSTR, TILE_BYTES = 64 * KSTR + 64 * VSTR;
constexpr float NEG_BIG = -1.0e30f;
constexpr int LUT_STRIDE = 132;
typedef unsigned long long u64;

struct StageRegs { v4u k; u64 v0, v1; };
__device__ __forceinline__ void stage_issue_bf16(const bf16* base, long row0, int nvalid, int kvh, int tid_, StageRegs& r) {
    int tid = tid_; asm volatile("" : "+v"(tid));
    const int key = tid >> 3, ch = tid & 7, kp = tid >> 4, dq = tid & 15;
    r.k = (v4u){0u, 0u, 0u, 0u}; r.v0 = 0ull; r.v1 = 0ull;
    if (key < nvalid) r.k = *(const GAS v4u*)(base + (size_t)(row0 + key) * KVW + kvh * 128 + ch * 8);
    if (2 * kp < nvalid) r.v0 = *(const GAS u64*)(base + (size_t)(row0 + 2 * kp) * KVW + kvh * 128 + 64 + dq * 4);
    if (2 * kp + 1 < nvalid) r.v1 = *(const GAS u64*)(base + (size_t)(row0 + 2 * kp + 1) * KVW + kvh * 128 + 64 + dq * 4);
}
__device__ __forceinline__ void stage_commit(const StageRegs& r, LAS unsigned char* tb, int tid_) {
    int tid = tid_; asm volatile("" : "+v"(tid));
    const int key = tid >> 3, ch = tid & 7, kp = tid >> 4, dq = tid & 15;
    *(LAS v4u*)(tb + key * KSTR + ch * 16) = r.k;
    const unsigned a0 = (unsigned)r.v0, a1 = (unsigned)(r.v0 >> 32), b0 = (unsigned)r.v1, b1 = (unsigned)(r.v1 >> 32);
    LAS unsigned char* vt = tb + TILE_K_BYTES + (4 * dq) * VSTR + vpos(2 * kp) * 2;
    *(LAS unsigned*)(vt) = (a0 & 0xffffu) | (b0 << 16);
    *(LAS unsigned*)(vt + VSTR) = (a0 >> 16) | (b0 & 0xffff0000u);
    *(LAS unsigned*)(vt + 2 * VSTR) = (a1 & 0xffffu) | (b1 << 16);
    *(LAS unsigned*)(vt + 3 * VSTR) = (a1 >> 16) | (b1 & 0xffff0000u);
}
__device__ __forceinline__ void stage_tile_bf16(const bf16* base, long row0, int nvalid, int kvh, LAS unsigned char* tb, int tid) {
    StageRegs r; stage_issue_bf16(base, row0, nvalid, kvh, tid, r); stage_commit(r, tb, tid);
}
__device__ __forceinline__ void stage_issue_full(const bf16* base, int row0  , int kvh, int tid_, StageRegs& r) {
    int tid = tid_; asm volatile("" : "+v"(tid));
    const GAS unsigned char* ub = (const GAS unsigned char*)(base + (size_t)__builtin_amdgcn_readfirstlane(row0) * KVW + kvh * 128);
    const unsigned offk = (unsigned)(tid >> 3) * (KVW * 2) + (unsigned)(tid & 7) * 16, offv = (unsigned)(tid >> 4) * (4 * KVW) + 128 + (unsigned)(tid & 15) * 8;
    r.k = *(const GAS v4u*)(ub + offk); r.v0 = *(const GAS u64*)(ub + offv); r.v1 = *(const GAS u64*)(ub + offv + KVW * 2);
}
__device__ __forceinline__ void stage_tile_full(const bf16* base, int row0, int kvh, LAS unsigned char* tb, int tid) {
    StageRegs r; stage_issue_full(base, row0, kvh, tid, r); stage_commit(r, tb, tid);
}
struct StageOff { unsigned offk, offv, wk, wv; };
__device__ __forceinline__ StageOff stage_off(int tid) {
    StageOff o; const int key = tid >> 3, ch = tid & 7, kp = tid >> 4, dq = tid & 15;
    o.offk = (unsigned)key * (KVW * 2) + (unsigned)ch * 16; o.offv = (unsigned)kp * (4 * KVW) + 128 + (unsigned)dq * 8;
    o.wk = (unsigned)(key * KSTR + ch * 16); o.wv = (unsigned)(TILE_K_BYTES + (4 * dq) * VSTR + vpos(2 * kp) * 2);
    asm volatile("" : "+v"(o.offk), "+v"(o.offv), "+v"(o.wk), "+v"(o.wv));
    return o;
}
__device__ __forceinline__ void stage_issue_off(const bf16* base, int row0  , int kvh, const StageOff& o, StageRegs& r) {
    const GAS unsigned char* ub = (const GAS unsigned char*)(base + (size_t)__builtin_amdgcn_readfirstlane(row0) * KVW + kvh * 128);
    r.k = *(const GAS v4u*)(ub + o.offk); r.v0 = *(const GAS u64*)(ub + o.offv); r.v1 = *(const GAS u64*)(ub + o.offv + KVW * 2);
}
__device__ __forceinline__ void stage_commit_off(const StageRegs& r, LAS unsigned char* tb, const StageOff& o) {
    *(LAS v4u*)(tb + o.wk) = r.k;
    const unsigned a0 = (unsigned)r.v0, a1 = (unsigned)(r.v0 >> 32), b0 = (unsigned)r.v1, b1 = (unsigned)(r.v1 >> 32);
    LAS unsigned char* vt = tb + o.wv;
    *(LAS unsigned*)(vt) = (a0 & 0xffffu) | (b0 << 16);
    *(LAS unsigned*)(vt + VSTR) = (a0 >> 16) | (b0 & 0xffff0000u);
    *(LAS unsigned*)(vt + 2 * VSTR) = (a1 & 0xffffu) | (b1 << 16);
    *(LAS unsigned*)(vt + 3 * VSTR) = (a1 >> 16) | (b1 & 0xffff0000u);
}
__device__ __forceinline__ void stage_tile_f32(const float* base, long row0, int kvh, LAS unsigned char* tb, int tid) {
    const int key = tid >> 3, ch = tid & 7, kp = tid >> 4, dq = tid & 15;
    const GAS f32x4* kpx = (const GAS f32x4*)(base + (size_t)(row0 + key) * KVW + kvh * 128 + ch * 8);
    const f32x4 k0 = kpx[0], k1 = kpx[1];
    const f32x4 va = *(const GAS f32x4*)(base + (size_t)(row0 + 2 * kp) * KVW + kvh * 128 + 64 + dq * 4);
    const f32x4 vb = *(const GAS f32x4*)(base + (size_t)(row0 + 2 * kp + 1) * KVW + kvh * 128 + 64 + dq * 4);
    v4u o; o.x = pk2(k0.x, k0.y); o.y = pk2(k0.z, k0.w); o.z = pk2(k1.x, k1.y); o.w = pk2(k1.z, k1.w);
    *(LAS v4u*)(tb + key * KSTR + ch * 16) = o;
    LAS unsigned char* vt = tb + TILE_K_BYTES + (4 * dq) * VSTR + vpos(2 * kp) * 2;
    *(LAS unsigned*)(vt) = pk2(va.x, vb.x); *(LAS unsigned*)(vt + VSTR) = pk2(va.y, vb.y); *(LAS unsigned*)(vt + 2 * VSTR) = pk2(va.z, vb.z); *(LAS unsigned*)(vt + 3 * VSTR) = pk2(va.w, vb.w);
}


struct StageRegsF { f32x4 k0, k1, va, vb; };
__device__ __forceinline__ void stage_f32_issue(const float* base, long row0, int kvh, int tid_, StageRegsF& r) {
    int tid = tid_; asm volatile("" : "+v"(tid));
    const int key = tid >> 3, ch = tid & 7, kp = tid >> 4, dq = tid & 15;
    const GAS f32x4* kpx = (const GAS f32x4*)(base + (size_t)(row0 + key) * KVW + kvh * 128 + ch * 8);
    r.k0 = kpx[0]; r.k1 = kpx[1];
    r.va = *(const GAS f32x4*)(base + (size_t)(row0 + 2 * kp) * KVW + kvh * 128 + 64 + dq * 4);
    r.vb = *(const GAS f32x4*)(base + (size_t)(row0 + 2 * kp + 1) * KVW + kvh * 128 + 64 + dq * 4);
}
__device__ __forceinline__ void stage_f32_commit(const StageRegsF& r, LAS unsigned char* tb, int tid_) {
    int tid = tid_; asm volatile("" : "+v"(tid));
    const int key = tid >> 3, ch = tid & 7, kp = tid >> 4, dq = tid & 15;
    v4u o; o.x = pk2(r.k0.x, r.k0.y); o.y = pk2(r.k0.z, r.k0.w); o.z = pk2(r.k1.x, r.k1.y); o.w = pk2(r.k1.z, r.k1.w);
    *(LAS v4u*)(tb + key * KSTR + ch * 16) = o;
    LAS unsigned char* vt = tb + TILE_K_BYTES + (4 * dq) * VSTR + vpos(2 * kp) * 2;
    *(LAS unsigned*)(vt) = pk2(r.va.x, r.vb.x); *(LAS unsigned*)(vt + VSTR) = pk2(r.va.y, r.vb.y); *(LAS unsigned*)(vt + 2 * VSTR) = pk2(r.va.z, r.vb.z); *(LAS unsigned*)(vt + 3 * VSTR) = pk2(r.va.w, r.vb.w);
}

struct StageOffF { unsigned offk, offv, wk, wv; };
__device__ __forceinline__ StageOffF stage_off_f32(int tid) {
    StageOffF o; const int key = tid >> 3, ch = tid & 7, kp = tid >> 4, dq = tid & 15;
    o.offk = (unsigned)key * (KVW * 4) + (unsigned)ch * 32; o.offv = (unsigned)kp * (2 * KVW * 4) + 256 + (unsigned)dq * 16;
    o.wk = (unsigned)(key * KSTR + ch * 16); o.wv = (unsigned)(TILE_K_BYTES + (4 * dq) * VSTR + vpos(2 * kp) * 2);
    asm volatile("" : "+v"(o.offk), "+v"(o.offv), "+v"(o.wk), "+v"(o.wv));
    return o;
}
__device__ __forceinline__ void stage_f32_issue_off(const float* base, int row0  , int kvh, const StageOffF& o, StageRegsF& r) {
    const GAS unsigned char* ub = (const GAS unsigned char*)(base + (size_t)__builtin_amdgcn_readfirstlane(row0) * KVW + kvh * 128);
    r.k0 = __builtin_nontemporal_load((const GAS f32x4*)(ub + o.offk)); r.k1 = __builtin_nontemporal_load((const GAS f32x4*)(ub + o.offk + 16));
    r.va = __builtin_nontemporal_load((const GAS f32x4*)(ub + o.offv)); r.vb = __builtin_nontemporal_load((const GAS f32x4*)(ub + o.offv + KVW * 4));
}
__device__ __forceinline__ void stage_f32_commit_off(const StageRegsF& r, LAS unsigned char* tb, const StageOffF& o) {
    v4u w; w.x = pk2(r.k0.x, r.k0.y); w.y = pk2(r.k0.z, r.k0.w); w.z = pk2(r.k1.x, r.k1.y); w.w = pk2(r.k1.z, r.k1.w);
    *(LAS v4u*)(tb + o.wk) = w;
    LAS unsigned char* vt = tb + o.wv;
    *(LAS unsigned*)(vt) = pk2(r.va.x, r.vb.x); *(LAS unsigned*)(vt + VSTR) = pk2(r.va.y, r.vb.y); *(LAS unsigned*)(vt + 2 * VSTR) = pk2(r.va.z, r.vb.z); *(LAS unsigned*)(vt + 3 * VSTR) = pk2(r.va.w, r.vb.w);
}

__device__ __forceinline__ void split8(const f32x4 a, const f32x4 b, v4u& hi, v4u& lo) {
    const float x[8] = {a.x, a.y, a.z, a.w, b.x, b.y, b.z, b.w}; unsigned h[8], l[8];
#pragma unroll
    for (int i = 0; i < 8; ++i) { h[i] = f2bf(x[i]); l[i] = f2bf(x[i] - __uint_as_float(h[i] << 16)); }
    hi.x = h[0] | (h[1] << 16); hi.y = h[2] | (h[3] << 16); hi.z = h[4] | (h[5] << 16); hi.w = h[6] | (h[7] << 16);
    lo.x = l[0] | (l[1] << 16); lo.y = l[2] | (l[3] << 16); lo.z = l[4] | (l[5] << 16); lo.w = l[6] | (l[7] << 16);
}
__device__ __forceinline__ void stage_k_hilo(const float* base, long row0, int kvh, LAS unsigned char* tb, LAS unsigned char* tb_lo, int tid) {
    const int key = tid >> 3, ch = tid & 7;
    const GAS f32x4* kp = (const GAS f32x4*)(base + ((size_t)(row0 + key) * 4 + kvh) * 64 + ch * 8);
    v4u hi, lo; split8(kp[0], kp[1], hi, lo);
    *(LAS v4u*)(tb + key * KSTR + ch * 16) = hi; *(LAS v4u*)(tb_lo + key * KSTR + ch * 16) = lo;
}

template <int MODE  , bool SPLIT = false>
__device__ __forceinline__ void attn_tile(const LAS unsigned char* tb, const bf16x8 (&qf)[4], float cinit, int qpos, int kpos0, bool sel,
                                          const LAS float* lut, float& m_run, float& l_run, f32x16& o0, f32x16& o1, f32x16& p0, f32x16& p1, int lane,
                                          const LAS unsigned char* tb_lo = nullptr, const bf16x8* qlo = nullptr) {
    constexpr bool NEAR = MODE != 0;
    constexpr int KS = MODE == 3 ? 64 : 1;
    const int r32 = lane & 31, h2 = lane >> 5;
    const float c0 = NEAR ? 0.f : cinit;
#pragma unroll
    for (int i = 0; i < 16; ++i) { p0[i] = c0; p1[i] = c0; }
#pragma unroll
    for (int ks = 0; ks < 4; ++ks) {
        const bf16x8 ka = *(const LAS bf16x8*)(tb + r32 * KSTR + (16 * ks + 8 * h2) * 2);
        const bf16x8 kb = *(const LAS bf16x8*)(tb + (32 + r32) * KSTR + (16 * ks + 8 * h2) * 2);
        p0 = MFMA32(ka, qf[ks], p0); p1 = MFMA32(kb, qf[ks], p1);
        if (SPLIT) {
            const bf16x8 la = *(const LAS bf16x8*)(tb_lo + r32 * KSTR + (16 * ks + 8 * h2) * 2);
            const bf16x8 lb = *(const LAS bf16x8*)(tb_lo + (32 + r32) * KSTR + (16 * ks + 8 * h2) * 2);
            p0 = MFMA32(ka, qlo[ks], p0); p1 = MFMA32(kb, qlo[ks], p1);
            p0 = MFMA32(la, qf[ks], p0); p1 = MFMA32(lb, qf[ks], p1);
        }
    }
    if (NEAR) {
        int base = sel ? qpos - kpos0 - KS * 4 * h2 : -0x20000000;
        asm volatile("" : "+v"(base));
#pragma unroll
        for (int i = 0; i < 16; ++i) {
            const int d0 = base - KS * ((i & 3) + 8 * (i >> 2)), d1 = d0 - 32 * KS;
            const bool ok0 = MODE == 2 ? ((unsigned)d0 < 512u) : (d0 >= 0), ok1 = MODE == 2 ? ((unsigned)d1 < 512u) : (d1 >= 0);
            const float b0 = lut[min(max(d0, 0), 128)], b1 = lut[min(max(d1, 0), 128)];
            p0[i] = ok0 ? p0[i] + b0 : -INFINITY; p1[i] = ok1 ? p1[i] + b1 : -INFINITY;
        }
    }
    float mx = fmaxf(p0[0], p1[0]);
#pragma unroll
    for (int i = 1; i < 16; ++i) mx = fmaxf(mx, fmaxf(p0[i], p1[i]));
    mx = fmaxf(mx, __shfl_xor(mx, 32));
    const float m_new = fmaxf(m_run, mx), alpha = fast_exp2(m_run - m_new);
    m_run = m_new;
    float rs = 0.f;
#pragma unroll
    for (int i = 0; i < 16; ++i) { p0[i] = fast_exp2(p0[i] - m_new); p1[i] = fast_exp2(p1[i] - m_new); rs += p0[i] + p1[i]; }
    l_run = l_run * alpha + rs;
#pragma unroll
    for (int i = 0; i < 16; ++i) { o0[i] *= alpha; o1[i] *= alpha; }
#pragma unroll
    for (int kt = 0; kt < 2; ++kt)
#pragma unroll
        for (int k2 = 0; k2 < 2; ++k2) {
            v4u bw;
            if (kt == 0) { bw.x = cvtpk(p0[8 * k2], p0[8 * k2 + 1]); bw.y = cvtpk(p0[8 * k2 + 2], p0[8 * k2 + 3]); bw.z = cvtpk(p0[8 * k2 + 4], p0[8 * k2 + 5]); bw.w = cvtpk(p0[8 * k2 + 6], p0[8 * k2 + 7]); }
            else         { bw.x = cvtpk(p1[8 * k2], p1[8 * k2 + 1]); bw.y = cvtpk(p1[8 * k2 + 2], p1[8 * k2 + 3]); bw.z = cvtpk(p1[8 * k2 + 4], p1[8 * k2 + 5]); bw.w = cvtpk(p1[8 * k2 + 6], p1[8 * k2 + 7]); }
            const bf16x8 pb = __builtin_bit_cast(bf16x8, bw);
            typedef u64 u64x2 __attribute__((ext_vector_type(2)));
            const LAS unsigned char* vp = tb + TILE_K_BYTES + r32 * VSTR + (32 * kt + 16 * k2 + 8 * h2) * 2;
            const bf16x8 a0 = *(const LAS bf16x8*)vp, a1 = *(const LAS bf16x8*)(vp + 32 * VSTR);
            o0 = MFMA32(a0, pb, o0);
            o1 = MFMA32(a1, pb, o1);
        }
}

template <int MODE>
__device__ __forceinline__ void attn_tile_fixed(const LAS unsigned char* tb, const bf16x8 (&qf)[4], float cinit, int qpos, int kpos0, bool sel,
                                                const LAS float* lut, float mq, float& l_run, f32x16& o0, f32x16& o1, int lane_, unsigned loff) {
    constexpr bool NEAR = MODE != 0;
    int lane = lane_; asm volatile("" : "+v"(lane));
    const int h2 = lane >> 5;
    const LAS unsigned char* tl = tb + loff;
    const float c0 = NEAR ? -mq : cinit;
    f32x16 p0, p1;
#pragma unroll
    for (int i = 0; i < 16; ++i) { p0[i] = c0; p1[i] = c0; }
    {
        bf16x8 kf[8];
#pragma unroll
        for (int ks = 0; ks < 4; ++ks) { kf[2 * ks] = *(const LAS bf16x8*)(tl + 32 * ks); kf[2 * ks + 1] = *(const LAS bf16x8*)(tl + 32 * KSTR + 32 * ks); }
        asm volatile("s_waitcnt lgkmcnt(0)" ::: "memory");
#pragma unroll
        for (int ks = 0; ks < 4; ++ks) { p0 = MFMA32(kf[2 * ks], qf[ks], p0); p1 = MFMA32(kf[2 * ks + 1], qf[ks], p1); }
    }
    if (NEAR) {
        int base = sel ? qpos - kpos0 - 4 * h2 : -0x20000000;
        asm volatile("" : "+v"(base));
#pragma unroll
        for (int i = 0; i < 16; ++i) {
            const int d0 = base - ((i & 3) + 8 * (i >> 2)), d1 = d0 - 32;
            const bool ok0 = MODE == 2 ? ((unsigned)d0 < 512u) : (d0 >= 0), ok1 = MODE == 2 ? ((unsigned)d1 < 512u) : (d1 >= 0);
            const float b0 = lut[min(max(d0, 0), 128)], b1 = lut[min(max(d1, 0), 128)];
            p0[i] = ok0 ? p0[i] + b0 : -INFINITY; p1[i] = ok1 ? p1[i] + b1 : -INFINITY;
        }
    }
    float rs = 0.f;
#pragma unroll
    for (int i = 0; i < 16; ++i) { p0[i] = fast_exp2(p0[i]); p1[i] = fast_exp2(p1[i]); rs += p0[i] + p1[i]; }
    l_run += rs;
    {
        typedef u64 u64x2 __attribute__((ext_vector_type(2)));
        bf16x8 va[4], vb[4];
#pragma unroll
        for (int q = 0; q < 4; ++q) { const LAS unsigned char* vp = tl + TILE_K_BYTES + 32 * q;
            va[q] = *(const LAS bf16x8*)vp; vb[q] = *(const LAS bf16x8*)(vp + 32 * VSTR); }
        bf16x8 pb[4];
#pragma unroll
        for (int q = 0; q < 4; ++q) { v4u bw;
            if (q < 2) { bw.x = cvtpk(p0[8 * q], p0[8 * q + 1]); bw.y = cvtpk(p0[8 * q + 2], p0[8 * q + 3]); bw.z = cvtpk(p0[8 * q + 4], p0[8 * q + 5]); bw.w = cvtpk(p0[8 * q + 6], p0[8 * q + 7]); }
            else { const int k2 = q - 2; bw.x = cvtpk(p1[8 * k2], p1[8 * k2 + 1]); bw.y = cvtpk(p1[8 * k2 + 2], p1[8 * k2 + 3]); bw.z = cvtpk(p1[8 * k2 + 4], p1[8 * k2 + 5]); bw.w = cvtpk(p1[8 * k2 + 6], p1[8 * k2 + 7]); }
            pb[q] = __builtin_bit_cast(bf16x8, bw); }
        asm volatile("s_waitcnt lgkmcnt(0)" ::: "memory");
#pragma unroll
        for (int q = 0; q < 4; ++q) { o0 = MFMA32(va[q], pb[q], o0); o1 = MFMA32(vb[q], pb[q], o1); }
    }
}

#define APIN(x) asm volatile("" : "+v"(x))
#define ASB() __builtin_amdgcn_sched_barrier(0)
__device__ __forceinline__ void attn_far_first(const LAS unsigned char* buf, const bf16x8 (&qf)[4], f32x16& C0, f32x16& C1, float cin, unsigned loff) {
    const LAS unsigned char* kp = buf + loff;
    f32x16 Zc;
#pragma unroll
    for (int i = 0; i < 16; ++i) Zc[i] = cin;
#pragma unroll
    for (int ks = 0; ks < 4; ++ks) {
        const bf16x8 ka = *(const LAS bf16x8*)(kp + 32 * ks), kb = *(const LAS bf16x8*)(kp + 32 * KSTR + 32 * ks);
        C0 = MFMA32(ka, qf[ks], ks == 0 ? Zc : C0); C1 = MFMA32(kb, qf[ks], ks == 0 ? Zc : C1); }
#pragma unroll
    for (int i = 0; i < 16; ++i) { C0[i] = fast_exp2(C0[i]); C1[i] = fast_exp2(C1[i]); }
}
__device__ __forceinline__ void attn_far_step(const LAS unsigned char* bufK, const LAS unsigned char* bufV, const bf16x8 (&qf)[4],
                                              f32x16& C0, f32x16& C1, f32x16& P0, f32x16& P1, float cin, float& l_run, f32x16& o0, f32x16& o1, unsigned loff) {
    const LAS unsigned char* vp = bufV + TILE_K_BYTES + loff;
    const LAS unsigned char* kp = bufK + loff;
#define KFR_(i) (*(const LAS bf16x8*)(kp + 32 * ((i) >> 1) + ((i) & 1) * 32 * KSTR))
#define VFR_(i) (*(const LAS bf16x8*)(vp + 32 * ((i) >> 1) + ((i) & 1) * 32 * VSTR))
    bf16x8 k0, k1, k2, k3, k4, k5, k6, k7, v0, v1, v2, v3, v4, v5, v6, v7; v4u pw0, pw1, pw2, pw3;
    typedef u64 u64x8 __attribute__((ext_vector_type(8)));
    const u64 c2 = ((u64)__float_as_uint(cin) << 32) | (u64)__float_as_uint(cin);
    const u64x8 z8 = {c2, c2, c2, c2, c2, c2, c2, c2};
    const f32x16 Z = __builtin_bit_cast(f32x16, z8);
    ASB();
    k0 = KFR_(0); k1 = KFR_(1); k2 = KFR_(2); ASB();
    float sacc = P0[0] + P0[1];
#define GAPA_(RD, MF, a0, a1, a2, a3, WA, EA, WB, EB) do { RD; ASB(); MF; sacc += a0; sacc += a1; sacc += a2; sacc += a3; WA = EA; WB = EB; APIN(WA); APIN(WB); APIN(sacc); ASB(); } while (0)
    unsigned w00, w01, w02, w03, w10, w11, w12, w13, w20, w21, w22, w23, w30, w31, w32, w33;
    GAPA_(k3 = KFR_(3), C0 = MFMA32(k0, qf[0], Z),  P0[2], P0[3], P0[4], P0[5],     w00, cvtpk(P0[0], P0[1]),   w01, cvtpk(P0[2], P0[3]));
    GAPA_(k4 = KFR_(4), C1 = MFMA32(k1, qf[0], Z),  P0[6], P0[7], P0[8], P0[9],     w02, cvtpk(P0[4], P0[5]),   w03, cvtpk(P0[6], P0[7]));
    GAPA_(k5 = KFR_(5), C0 = MFMA32(k2, qf[1], C0), P0[10], P0[11], P0[12], P0[13], w10, cvtpk(P0[8], P0[9]),   w11, cvtpk(P0[10], P0[11]));
    GAPA_(k6 = KFR_(6), C1 = MFMA32(k3, qf[1], C1), P0[14], P0[15], P1[0], P1[1],   w12, cvtpk(P0[12], P0[13]), w13, cvtpk(P0[14], P0[15]));
    GAPA_(k7 = KFR_(7), C0 = MFMA32(k4, qf[2], C0), P1[2], P1[3], P1[4], P1[5],     w20, cvtpk(P1[0], P1[1]),   w21, cvtpk(P1[2], P1[3]));
    GAPA_(v0 = VFR_(0), C1 = MFMA32(k5, qf[2], C1), P1[6], P1[7], P1[8], P1[9],     w22, cvtpk(P1[4], P1[5]),   w23, cvtpk(P1[6], P1[7]));
    GAPA_(v1 = VFR_(1), C0 = MFMA32(k6, qf[3], C0), P1[10], P1[11], P1[12], P1[13], w30, cvtpk(P1[8], P1[9]),   w31, cvtpk(P1[10], P1[11]));
    GAPA_(v2 = VFR_(2), C1 = MFMA32(k7, qf[3], C1), P1[14], P1[15], 0.f, 0.f,       w32, cvtpk(P1[12], P1[13]), w33, cvtpk(P1[14], P1[15]));
    l_run += sacc;
    pw0 = (v4u){w00, w01, w02, w03}; pw1 = (v4u){w10, w11, w12, w13}; pw2 = (v4u){w20, w21, w22, w23}; pw3 = (v4u){w30, w31, w32, w33};
    const bf16x8 pb0 = __builtin_bit_cast(bf16x8, pw0), pb1 = __builtin_bit_cast(bf16x8, pw1), pb2 = __builtin_bit_cast(bf16x8, pw2), pb3 = __builtin_bit_cast(bf16x8, pw3);
#define EX_(v) fast_exp2(v)
#define GAPB_(RD, MF, X, i) do { RD; ASB(); MF; X[i] = EX_(X[i]); X[i + 1] = EX_(X[i + 1]); X[i + 2] = EX_(X[i + 2]); X[i + 3] = EX_(X[i + 3]); APIN(X); ASB(); } while (0)
    GAPB_(v3 = VFR_(3), o0 = MFMA32(v0, pb0, o0), C0, 0);
    GAPB_(v4 = VFR_(4), o1 = MFMA32(v1, pb0, o1), C0, 4);
    GAPB_(v5 = VFR_(5), o0 = MFMA32(v2, pb1, o0), C0, 8);
    GAPB_(v6 = VFR_(6), o1 = MFMA32(v3, pb1, o1), C0, 12);
    GAPB_(v7 = VFR_(7), o0 = MFMA32(v4, pb2, o0), C1, 0);
    GAPB_((void)0,      o1 = MFMA32(v5, pb2, o1), C1, 4);
    GAPB_((void)0,      o0 = MFMA32(v6, pb3, o0), C1, 8);
    GAPB_((void)0,      o1 = MFMA32(v7, pb3, o1), C1, 12);
#undef KFR_
#undef VFR_
#undef GAPA_
#undef EX_
#undef GAPB_
}
__device__ __forceinline__ void attn_far_drain(const LAS unsigned char* bufV, const f32x16& P0, const f32x16& P1, float& l_run, f32x16& o0, f32x16& o1, unsigned loff) {
    const LAS unsigned char* vp = bufV + TILE_K_BYTES + loff;
    float sacc = 0.f;
#pragma unroll
    for (int i = 0; i < 16; ++i) sacc += P0[i] + P1[i];
    l_run += sacc;
#pragma unroll
    for (int q = 0; q < 4; ++q) {
        const bf16x8 va = *(const LAS bf16x8*)(vp + 32 * q), vb = *(const LAS bf16x8*)(vp + 32 * VSTR + 32 * q);
        v4u bw;
        if (q < 2) { bw.x = cvtpk(P0[8 * q], P0[8 * q + 1]); bw.y = cvtpk(P0[8 * q + 2], P0[8 * q + 3]); bw.z = cvtpk(P0[8 * q + 4], P0[8 * q + 5]); bw.w = cvtpk(P0[8 * q + 6], P0[8 * q + 7]); }
        else { const int k2 = q - 2; bw.x = cvtpk(P1[8 * k2], P1[8 * k2 + 1]); bw.y = cvtpk(P1[8 * k2 + 2], P1[8 * k2 + 3]); bw.z = cvtpk(P1[8 * k2 + 4], P1[8 * k2 + 5]); bw.w = cvtpk(P1[8 * k2 + 6], P1[8 * k2 + 7]); }
        const bf16x8 pb = __builtin_bit_cast(bf16x8, bw);
        o0 = MFMA32(va, pb, o0); o1 = MFMA32(vb, pb, o1);
    }
}

template <bool F32SRC, int NRT>
__device__ __forceinline__ void compress_unit(const void* src, const int* pt, long token0, int blk0, const bf16* WCF, const bf16* WCFL, const float* PEB, bf16* dst  ,
                                              float* dst32  , LAS unsigned char* lds, int tid_, int wave, int lane_) {
    asm volatile("; MARK_compress_unit_BEGIN" ::: "memory");
    int tid = tid_, lane = lane_; asm volatile("" : "+v"(tid), "+v"(lane));
    const int r32 = lane & 31, h2 = lane >> 5;
    LAS float* red = (LAS float*)lds;
    LAS float* pebs = (LAS float*)(lds + 98304);
    if (tid < 128) { float sp = 0.f;
#pragma unroll
        for (int k = 0; k < 16; ++k) sp += PEB[k * 128 + tid];
        pebs[tid] = sp; }
    for (int c = 0; c < 2; ++c) {
        f32x16 acc[NRT][2];
#pragma unroll
        for (int a = 0; a < NRT; ++a)
#pragma unroll
            for (int e = 0; e < 2; ++e)
#pragma unroll
                for (int i = 0; i < 16; ++i) acc[a][e][i] = 0.f;
#pragma unroll 4
        for (int li = 0; li < 8; ++li) {
            const int lp = 8 * wave + li;
#pragma unroll
            for (int rt = 0; rt < NRT; ++rt) {
                const int nl = 8 * rt + (r32 >> 2), kvh = r32 & 3, blk = blk0 + nl;
                bf16x8 af[4], al[4];
                if (F32SRC) {
                    const int page = pt[blk >> 1];
                    const GAS f32x4* p = (const GAS f32x4*)((const float*)src + (((size_t)page * 128 + (blk & 1) * 64 + lp) * 4 + kvh) * 128 + c * 64 + 16 * h2);
#pragma unroll
                    for (int uu = 0; uu < 2; ++uu) { const f32x4 x0 = p[8 * uu], x1 = p[8 * uu + 1], x2 = p[8 * uu + 2], x3 = p[8 * uu + 3];
                        v4u w0, w1, l0, l1; split8(x0, x1, w0, l0); split8(x2, x3, w1, l1);
                        af[2 * uu] = __builtin_bit_cast(bf16x8, w0); af[2 * uu + 1] = __builtin_bit_cast(bf16x8, w1);
                        al[2 * uu] = __builtin_bit_cast(bf16x8, l0); al[2 * uu + 1] = __builtin_bit_cast(bf16x8, l1); }
                } else {
                    const GAS v4u* p = (const GAS v4u*)((const bf16*)src + ((size_t)(token0 + (size_t)blk * 64 + lp) * 4 + kvh) * 128 + c * 64 + 16 * h2);
#pragma unroll
                    for (int uu = 0; uu < 2; ++uu) { af[2 * uu] = __builtin_bit_cast(bf16x8, p[4 * uu]); af[2 * uu + 1] = __builtin_bit_cast(bf16x8, p[4 * uu + 1]); }
                }
#pragma unroll
                for (int kk = 0; kk < 4; ++kk) {
                    const int ks = lp * 4 + kk;
                    const GAS v4u* wp = (const GAS v4u*)(WCF + ((((size_t)c * 256 + ks) * 2) * 64 + lane) * 8);
                    const bf16x8 w0 = __builtin_bit_cast(bf16x8, wp[0]), w1 = __builtin_bit_cast(bf16x8, wp[64]);
                    acc[rt][0] = MFMA32(af[kk], w0, acc[rt][0]); acc[rt][1] = MFMA32(af[kk], w1, acc[rt][1]);
                    if (SPLIT_RANK && F32SRC && c == 0) {
                        const GAS v4u* wl = (const GAS v4u*)(WCFL + (((size_t)ks * 2) * 64 + lane) * 8);
                        const bf16x8 v0 = __builtin_bit_cast(bf16x8, wl[0]), v1 = __builtin_bit_cast(bf16x8, wl[64]);
                        acc[rt][0] = MFMA32(af[kk], v0, acc[rt][0]); acc[rt][1] = MFMA32(af[kk], v1, acc[rt][1]);
                        acc[rt][0] = MFMA32(al[kk], w0, acc[rt][0]); acc[rt][1] = MFMA32(al[kk], w1, acc[rt][1]);
                    }
                }
            }
        }
        wg_sync();
        LAS float* my = red + (wave & 3) * (NRT * 2048);
        if (wave < 4) {
#pragma unroll
            for (int rt = 0; rt < NRT; ++rt)
#pragma unroll
                for (int e = 0; e < 2; ++e)
#pragma unroll
                    for (int i = 0; i < 16; ++i) my[(32 * rt + crow(i, h2)) * 64 + 32 * e + r32] = acc[rt][e][i];
        }
        wg_sync();
        if (wave >= 4) {
#pragma unroll
            for (int rt = 0; rt < NRT; ++rt)
#pragma unroll
                for (int e = 0; e < 2; ++e)
#pragma unroll
                    for (int i = 0; i < 16; ++i) my[(32 * rt + crow(i, h2)) * 64 + 32 * e + r32] += acc[rt][e][i];
        }
        wg_sync();
        for (int idx = tid; idx < NRT * 2048; idx += NWAVES * 64) {
            const int row = idx >> 6, e = idx & 63, nl = row >> 2, kvh = row & 3;
            const float v = (red[idx] + red[NRT * 2048 + idx]) + (red[2 * NRT * 2048 + idx] + red[3 * NRT * 2048 + idx]) + pebs[c * 64 + e];
            dst[(((size_t)nl * 4 + kvh) * 2 + c) * 64 + e] = (bf16)f2bf(v);
            if (SPLIT_RANK && F32SRC && c == 0) dst32[((size_t)nl * 4 + kvh) * 64 + e] = v;
        }
    }
    wg_sync();
}

template <bool BF>
__device__ __forceinline__ void compress_sample_unit(const void* src_, const int* pt, int blk0, const bf16* WCF, const float* PEB, bf16* dst  ,
                                                     LAS unsigned char* lds, int tid_, int wave, int lane_) {
    const float* src = (const float*)src_;
    asm volatile("; MARK_compress_sample_BEGIN" ::: "memory");
    int tid = tid_, lane = lane_; asm volatile("" : "+v"(tid), "+v"(lane));
    constexpr int RSTR = 272;
    const int r32 = lane & 31, h2 = lane >> 5;
    LAS unsigned char* my = lds + wave * (32 * RSTR);
    LAS float* red = (LAS float*)lds;
    LAS float* pebs = (LAS float*)(lds + 98304);
    if (tid < 128) { float sp = 0.f;
#pragma unroll
        for (int k = 0; k < 16; ++k) sp += PEB[k * 128 + tid];
        pebs[tid] = sp; }
    int pg0 = 0, pg1 = 0, pg2 = 0, pg3 = 0;
    if (!BF) { pg0 = pt[(blk0 >> 1)]; pg1 = pt[(blk0 >> 1) + 1]; pg2 = pt[(blk0 >> 1) + 2]; pg3 = pt[(blk0 >> 1) + 3]; }
    const bf16* sb = (const bf16*)src_ + (size_t)blk0 * (64 * 512) + lane * 8;
    const float* rb0 = src + (size_t)pg0 * (128 * 512) + lane * 4; const float* rb1 = src + (size_t)pg1 * (128 * 512) + lane * 4;
    const float* rb2 = src + (size_t)pg2 * (128 * 512) + lane * 4; const float* rb3 = src + (size_t)pg3 * (128 * 512) + lane * 4;
    f32x16 acc00, acc01, acc10, acc11;
#pragma unroll
    for (int i = 0; i < 16; ++i) { acc00[i] = 0.f; acc01[i] = 0.f; acc10[i] = 0.f; acc11[i] = 0.f; }
    f32x4 st[16];
#define CS_ISSUE(lp) do { if (BF) { _Pragma("unroll") for (int q = 0; q < 8; ++q) st[q] = __builtin_bit_cast(f32x4, __builtin_nontemporal_load((const GAS v4u*)(sb + (size_t)(q * 64 + (lp)) * 512))); } \
    else { _Pragma("unroll") for (int q = 0; q < 16; ++q) { const int bl = q >> 1; const float* rb = (bl >> 1) == 0 ? rb0 : ((bl >> 1) == 1 ? rb1 : ((bl >> 1) == 2 ? rb2 : rb3)); \
        st[q] = __builtin_nontemporal_load((const GAS f32x4*)(rb + (size_t)((bl & 1) * 64 + (lp)) * 512 + (q & 1) * 256)); } } } while (0)
    CS_ISSUE(8 * wave);
#pragma unroll 1
    for (int i = 0; i < 8; ++i) {
        const int lp = 8 * wave + i;
        v4u wf[16];
#pragma unroll
        for (int c = 0; c < 2; ++c)
#pragma unroll
            for (int kk = 0; kk < 4; ++kk) { const GAS v4u* wp = (const GAS v4u*)(WCF + ((((size_t)c * 256 + lp * 4 + kk) * 2) * 64 + lane) * 8);
                wf[(c * 4 + kk) * 2] = wp[0]; wf[(c * 4 + kk) * 2 + 1] = wp[64]; }
        if (BF) {
#pragma unroll
            for (int q = 0; q < 8; ++q) *(LAS v4u*)(my + (q * 4 + (lane >> 4)) * RSTR + (lane & 15) * 16) = __builtin_bit_cast(v4u, st[q]);
        } else
#pragma unroll
        for (int q = 0; q < 16; ++q) {
            const f32x4 x = st[q];
            typedef unsigned u32x2 __attribute__((ext_vector_type(2)));
            u32x2 o; o.x = cvtpk(x.x, x.y); o.y = cvtpk(x.z, x.w);
            *(LAS u32x2*)(my + ((q >> 1) * 4 + (q & 1) * 2 + h2) * RSTR + r32 * 8) = o;
        }
        if (i < 7) CS_ISSUE(lp + 1);
#pragma unroll
        for (int kk = 0; kk < 4; ++kk) {
            const LAS unsigned char* ap = my + r32 * RSTR + (32 * (kk >> 1) + 16 * h2 + 8 * (kk & 1)) * 2;
            const bf16x8 a0 = *(const LAS bf16x8*)ap, a1 = *(const LAS bf16x8*)(ap + 128);
            acc00 = MFMA32(a0, __builtin_bit_cast(bf16x8, wf[kk * 2]), acc00); acc01 = MFMA32(a0, __builtin_bit_cast(bf16x8, wf[kk * 2 + 1]), acc01);
            acc10 = MFMA32(a1, __builtin_bit_cast(bf16x8, wf[(4 + kk) * 2]), acc10); acc11 = MFMA32(a1, __builtin_bit_cast(bf16x8, wf[(4 + kk) * 2 + 1]), acc11);
        }
    }
#undef CS_ISSUE
#pragma unroll
    for (int c = 0; c < 2; ++c) {
        wg_sync();
        LAS float* mys = red + (wave & 3) * 2048;
        if (wave < 4) {
#pragma unroll
            for (int i = 0; i < 16; ++i) { mys[crow(i, h2) * 64 + r32] = c == 0 ? acc00[i] : acc10[i]; mys[crow(i, h2) * 64 + 32 + r32] = c == 0 ? acc01[i] : acc11[i]; }
        }
        wg_sync();
        if (wave >= 4) {
#pragma unroll
            for (int i = 0; i < 16; ++i) { mys[crow(i, h2) * 64 + r32] += c == 0 ? acc00[i] : acc10[i]; mys[crow(i, h2) * 64 + 32 + r32] += c == 0 ? acc01[i] : acc11[i]; }
        }
        wg_sync();
        for (int idx = tid; idx < 2048; idx += NWAVES * 64) {
            const int row = idx >> 6, e = idx & 63, nl = row >> 2, kvh = row & 3;
            const float v = (red[idx] + red[2048 + idx]) + (red[2 * 2048 + idx] + red[3 * 2048 + idx]) + pebs[c * 64 + e];
            dst[(((size_t)nl * 4 + kvh) * 2 + c) * 64 + e] = (bf16)f2bf(v);
        }
    }
    wg_sync();
}

constexpr int AP_TB0 = 0, AP_TB1 = TILE_BYTES, AP_IMP = 4 * TILE_BYTES, AP_LUT = AP_IMP + 4 * 64 * 64 * 4, AP_SEL = AP_LUT + 4 * LUT_STRIDE * 4, AP_TL = AP_SEL + 64 * 8, AP_CT = AP_TL + 96 * 4, AP_END = AP_CT + TILE_BYTES;
static_assert(AP_END <= MISC_OFF, "prompt attention LDS map");
__device__ __forceinline__ void attn_prompt_unit(bool fresh  , int b, int kvh, int qb, const bf16* QB, const bf16* KCP, const bf16* SKV, const bf16* WKV, const float* GATES, const float* rel_table,
                                                 const float* KMP, bf16* MIX, float* SSQA, LAS unsigned char* lds, int tid_, int wave, int lane_) {
    asm volatile("; MARK_attn_prompt_unit_BEGIN" ::: "memory");
    int tid = tid_, lane = lane_; asm volatile("" : "+v"(tid), "+v"(lane));
    const int g = wave >> 1, th = wave & 1, r32 = lane & 31, h2 = lane >> 5;
    const int tl = 32 * th + r32, t = 64 * qb + tl, m = b * SEQ + t, hh = kvh * 4 + g;
    LAS unsigned char* TB0 = lds + AP_TB0; LAS unsigned char* TB1 = lds + AP_TB1;
    LAS float* IMP = (LAS float*)(lds + AP_IMP); LAS float* LUT = (LAS float*)(lds + AP_LUT); LAS u64* SEL = (LAS u64*)(lds + AP_SEL); LAS int* TL = (LAS int*)(lds + AP_TL);
    bf16x8 qf[4];
#pragma unroll
    for (int ks = 0; ks < 4; ++ks) qf[ks] = __builtin_bit_cast(bf16x8, *(const GAS v4u*)(QB + (size_t)m * DM + hh * 64 + 16 * ks + 8 * h2));
    if (fresh) for (int idx = tid; idx < 4 * 129; idx += NWAVES * 64) { const int gg = idx / 129, d = idx % 129; LUT[gg * LUT_STRIDE + d] = rel_table[BKT[d] * 16 + kvh * 4 + gg] * LOG2E; }
    const float gate_c = sigmoid_f(GATES[(size_t)m * 48 + hh * 3 + 0]), gate_s = sigmoid_f(GATES[(size_t)m * 48 + hh * 3 + 1]), gate_w = sigmoid_f(GATES[(size_t)m * 48 + hh * 3 + 2]);
    const float bias_far = rel_table[31 * 16 + hh] * LOG2E;
    const LAS float* lut = LUT + g * LUT_STRIDE;
    if (fresh) stage_tile_bf16(KCP, (long)b * 64, 64, kvh, lds + AP_CT, tid);
    wg_sync();
    float mq_s, mq_w;
    {
        float qq = 0.f;
#pragma unroll
        for (int ks = 0; ks < 4; ++ks)
#pragma unroll
            for (int e = 0; e < 8; ++e) { const float x = bf2f((unsigned short)qf[ks][e]); qq += x * x; }
        qq += __shfl_xor(qq, 32);
        float lmx = fmaxf(fmaxf(lut[lane], lut[64 + lane]), lut[128]);
#pragma unroll
        for (int o = 1; o < 64; o <<= 1) lmx = fmaxf(lmx, __shfl_xor(lmx, o));
        const float qn = sqrtf(qq) * 1.002f;
        LAS float* kred = (LAS float*)(lds + AP_TL + 70 * 4);
        if (fresh) {
            float ks_ = KMP[((size_t)b * 256 + (tid & 255)) * 4 + kvh], kw_ = KMP[((size_t)(NPR / 16) + b * 256 + (tid & 255)) * 4 + kvh];
#pragma unroll
            for (int o = 1; o < 64; o <<= 1) { ks_ = fmaxf(ks_, __shfl_xor(ks_, o)); kw_ = fmaxf(kw_, __shfl_xor(kw_, o)); }
            if (lane == 0) { kred[wave] = ks_; kred[8 + wave] = kw_; }
        }
        wg_sync();
        float kms = kred[0], kmw = kred[8];
#pragma unroll
        for (int w = 1; w < 8; ++w) { kms = fmaxf(kms, kred[w]); kmw = fmaxf(kmw, kred[8 + w]); }
        mq_s = qn * sqrtf(kms) + lmx;
        mq_w = qn * sqrtf(kmw) + lmx;
#ifdef PROBE_CONSTMQ
        mq_s = 30.f; mq_w = 30.f;
#endif
    }
    f32x16 ot0, ot1, o0, o1, p0, p1;
    float m_run = NEG_BIG, l_run = 0.f;
#pragma unroll
    for (int i = 0; i < 16; ++i) { o0[i] = 0.f; o1[i] = 0.f; }
    attn_tile<3>(lds + AP_CT, qf, 0.f, t, 63, true, lut, m_run, l_run, o0, o1, p0, p1, lane);
    {
        const float lt = l_run + __shfl_xor(l_run, 32), inv = lt > 0.f ? 1.0f / lt : 0.f, sc = gate_c * inv;
#pragma unroll
        for (int i = 0; i < 16; ++i) { ot0[i] = o0[i] * sc; ot1[i] = o1[i] * sc; }
        LAS float* slab = IMP + (g * 64 + tl) * 64;
#pragma unroll
        for (int i = 0; i < 16; ++i) { slab[crow(i, h2)] = p0[i] * inv; slab[32 + crow(i, h2)] = p1[i] * inv; }
    }
    wg_sync();
    if (qb < 16) { if (tid < 64) SEL[tid] = (2ull << qb) - 1ull; }
    else {
        for (int i = 0; i < 8; ++i) {
            const int tk = 8 * wave + i;
            const bool cand = (lane >= 1 && lane <= qb - 2);
            const float v = cand ? (IMP[(0 * 64 + tk) * 64 + lane] + IMP[(1 * 64 + tk) * 64 + lane]) + (IMP[(2 * 64 + tk) * 64 + lane] + IMP[(3 * 64 + tk) * 64 + lane]) : -1.f;
            const u64 key = cand ? ((((u64)__float_as_uint(v)) << 6) | (u64)(unsigned)(63 - lane)) : 0ull;
            u64 T13 = 0ull;
#pragma unroll
            for (int bp = 36; bp >= 0; --bp) { const u64 trial = T13 | (1ull << bp); const u64 bm = __ballot(key >= trial); const int cnt = __builtin_popcount((unsigned)bm) + __builtin_popcount((unsigned)(bm >> 32)); T13 = cnt >= 13 ? trial : T13; }
            const bool selected = (lane == 0 || lane == qb || lane == qb - 1) || (cand && key >= T13);
            const u64 mask = __ballot(selected);
            if (lane == 0) SEL[tk] = mask;
        }
    }
    wg_sync();
    if (wave == 0) {
        const u64 mine = SEL[lane]; unsigned lo = (unsigned)mine, hi = (unsigned)(mine >> 32);
#pragma unroll
        for (int o = 1; o < 64; o <<= 1) { lo |= __shfl_xor(lo, o); hi |= __shfl_xor(hi, o); }
        const u64 any = ((u64)hi << 32) | lo;
        const bool on = ((any >> lane) & 1ull) && lane <= qb;
        const u64 bal = __ballot(on);
        if (on) TL[1 + __popcll(bal & ((1ull << lane) - 1ull))] = lane;
        if (lane == 0) { TL[0] = __popcll(bal); TL[68] = qb >= 3 ? __popcll(bal & ((1ull << (qb - 2)) - 1ull)) : 0; }
    }
    wg_sync();
    const u64 mysel = SEL[tl];
    if (wave >= 4) __builtin_amdgcn_s_setprio(1);
    unsigned loff = (unsigned)((lane & 31) * KSTR + (lane >> 5) * 16); APIN(loff);
    LAS float* park = IMP + tid;
#pragma unroll
    for (int i = 0; i < 16; ++i) { park[i * 512] = ot0[i]; park[(16 + i) * 512] = ot1[i]; }
    const int ntl = TL[0];
    m_run = NEG_BIG; l_run = 0.f;
#pragma unroll
    for (int i = 0; i < 16; ++i) { o0[i] = 0.f; o1[i] = 0.f; }
    {
        StageRegs s1;
        const StageOff so = stage_off(tid);
        int it0 = 0;
        const int nfar = TL[68];
#define FB_(k) (lds + AP_TB0 + ((k) & 3) * TILE_BYTES)
#define SROW_(i) (b * SEQ + 64 * TL[1 + (i)])
#define FCIN_(i) ((((mysel >> TL[1 + (i)]) & 1ull) != 0ull) ? bias_far - mq_s : -INFINITY)
        if (nfar >= 4) {
            stage_tile_full(SKV, SROW_(0), kvh, FB_(0), tid); stage_tile_full(SKV, SROW_(1), kvh, FB_(1), tid); stage_tile_full(SKV, SROW_(2), kvh, FB_(2), tid);
            wg_sync();
            f32x16 A0, A1, B0, B1;
            attn_far_first(FB_(0), qf, A0, A1, FCIN_(0), loff);
            int tt = 1;
            for (; tt + 1 < nfar; tt += 2) {
                if (tt + 2 < nfar) stage_issue_off(SKV, SROW_(tt + 2), kvh, so, s1);
                attn_far_step(FB_(tt), FB_(tt - 1), qf, B0, B1, A0, A1, FCIN_(tt), l_run, o0, o1, loff);
                if (tt + 2 < nfar) stage_commit_off(s1, FB_(tt + 2), so);
                wg_sync();
                if (tt + 3 < nfar) stage_issue_off(SKV, SROW_(tt + 3), kvh, so, s1);
                attn_far_step(FB_(tt + 1), FB_(tt), qf, A0, A1, B0, B1, FCIN_(tt + 1), l_run, o0, o1, loff);
                if (tt + 3 < nfar) stage_commit_off(s1, FB_(tt + 3), so);
                wg_sync();
            }
            if (tt < nfar) {
                attn_far_step(FB_(tt), FB_(tt - 1), qf, B0, B1, A0, A1, FCIN_(tt), l_run, o0, o1, loff);
                attn_far_drain(FB_(tt), B0, B1, l_run, o0, o1, loff);
            } else attn_far_drain(FB_(nfar - 1), A0, A1, l_run, o0, o1, loff);
            wg_sync();
            it0 = nfar;
        }
#undef FB_
#undef SROW_
#undef FCIN_
        if (it0 < ntl) {
            stage_tile_full(SKV, b * SEQ + 64 * TL[1 + it0], kvh, TB0, tid);
            wg_sync();
            for (int it = it0; it < ntl; ++it) {
                const int j = TL[1 + it];
                LAS unsigned char* cur = ((it - it0) & 1) ? TB1 : TB0; LAS unsigned char* nxt = ((it - it0) & 1) ? TB0 : TB1;
                if (it + 1 < ntl) stage_issue_off(SKV, b * SEQ + 64 * TL[2 + it], kvh, so, s1);
                const bool sel = (mysel >> j) & 1ull;
                if (j <= qb - 3) attn_tile_fixed<0>(cur, qf, sel ? bias_far - mq_s : -INFINITY, 0, 0, true, lut, mq_s, l_run, o0, o1, lane, loff);
                else attn_tile_fixed<1>(cur, qf, 0.f, t, 64 * j, sel, lut, mq_s, l_run, o0, o1, lane, loff);
                if (it + 1 < ntl) stage_commit_off(s1, nxt, so);
                wg_sync();
            }
        }
        const float lt = l_run + __shfl_xor(l_run, 32), sc = gate_s / lt;
#pragma unroll
        for (int i = 0; i < 16; ++i) { park[i * 512] += o0[i] * sc; park[(16 + i) * 512] += o1[i] * sc; }
    }
    m_run = NEG_BIG; l_run = 0.f;
#pragma unroll
    for (int i = 0; i < 16; ++i) { o0[i] = 0.f; o1[i] = 0.f; }
    {
        StageRegs s1;
        const StageOff so = stage_off(tid);
        const int j0 = qb >= 8 ? qb - 8 : 0, nw = qb - j0 + 1;
        stage_tile_full(WKV, b * SEQ + 64 * j0, kvh, TB0, tid);
        wg_sync();
        for (int it = 0; it < nw; ++it) {
            const int j = j0 + it;
            LAS unsigned char* cur = (it & 1) ? TB1 : TB0; LAS unsigned char* nxt = (it & 1) ? TB0 : TB1;
            if (it + 1 < nw) stage_issue_off(WKV, b * SEQ + 64 * (j + 1), kvh, so, s1);
            if (j >= qb - 7 && j <= qb - 3) attn_tile_fixed<0>(cur, qf, bias_far - mq_w, 0, 0, true, lut, mq_w, l_run, o0, o1, lane, loff);
            else attn_tile_fixed<2>(cur, qf, 0.f, t, 64 * j, true, lut, mq_w, l_run, o0, o1, lane, loff);
            if (it + 1 < nw) stage_commit_off(s1, nxt, so);
            wg_sync();
        }
        const float lt = l_run + __shfl_xor(l_run, 32), sc = gate_w / lt;
#pragma unroll
        for (int i = 0; i < 16; ++i) { ot0[i] = park[i * 512] + o0[i] * sc; ot1[i] = park[(16 + i) * 512] + o1[i] * sc; }
    }
    __builtin_amdgcn_s_setprio(0);
    float ssq = 0.f;
#pragma unroll
    for (int i = 0; i < 16; ++i) ssq += ot0[i] * ot0[i] + ot1[i] * ot1[i];
    ssq += __shfl_xor(ssq, 32);
    if (h2 == 0) SSQA[(size_t)m * 16 + hh] = ssq;
    bf16* op = MIX + (size_t)m * DMIX + hh * 64 + 4 * h2;
#pragma unroll
    for (int gq = 0; gq < 4; ++gq) {
        *(u64*)(op + 8 * gq) = (u64)pk2(ot0[4 * gq], ot0[4 * gq + 1]) | ((u64)pk2(ot0[4 * gq + 2], ot0[4 * gq + 3]) << 32);
        *(u64*)(op + 32 + 8 * gq) = (u64)pk2(ot1[4 * gq], ot1[4 * gq + 1]) | ((u64)pk2(ot1[4 * gq + 2], ot1[4 * gq + 3]) << 32);
    }
    wg_sync();
}

constexpr int AS_TB = 0, AS_MOC = 4 * TILE_BYTES, AS_SIMP = AS_MOC + 16384, AS_MO = 65536, AS_LUT = 8 * TILE_BYTES, AS_SG = AS_LUT + 4 * LUT_STRIDE * 4, AS_SEL = AS_SG + 32 * 4 * 4, AS_TL = AS_SEL + 8 * 16,
              AS_OT = AS_TL + 132 * 4, AS_ML = AS_OT + 32 * 64 * 4, AS_PT = AS_ML + 8 * 32 * 8, AS_END = AS_PT + 64 * 4;
static_assert(AS_END <= MISC_OFF && AS_SIMP + 32 * 128 * 4 <= AS_LUT && AS_MO + 65536 <= AS_LUT, "sample attention LDS map");
__device__ __forceinline__ void as_write_state(LAS unsigned char* lds, int mo_off, int wave, int lane, float m_run, float l_run, const f32x16& o0, const f32x16& o1) {
    const int r32 = lane & 31, h2 = lane >> 5;
    const float lt = l_run + __shfl_xor(l_run, 32);
    LAS float* mo = (LAS float*)(lds + mo_off) + (wave * 32 + r32) * 64 + 4 * h2;
#pragma unroll
    for (int gq = 0; gq < 4; ++gq) {
        *(LAS f32x4*)(mo + 8 * gq) = (f32x4){o0[4 * gq], o0[4 * gq + 1], o0[4 * gq + 2], o0[4 * gq + 3]};
        *(LAS f32x4*)(mo + 32 + 8 * gq) = (f32x4){o1[4 * gq], o1[4 * gq + 1], o1[4 * gq + 2], o1[4 * gq + 3]};
    }
    if (h2 == 0) { LAS float* ml = (LAS float*)(lds + AS_ML) + (wave * 32 + r32) * 2; ml[0] = m_run; ml[1] = lt; }
}
template <int NW> __device__ __forceinline__ void as_merge(LAS unsigned char* lds, int mo_off, int br, int tid) {
    const int q = tid >> 4, d = (tid & 15) * 4;
    const LAS float* ml = (const LAS float*)(lds + AS_ML); const LAS float* mo = (const LAS float*)(lds + mo_off);
    float M = NEG_BIG;
#pragma unroll
    for (int w = 0; w < NW; ++w) M = fmaxf(M, ml[(w * 32 + q) * 2]);
    float L = 0.f; f32x4 acc = (f32x4){0.f, 0.f, 0.f, 0.f};
#pragma unroll
    for (int w = 0; w < NW; ++w) { const float f = fast_exp2(ml[(w * 32 + q) * 2] - M); L += ml[(w * 32 + q) * 2 + 1] * f; acc += *(const LAS f32x4*)(mo + (w * 32 + q) * 64 + d) * f; }
    const float sc = ((const LAS float*)(lds + AS_SG))[q * 4 + br] / L;
    LAS f32x4* ot = (LAS f32x4*)((LAS float*)(lds + AS_OT) + q * 64 + d);
    *ot = *ot + acc * sc;
}
__device__ __forceinline__ void attn_sample_unit(int b, int kvh, const bf16* QB, const float* QS32, const bf16* KCS, const float* KCS32, const bf16* SKV, const bf16* WKV, const float* cache_slc, const float* cache_win,
                                                 const int* page_table, const float* GATES, const float* rel_table, bf16* MIX, float* SSQA, const float* OUTP, LAS unsigned char* lds, int tid_, int wave, int lane_) {
    asm volatile("; MARK_attn_sample_unit_BEGIN" ::: "memory");
    int tid = tid_, lane = lane_; asm volatile("" : "+v"(tid), "+v"(lane));
    const int r32 = lane & 31, h2 = lane >> 5, g = r32 >> 3, t = r32 & 7, m = NPR + b * STOK + t, hh = kvh * 4 + g, qpos = PAST + t;
    LAS float* LUT = (LAS float*)(lds + AS_LUT); LAS float* SG = (LAS float*)(lds + AS_SG); LAS u64* SEL = (LAS u64*)(lds + AS_SEL); LAS int* TL = (LAS int*)(lds + AS_TL);
    LAS float* SIMP = (LAS float*)(lds + AS_SIMP);
    LAS int* pt = (LAS int*)(lds + AS_PT);
    if (tid < NPAGES) pt[tid] = page_table[b * NPAGES + tid];
    bf16x8 qf[4];
#pragma unroll
    for (int ks = 0; ks < 4; ++ks) qf[ks] = __builtin_bit_cast(bf16x8, *(const GAS v4u*)(QB + (size_t)m * DM + hh * 64 + 16 * ks + 8 * h2));
    for (int idx = tid; idx < 4 * 129; idx += NWAVES * 64) { const int gg = idx / 129, d = idx % 129; LUT[gg * LUT_STRIDE + d] = rel_table[BKT[d] * 16 + kvh * 4 + gg] * LOG2E; }
    if (tid < 96) { const int q = tid / 3, br = tid % 3; SG[q * 4 + br] = sigmoid_f(GATES[(size_t)(NPR + b * STOK + (q & 7)) * 48 + (kvh * 4 + (q >> 3)) * 3 + br]); }
    for (int idx = tid; idx < 32 * 64; idx += NWAVES * 64) ((LAS float*)(lds + AS_OT))[idx] = 0.f;
    const float bias_far = rel_table[31 * 16 + hh] * LOG2E;
    const LAS float* lut = LUT + g * LUT_STRIDE;
    f32x16 o0, o1, p0, p1; float m_run, l_run;
#define AS_RESET() do { m_run = NEG_BIG; l_run = 0.f; _Pragma("unroll") for (int i = 0; i < 16; ++i) { o0[i] = 0.f; o1[i] = 0.f; } } while (0)
    stage_tile_bf16(KCS, (long)b * 128, 64, kvh, lds + AS_TB, tid);
    stage_tile_bf16(KCS, (long)b * 128 + 64, 64, kvh, lds + AS_TB + TILE_BYTES, tid);
    wg_sync();
#if SPLIT_RANK
    stage_k_hilo(KCS32, (long)b * 128, kvh, lds + AS_TB, lds + AS_TB + 2 * TILE_BYTES, tid);
    stage_k_hilo(KCS32, (long)b * 128 + 64, kvh, lds + AS_TB + TILE_BYTES, lds + AS_TB + 3 * TILE_BYTES, tid);
    wg_sync();
#endif
    AS_RESET();
    if (wave < 2) {
#if SPLIT_RANK
        bf16x8 qh[4], ql[4];
#pragma unroll
        for (int ks = 0; ks < 4; ++ks) { const GAS f32x4* qp = (const GAS f32x4*)(QS32 + (size_t)(b * STOK + t) * DM + hh * 64 + 16 * ks + 8 * h2);
            v4u h_, l_; split8(qp[0], qp[1], h_, l_); qh[ks] = __builtin_bit_cast(bf16x8, h_); ql[ks] = __builtin_bit_cast(bf16x8, l_); }
        attn_tile<3, true>(lds + AS_TB + wave * TILE_BYTES, qh, 0.f, qpos, 64 * 64 * wave + 63, true, lut, m_run, l_run, o0, o1, p0, p1, lane, lds + AS_TB + (2 + wave) * TILE_BYTES, ql);
#else
        attn_tile<3>(lds + AS_TB + wave * TILE_BYTES, qf, 0.f, qpos, 64 * 64 * wave + 63, true, lut, m_run, l_run, o0, o1, p0, p1, lane);
#endif
        LAS float* sp = SIMP + r32 * 128 + 64 * wave;
#pragma unroll
        for (int i = 0; i < 16; ++i) { sp[crow(i, h2)] = p0[i]; sp[32 + crow(i, h2)] = p1[i]; }
    }
    if (wave < 2) as_write_state(lds, AS_MOC, wave, lane, m_run, l_run, o0, o1);
    wg_sync();
    as_merge<2>(lds, AS_MOC, 0, tid);
    {
        const int tk = wave;
        const LAS float* ml = (const LAS float*)(lds + AS_ML);
        float v0 = 0.f, v1 = 0.f;
#pragma unroll
        for (int gg = 0; gg < 4; ++gg) { const int q = gg * 8 + tk;
            const float m0 = ml[(0 * 32 + q) * 2], l0 = ml[(0 * 32 + q) * 2 + 1], m1 = ml[(1 * 32 + q) * 2], l1 = ml[(1 * 32 + q) * 2 + 1];
            const float M = fmaxf(m0, m1), f0 = fast_exp2(m0 - M), f1 = fast_exp2(m1 - M), inv = 1.0f / (l0 * f0 + l1 * f1);
            v0 += SIMP[q * 128 + lane] * (f0 * inv); v1 += SIMP[q * 128 + 64 + lane] * (f1 * inv); }
        const bool c0 = lane >= 1, c1 = lane <= 62;
#ifdef PROBE_COARSE
        v0 = __uint_as_float(f2bf(v0) << 16); v1 = __uint_as_float(f2bf(v1) << 16);
#endif
        if (!c0) v0 = -1.f; if (!c1) v1 = -1.f;
        int rk0 = 0, rk1 = 0;
#pragma unroll
        for (int jj = 0; jj < 64; ++jj) {
            const float a = __builtin_bit_cast(float, __builtin_amdgcn_readlane(__builtin_bit_cast(int, v0), jj)), bb = __builtin_bit_cast(float, __builtin_amdgcn_readlane(__builtin_bit_cast(int, v1), jj));
            rk0 += (a > v0 || (a == v0 && jj < lane)) ? 1 : 0; rk0 += (bb > v0) ? 1 : 0;
            rk1 += (a > v1 || a == v1) ? 1 : 0; rk1 += (bb > v1 || (bb == v1 && jj < lane)) ? 1 : 0;
        }
        const bool s0 = (lane == 0) || (c0 && rk0 < 13), s1 = (lane == 63) || (c1 && rk1 < 13);
        const u64 mk0 = __ballot(s0), mk1 = __ballot(s1);
        if (lane == 0) { SEL[tk * 2] = mk0; SEL[tk * 2 + 1] = mk1; }
    }
    wg_sync();
    if (tid == 0) { u64 a0 = 0ull, a1 = 0ull; for (int i = 0; i < 8; ++i) { a0 |= SEL[2 * i]; a1 |= SEL[2 * i + 1]; }
        int n = 0; for (int j = 0; j < 64; ++j) if ((a0 >> j) & 1ull) TL[1 + n++] = j; for (int j = 0; j < 64; ++j) if ((a1 >> j) & 1ull) TL[1 + n++] = 64 + j; TL[1 + n++] = 128; TL[0] = n; }
    wg_sync();
#ifdef SAMPLE_BRUTE
    {
        const int q = tid >> 4, part = tid & 15, gq = q >> 3, tq = q & 7, hq = kvh * 4 + gq, qp = PAST + tq;
        float qv[64];
#pragma unroll
        for (int d = 0; d < 64; ++d) qv[d] = QS32[(size_t)(b * STOK + tq) * DM + hq * 64 + d];
        for (int br = 1; br <= 2; ++br) {
            float mrun = NEG_BIG, lrun = 0.f, ov[64];
#pragma unroll
            for (int d = 0; d < 64; ++d) ov[d] = 0.f;
            int nkeys, jblk = -1;
            if (br == 1) { const u64 a0 = SEL[tq * 2], a1 = SEL[tq * 2 + 1]; int cnt = 0; jblk = 128;
                for (int j = 0; j < 128; ++j) { const bool on = j < 64 ? ((a0 >> j) & 1ull) : ((a1 >> (j - 64)) & 1ull); if (on) { if (cnt == part) jblk = j; ++cnt; } }
                nkeys = 64; }
            else nkeys = 33;
            for (int kk = 0; kk < nkeys; ++kk) {
                int kpos; const float* krow;
                if (br == 1) { kpos = 64 * jblk + kk;
                    if (jblk < 128) krow = cache_slc + (((size_t)pt[jblk >> 1] * 128 + (jblk & 1) * 64 + kk) * 4 + kvh) * 128;
                    else krow = (kk < STOK) ? OUTP + O_SSLC + ((size_t)(b * STOK + kk) * 4 + kvh) * 128 : nullptr; }
                else { const int widx = part + 16 * kk; if (widx >= 520) continue; kpos = PAST - 512 + widx;
                    krow = widx < 512 ? cache_win + (((size_t)b * 512 + widx) * 4 + kvh) * 128 : OUTP + O_SWIN + (((size_t)b * 512 + 504 + (widx - 512)) * 4 + kvh) * 128; }
                const int dist = qp - kpos;
                const bool ok = krow != nullptr && dist >= 0 && (br == 1 || dist < 512);
                if (!ok) continue;
                float sdot = 0.f;
#pragma unroll
                for (int d = 0; d < 64; ++d) sdot += qv[d] * krow[d];
                sdot += rel_table[BKT[min(dist, 128)] * 16 + hq] * LOG2E;
                const float mn = fmaxf(mrun, sdot), al = fast_exp2(mrun - mn), pp = fast_exp2(sdot - mn);
                mrun = mn; lrun = lrun * al + pp;
#pragma unroll
                for (int d = 0; d < 64; ++d) ov[d] = ov[d] * al + pp * krow[64 + d];
            }
            float M = mrun;
#pragma unroll
            for (int o = 1; o < 16; o <<= 1) M = fmaxf(M, __shfl_xor(M, o));
            const float f = fast_exp2(mrun - M);
            float L = lrun * f;
#pragma unroll
            for (int o = 1; o < 16; o <<= 1) L += __shfl_xor(L, o);
            const float sc = SG[q * 4 + br] / L;
#pragma unroll
            for (int d = 0; d < 64; ++d) { float v = ov[d] * f;
#pragma unroll
                for (int o = 1; o < 16; o <<= 1) v += __shfl_xor(v, o);
                if (part == (d & 15)) ((LAS float*)(lds + AS_OT))[q * 64 + d] += v * sc; }
        }
    }
    wg_sync();
#else
    {
        const int ntl = TL[0];
        const u64 ms0 = SEL[t * 2], ms1 = SEL[t * 2 + 1];
        AS_RESET();
        const int nh = (ntl + 3) >> 2;
        StageRegsF rf[4];
        const StageOffF sof = stage_off_f32(tid);
#define SEL_ISSUE(h_) do { _Pragma("unroll") for (int s4 = 0; s4 < 4; ++s4) { const int idx = 4 * (h_) + s4; if (idx < ntl) { const int j = TL[1 + idx]; \
            if (j < 128) stage_f32_issue_off(cache_slc, pt[j >> 1] * 128 + (j & 1) * 64, kvh, sof, rf[s4]); \
            else stage_tile_bf16(SKV, (long)NPR + b * STOK, STOK, kvh, lds + AS_TB + ((((h_) & 1) << 2) + s4) * TILE_BYTES, tid); } } } while (0)
#define SEL_COMMIT(h_) do { _Pragma("unroll") for (int s4 = 0; s4 < 4; ++s4) { const int idx = 4 * (h_) + s4; \
            if (idx < ntl && TL[1 + idx] < 128) stage_f32_commit_off(rf[s4], lds + AS_TB + ((((h_) & 1) << 2) + s4) * TILE_BYTES, sof); } } while (0)
        SEL_ISSUE(0); SEL_COMMIT(0);
        wg_sync();
        for (int h = 0; h < nh; ++h) {
            if (h + 1 < nh) SEL_ISSUE(h + 1);
            if ((wave >> 2) == (h & 1)) { const int idx = 4 * h + (wave & 3);
                if (idx < ntl) { const int j = TL[1 + idx];
                    const bool sel = j >= 128 ? true : (j < 64 ? ((ms0 >> j) & 1ull) : ((ms1 >> (j - 64)) & 1ull));
                    if (j <= 125) attn_tile<0>(lds + AS_TB + wave * TILE_BYTES, qf, sel ? bias_far : -INFINITY, 0, 0, true, lut, m_run, l_run, o0, o1, p0, p1, lane);
                    else attn_tile<1>(lds + AS_TB + wave * TILE_BYTES, qf, 0.f, qpos, 64 * j, sel, lut, m_run, l_run, o0, o1, p0, p1, lane); } }
            if (h + 1 < nh) SEL_COMMIT(h + 1);
            wg_sync();
        }
#undef SEL_ISSUE
#undef SEL_COMMIT
        as_write_state(lds, AS_MO, wave, lane, m_run, l_run, o0, o1);
        wg_sync();
        as_merge<8>(lds, AS_MO, 1, tid);
        wg_sync();
    }
    {
#ifdef PROBE_DELAY
        for (int dly = 0; dly < 4000; ++dly) __builtin_amdgcn_s_sleep(127);
#endif
        AS_RESET();
        StageRegsF rf[4];
        const StageOffF sof = stage_off_f32(tid);
#define WIN_ISSUE(h_) do { _Pragma("unroll") for (int s4 = 0; s4 < 4; ++s4) { const int wt = 4 * (h_) + s4; if (wt < 9) { \
            if (wt < 8) stage_f32_issue_off(cache_win, b * 512 + 64 * wt, kvh, sof, rf[s4]); \
            else stage_tile_bf16(WKV, (long)NPR + b * STOK, STOK, kvh, lds + AS_TB + ((((h_) & 1) << 2) + s4) * TILE_BYTES, tid); } } } while (0)
#define WIN_COMMIT(h_) do { _Pragma("unroll") for (int s4 = 0; s4 < 4; ++s4) { const int wt = 4 * (h_) + s4; \
            if (wt < 8) stage_f32_commit_off(rf[s4], lds + AS_TB + ((((h_) & 1) << 2) + s4) * TILE_BYTES, sof); } } while (0)
        WIN_ISSUE(0); WIN_COMMIT(0);
        wg_sync();
        for (int h = 0; h < 3; ++h) {
            if (h + 1 < 3) WIN_ISSUE(h + 1);
            if ((wave >> 2) == (h & 1)) { const int wt = 4 * h + (wave & 3);
                if (wt < 9) attn_tile<2>(lds + AS_TB + wave * TILE_BYTES, qf, 0.f, qpos, PAST - 512 + 64 * wt, true, lut, m_run, l_run, o0, o1, p0, p1, lane); }
            if (h + 1 < 3) WIN_COMMIT(h + 1);
            wg_sync();
        }
#undef WIN_ISSUE
#undef WIN_COMMIT
        as_write_state(lds, AS_MO, wave, lane, m_run, l_run, o0, o1);
        wg_sync();
        as_merge<8>(lds, AS_MO, 2, tid);
        wg_sync();
    }
#endif
    {
        const int q = tid >> 4, d = (tid & 15) * 4, gq = q >> 3, tq = q & 7, mq = NPR + b * STOK + tq, hq = kvh * 4 + gq;
        const f32x4 v = *(const LAS f32x4*)((const LAS float*)(lds + AS_OT) + q * 64 + d);
        float ssq = (v.x * v.x + v.y * v.y) + (v.z * v.z + v.w * v.w);
        ssq += __shfl_xor(ssq, 1); ssq += __shfl_xor(ssq, 2); ssq += __shfl_xor(ssq, 4); ssq += __shfl_xor(ssq, 8);
        *(u64*)(MIX + (size_t)mq * DMIX + hq * 64 + d) = (u64)pk2(v.x, v.y) | ((u64)pk2(v.z, v.w) << 32);
        if ((tid & 15) == 0) SSQA[(size_t)mq * 16 + hq] = ssq;
    }
    wg_sync();
#undef AS_RESET
}

__device__ __forceinline__ void sample_q_unit(int unit, const float* X1, const float* mix_pre, const float* w_in, float* QS32, LAS unsigned char* lds, int tid, int wave, int lane) {
    const int r0 = (unit >> 4) * 16, c0 = (unit & 15) * 64;
    LAS float* xs = (LAS float*)lds;
    for (int rr = 2 * wave; rr < 2 * wave + 2; ++rr) {
        const GAS f32x4* xr = (const GAS f32x4*)(X1 + (size_t)(NPR + r0 + rr) * DM) + lane; const GAS f32x4* gr = (const GAS f32x4*)mix_pre + lane;
        f32x4 v[4]; float ss = 0.f;
#pragma unroll
        for (int j = 0; j < 4; ++j) { v[j] = xr[64 * j]; ss += (v[j].x * v[j].x + v[j].y * v[j].y) + (v[j].z * v[j].z + v[j].w * v[j].w); }
        const float rs = 1.0f / sqrtf(wave_sum(ss) * (1.f / DM) + EPS);
#pragma unroll
        for (int j = 0; j < 4; ++j) { const f32x4 gg = gr[64 * j]; *(LAS f32x4*)(xs + rr * 1024 + 4 * lane + 256 * j) = (f32x4){v[j].x * rs * gg.x, v[j].y * rs * gg.y, v[j].z * rs * gg.z, v[j].w * rs * gg.w}; }
    }
    wg_sync();
    {
        const int kq = tid >> 5, cp = tid & 31, c = c0 + 2 * cp;
        float acc[16][2];
#pragma unroll
        for (int r = 0; r < 16; ++r) { acc[r][0] = 0.f; acc[r][1] = 0.f; }
        const float* wp = w_in + (size_t)(64 * kq) * DIN + c;
#pragma unroll 4
        for (int k8 = 0; k8 < 8; ++k8) {
            float2 w[8];
#pragma unroll
            for (int i = 0; i < 8; ++i) w[i] = *(const float2*)(wp + (size_t)(8 * k8 + i) * DIN);
#pragma unroll
            for (int r = 0; r < 16; ++r) {
                const f32x4 xa = *(const LAS f32x4*)(xs + r * 1024 + 64 * kq + 8 * k8), xb = *(const LAS f32x4*)(xs + r * 1024 + 64 * kq + 8 * k8 + 4);
                acc[r][0] += xa.x * w[0].x + xa.y * w[1].x + xa.z * w[2].x + xa.w * w[3].x + xb.x * w[4].x + xb.y * w[5].x + xb.z * w[6].x + xb.w * w[7].x;
                acc[r][1] += xa.x * w[0].y + xa.y * w[1].y + xa.z * w[2].y + xa.w * w[3].y + xb.x * w[4].y + xb.y * w[5].y + xb.z * w[6].y + xb.w * w[7].y;
            }
        }
        LAS float* red = (LAS float*)(lds + 65536);
#pragma unroll
        for (int r = 0; r < 16; ++r) { typedef float f32x2v __attribute__((ext_vector_type(2))); *(LAS f32x2v*)(red + (kq * 16 + r) * 64 + 2 * cp) = (f32x2v){acc[r][0], acc[r][1]}; }
        wg_sync();
        for (int idx = tid; idx < 1024; idx += NWAVES * 64) { const int r = idx >> 6, cc = idx & 63; float sum = 0.f;
#pragma unroll
            for (int q = 0; q < 16; ++q) sum += red[(q * 16 + r) * 64 + cc];
            QS32[(size_t)(r0 + r) * DM + c0 + cc] = sum * C2; }
    }
    wg_sync();
}

constexpr int REP_0 = 1, REP_3 = 1, REP_13 = 1, REP_1 = 1, REP_2 = 1, REP_4 = 1, REP_5A = 1, REP_5B = 1, REP_6 = 1, REP_7A = 1, REP_7B = 1, REP_7C = 1, REP_9 = 1, REP_11 = 1, REP_12 = 1;
struct Args { const float* in[30]; float* out; unsigned char* ws; int ph_lo, ph_hi; };
constexpr int N_PHASES = 14;

#define x_prompt (args.in[0])
#define x_sample (args.in[1])
#define cache_cmp (args.in[2])
#define cache_slc (args.in[3])
#define cache_win (args.in[4])
#define state_ssm (args.in[5])
#define state_conv (args.in[6])
#define page_table ((const int*)args.in[7])
#define rel_table (args.in[8])
#define ffn1_pre (args.in[9])
#define ffn1_post (args.in[10])
#define ffn1_w_in (args.in[11])
#define ffn1_w_out (args.in[12])
#define mix_pre (args.in[13])
#define mix_post (args.in[14])
#define w_in (args.in[15])
#define w_out (args.in[16])
#define att_out_norm (args.in[17])
#define cmp_pe (args.in[18])
#define w_cmp (args.in[19])
#define conv_w (args.in[20])
#define conv_b (args.in[21])
#define dt_bias (args.in[22])
#define a_log (args.in[23])
#define d_skip (args.in[24])
#define ssd_norm (args.in[25])
#define ffn2_pre (args.in[26])
#define ffn2_post (args.in[27])
#define ffn2_w_in (args.in[28])
#define ffn2_w_out (args.in[29])
#define W1A ((bf16*)(args.ws + WS_W1A))
#define W1B ((bf16*)(args.ws + WS_W1B))
#define WIN ((bf16*)(args.ws + WS_WIN))
#define WOUT ((bf16*)(args.ws + WS_WOUT))
#define W2A ((bf16*)(args.ws + WS_W2A))
#define W2B ((bf16*)(args.ws + WS_W2B))
#define WCF ((bf16*)(args.ws + WS_WCF))
#define PEB ((float*)(args.ws + WS_PEB))
#define WCFL ((bf16*)(args.ws + WS_WCFL))
#define QS32 ((float*)(args.ws + WS_QS32))
#define KCS32 ((float*)(args.ws + WS_KCS32))
#define GATES ((float*)(args.ws + WS_GATES))
#define DTR ((float*)(args.ws + WS_DT))
#define SSQA ((float*)(args.ws + WS_SSQA))
#define SSQY ((float*)(args.ws + WS_SSQY))
#define DC ((float*)(args.ws + WS_DC))
#define KCP ((bf16*)(args.ws + WS_KCP))
#define KCS ((bf16*)(args.ws + WS_KCS))
#define XN ((bf16*)(args.ws + WS_XN))
#define QB ((bf16*)(args.ws + WS_Q))
#define CKV ((bf16*)(args.ws + WS_CKV))
#define SKV ((bf16*)(args.ws + WS_SKV))
#define WKV ((bf16*)(args.ws + WS_WKV))
#define ZB ((bf16*)(args.ws + WS_Z))
#define XBC ((bf16*)(args.ws + WS_XBC))
#define ACT ((bf16*)(args.ws + WS_ACT))
#define O32 ((float*)(args.ws + WS_O32))
#define X1 ((float*)(args.ws + WS_X1))
#define MIX ((bf16*)(args.ws + WS_MIX))
#define STB ((bf16*)(args.ws + WS_ST))
#define PART ((float*)(args.ws + WS_PART))
#define KMP ((float*)(args.ws + WS_KMP))
#define XCV (args.ws + WS_XCV)
#define BCV (args.ws + WS_BCV)
#define CCV (args.ws + WS_CCV)
#define SCV ((float*)(args.ws + WS_SCV))
__global__ void __launch_bounds__(NWAVES * 64, 2) mk_fwd(Args args) {
    extern __shared__ __attribute__((aligned(16))) unsigned char lds_raw[];
    LAS unsigned char* lds = (LAS unsigned char*)lds_raw;
    volatile LAS unsigned* MISC = (volatile LAS unsigned*)(lds + MISC_OFF);
    const int tid = threadIdx.x, lane = tid & 63, wave = __builtin_amdgcn_readfirstlane(tid >> 6);
    const int G = gridDim.x, bx = blockIdx.x;
    const int vcu = (G % 8 == 0) ? (bx % 8) * (G / 8) + bx / 8 : bx;
    const int gw = vcu * NWAVES + wave, NGW = G * NWAVES;
    unsigned char* ws = args.ws;
    gu32* ctl = (gu32*)(ws + WS_CTL);
    float* out = args.out;
    for (int u = tid; u < 64; u += NWAVES * 64) ((LAS unsigned*)(lds + MISC_OFF))[u] = 0u;
    __syncthreads();
    XcdBarrier bar = xcd_barrier_post((unsigned*)(ctl + CW_BAR), MISC + 8);
    const int lo = args.ph_lo, hi = args.ph_hi;
#define IN(k) (lo <= (k) && (k) < hi)
#define SEAM(k) do { if (IN(k) && IN((k) + 1)) xcd_barrier(bar); } while (0)

    if (IN(0)) {
    _Pragma("unroll 1") for (int rep0_ = 0; rep0_ < REP_0; ++rep0_) {
        int ln = lane; asm volatile("" : "+v"(ln));
        LAS float* scr = (LAS float*)(lds + wave * 16896);
        constexpr int I_A = 16 * (2 * DFF / 64), I_B = (DFF / 64) * (DM / 64), I_IN = 16 * (DINP / 64), I_OUT = (DMIX / 64) * (DM / 64);
        constexpr int NITEMS = I_A + I_B + I_IN + I_OUT;
        for (int it = gw; it < NITEMS; it += NGW) {
            int r = it;
            if (r < I_A) { transpose_item64<0>(ffn1_w_in, DM, 2 * DFF, W1A, nullptr, nullptr, scr, r, 2 * DFF / 64, ln); continue; } r -= I_A;
            if (r < I_B) { transpose_item64<1>(ffn1_w_out, DFF, DM, W1B, nullptr, nullptr, scr, r, DM / 64, ln); continue; } r -= I_B;
            if (r < I_IN) { transpose_item64<2>(w_in, DM, DIN, WIN, nullptr, nullptr, scr, r, DINP / 64, ln); continue; } r -= I_IN;
            transpose_item64<3>(w_out, DMIX, DM, WOUT, att_out_norm, ssd_norm, scr, r, DM / 64, ln);
        }
        for (int m = gw; m < NPR; m += 4 * NGW) {
            const int m1 = m + NGW < NPR ? m + NGW : m, m2 = m + 2 * NGW < NPR ? m + 2 * NGW : m, m3 = m + 3 * NGW < NPR ? m + 3 * NGW : m;
            rms_rows4_to_bf16(x_prompt + (size_t)m * DM, x_prompt + (size_t)m1 * DM, x_prompt + (size_t)m2 * DM, x_prompt + (size_t)m3 * DM, ffn1_pre,
                              XN + (size_t)m * DM, XN + (size_t)m1 * DM, XN + (size_t)m2 * DM, XN + (size_t)m3 * DM, ln);
        }
        for (int m = NPR + gw; m < MT; m += NGW) rms_row_to_bf16(x_sample + (size_t)(m - NPR) * DM, ffn1_pre, XN + (size_t)m * DM, ln);
#if 0
        for (int r = gw; r < SBAT * 504; r += NGW) {
            const int b = r / 504, j = r % 504;
            const GAS f32x4* s = (const GAS f32x4*)(cache_win + ((size_t)b * 512 + j + 8) * KVW) + ln;
            GAS f32x4* d = (GAS f32x4*)(out + O_SWIN + ((size_t)b * 512 + j) * KVW) + ln;
            d[0] = s[0]; d[64] = s[64];
        }
#endif
        for (int f = bx * (NWAVES * 64) + tid; f < 2 * 256 * 2 * 64; f += G * NWAVES * 64) {
            const int ln = f & 63, et = (f >> 6) & 1, ks = (f >> 7) & 255, c = f >> 15;
            const int l = ks >> 2, d0 = 32 * ((ks & 3) >> 1) + 16 * (ln >> 5) + 8 * (ks & 1), e = 32 * et + (ln & 31);
            const float* src = w_cmp + (((size_t)l * 2 + c) * 64 + d0) * 64 + e;
            v4u o; o.x = pk2(src[0], src[64]); o.y = pk2(src[128], src[192]); o.z = pk2(src[256], src[320]); o.w = pk2(src[384], src[448]);
            *(GAS v4u*)(WCF + (size_t)f * 8) = o;
            if (SPLIT_RANK && c == 0) {
                unsigned lw[8];
#pragma unroll
                for (int j = 0; j < 8; ++j) { const float x = src[64 * j]; lw[j] = f2bf(x - __uint_as_float(f2bf(x) << 16)); }
                v4u ol; ol.x = lw[0] | (lw[1] << 16); ol.y = lw[2] | (lw[3] << 16); ol.z = lw[4] | (lw[5] << 16); ol.w = lw[6] | (lw[7] << 16);
                *(GAS v4u*)(WCFL + (size_t)f * 8) = ol;
            }
        }
        if (bx < 16) {
            LAS float* red = (LAS float*)(lds + 140032);
            const int sub = tid >> 7, ce = tid & 127, c = ce >> 6, e = ce & 63, l = 4 * bx + sub;
            float s0 = 0.f, s1 = 0.f;
#pragma unroll 8
            for (int d = 0; d < 64; d += 2) { s0 += cmp_pe[(l * 2 + c) * 64 + d] * w_cmp[(((size_t)l * 2 + c) * 64 + d) * 64 + e]; s1 += cmp_pe[(l * 2 + c) * 64 + d + 1] * w_cmp[(((size_t)l * 2 + c) * 64 + d + 1) * 64 + e]; }
            red[tid] = s0 + s1;
            __syncthreads();
            if (tid < 128) PEB[bx * 128 + tid] = (red[tid] + red[tid + 128]) + (red[tid + 256] + red[tid + 384]);
        }
    }}
    SEAM(0);

    if (IN(1)) {
    _Pragma("unroll") for (int rep_ = 0; rep_ < REP_1; ++rep_) {
        pg8::Gemm g{XN, W1A, MT, 2 * DFF, DM}; pg8::StaticOrder S; S.init(MT, 2 * DFF, G, bx, DM);
        EpiSwiglu E{ACT};
        if (G == 256 && bx >= (65 * 22) % 256 && (bx & 1)) { const int hu = bx - (65 * 22) % 256, b = hu >> 4, b0 = (hu & 15) * 8;
            compress_sample_unit<false>(cache_cmp, page_table + b * NPAGES, b0, WCF, PEB, KCS + ((size_t)b * 128 + b0) * KVW, lds, tid, wave, lane); }
        pg8::gemm_phase<EpiSwiglu, pg8::StaticOrder, true, true>(lds, g, S, E);
        if (G == 256 && bx >= (65 * 22) % 256 && !(bx & 1)) { const int hu = bx - (65 * 22) % 256, b = hu >> 4, b0 = (hu & 15) * 8;
            compress_sample_unit<false>(cache_cmp, page_table + b * NPAGES, b0, WCF, PEB, KCS + ((size_t)b * 128 + b0) * KVW, lds, tid, wave, lane); }
    }}
    SEAM(1);
    if (IN(2)) {
    _Pragma("unroll") for (int rep_ = 0; rep_ < REP_2; ++rep_) {
        pg8::Gemm g{ACT, W1B, MT, DM, DFF}; MixedOrder S; S.S.init(NPR, DM, G, bx, DFF); S.nks = DFF / 256; EpiF32Mixed E{(bf16*)O32, PART};
        pg8::gemm_phase<EpiF32Mixed, MixedOrder, true, true>(lds, g, S, E);
        {
            int ln = lane; asm volatile("" : "+v"(ln));
            LAS float* scr = (LAS float*)(lds + wave * 16896);
            const int first = (G == 256) ? 4 * (DFF / 256) : 0;
            if (bx >= first) for (int it = (bx - first) * NWAVES + wave; it < 16 * (2 * DFF / 64); it += (G - first) * NWAVES)
                transpose_item64<0>(ffn2_w_in, DM, 2 * DFF, W2A, nullptr, nullptr, scr, it, 2 * DFF / 64, ln);
        }
    }}
    SEAM(2);
    if (IN(3)) {
    _Pragma("unroll 1") for (int rep3_ = 0; rep3_ < REP_3; ++rep3_) {
        int ln = lane; asm volatile("" : "+v"(ln));
        for (int m = gw; m < NPR; m += 2 * NGW) {
            RowRegs ra, rb; const int m2 = (m + NGW < NPR) ? m + NGW : m;
            row_load<true, true>(ra, x_prompt + (size_t)m * DM, (const bf16*)O32 + (size_t)m * DM, ln); row_load<true, true>(rb, x_prompt + (size_t)m2 * DM, (const bf16*)O32 + (size_t)m2 * DM, ln);
            row_finish(ra, ffn1_post, 0.5f, X1 + (size_t)m * DM, mix_pre, XN + (size_t)m * DM, ln);
            row_finish(rb, ffn1_post, 0.5f, X1 + (size_t)m2 * DM, mix_pre, XN + (size_t)m2 * DM, ln);
        }
        for (int m = NPR + gw; m < MT; m += NGW)
            row_post<false>(x_sample + (size_t)(m - NPR) * DM, PART + (size_t)(m - NPR) * DM, DFF / 256, (size_t)NSA * DM, ffn1_post, 0.5f, X1 + (size_t)m * DM, mix_pre, XN + (size_t)m * DM, ln);
    }}
    SEAM(3);
    if (IN(4)) {
    _Pragma("unroll") for (int rep_ = 0; rep_ < REP_4; ++rep_) {
        pg8::Gemm g{XN, WIN, MT, DINP, DM}; pg8::StaticOrder S; S.init(MT, DINP, G, bx, DM);
        EpiInProj E{QB, CKV, ZB, XBC, GATES, DTR, out};
        if (G == 256 && bx >= (65 * 21) % 256 && (bx & 1)) { const int hu = 106 + bx - (65 * 21) % 256, b = hu >> 4, b0 = (hu & 15) * 8;
            compress_sample_unit<false>(cache_cmp, page_table + b * NPAGES, b0, WCF, PEB, KCS + ((size_t)b * 128 + b0) * KVW, lds, tid, wave, lane); }
        pg8::gemm_phase<EpiInProj, pg8::StaticOrder, true, true>(lds, g, S, E);
        if (G == 256 && bx >= (65 * 21) % 256 && !(bx & 1)) { const int hu = 106 + bx - (65 * 21) % 256, b = hu >> 4, b0 = (hu & 15) * 8;
            compress_sample_unit<false>(cache_cmp, page_table + b * NPAGES, b0, WCF, PEB, KCS + ((size_t)b * 128 + b0) * KVW, lds, tid, wave, lane); }
    }}
    SEAM(4);

    if (IN(5)) {
    {
        if (SPLIT_RANK) for (int u = vcu; u < 256; u += G) sample_q_unit(u, X1, mix_pre, w_in, QS32, lds, tid, wave, lane);
        for (int e = vcu * (NWAVES * 64) + tid; e < 2 * NPR * 4; e += G * NWAVES * 64) {
            const int br = e >= NPR * 4, r = (e - br * NPR * 4) >> 2, kv = e & 3;
            const GAS v4u* kp = (const GAS v4u*)((br ? WKV : SKV) + (size_t)r * KVW + kv * 128);
            float ss = 0.f;
#pragma unroll
            for (int q = 0; q < 8; ++q) { const v4u w = kp[q];
                const float a0 = __uint_as_float(w.x << 16), a1 = __uint_as_float(w.x & 0xffff0000u), a2 = __uint_as_float(w.y << 16), a3 = __uint_as_float(w.y & 0xffff0000u);
                const float a4 = __uint_as_float(w.z << 16), a5 = __uint_as_float(w.z & 0xffff0000u), a6 = __uint_as_float(w.w << 16), a7 = __uint_as_float(w.w & 0xffff0000u);
                ss += (a0 * a0 + a1 * a1) + (a2 * a2 + a3 * a3) + (a4 * a4 + a5 * a5) + (a6 * a6 + a7 * a7); }
#pragma unroll
            for (int o = 4; o < 64; o <<= 1) ss = fmaxf(ss, __shfl_xor(ss, o));
            if (lane < 4) KMP[((size_t)br * (NPR / 16) + (r >> 4)) * 4 + kv] = ss;
        }
        _Pragma("unroll 1") for (int pass = 0; pass < 2; ++pass) {
        if (((pass ^ vcu) & 1) == 0) {
        _Pragma("unroll 1") for (int rep_ = 0; rep_ < REP_5A; ++rep_)
        for (int hu = (G == 256 ? 277 : 0) + vcu; hu < SBAT * 16; hu += G) { const int b = hu >> 4, b0 = (hu & 15) * 8;
            compress_sample_unit<false>(cache_cmp, page_table + b * NPAGES, b0, WCF, PEB, KCS + ((size_t)b * 128 + b0) * KVW, lds, tid, wave, lane); }
        _Pragma("unroll 1") for (int rep_ = 0; rep_ < REP_5A; ++rep_) {
            const int p0 = (G == 256) ? (vcu >= 235 ? vcu - 235 : NB * 8) : vcu, pst = (G == 256) ? 21 : G;
            for (int u = p0; u < NB * 8; u += pst) { const int b = u >> 3, b0 = (u & 7) * 8;
                compress_sample_unit<true>(CKV + (size_t)b * SEQ * KVW, nullptr, b0, WCF, PEB, KCP + ((size_t)b * 64 + b0) * KVW, lds, tid, wave, lane); }
        }
        } else {
        _Pragma("unroll 1") for (int rep_ = 0; rep_ < REP_5B; ++rep_)
            for (int gi = vcu; gi < NB * 32 * 2; gi += G) ssd_a_item<8>(8 * gi, XBC, DTR, dt_bias, a_log, conv_w, conv_b, STB, DC, XCV, BCV, CCV, SCV, lds, tid, wave, lane);
        }
        }
    }}
    SEAM(5);
    if (IN(6)) {
        ssd_scan(STB, DC, out + O_PSSM, vcu * (NWAVES * 64) + tid, G * NWAVES * 64);
        asm volatile("s_waitcnt vmcnt(0)" ::: "memory"); __syncthreads();
        if (tid == 0) { __builtin_amdgcn_fence(__ATOMIC_RELEASE, "agent"); asm volatile("s_waitcnt vmcnt(0)" ::: "memory"); (void)xb_add((unsigned*)(ctl + CW_SCAN), 1u); }
        _Pragma("unroll 1") for (int rep_ = 0; rep_ < REP_6; ++rep_) {
            const int npu = (1024 - vcu + G - 1) / G, nsu = IN(7) ? ((G == 256) ? ((vcu & 1) ? 0 : 1) : (SBAT * 4 - vcu + G - 1) / G) : 0;
            const int spos = (G == 256) ? ((vcu >> 1) & 3) : npu;
            bool fresh = true;
            for (int st = 0; st < npu + nsu; ++st) {
                if (st >= spos && st < spos + nsu) {
                    const int su = (G == 256) ? (vcu >> 1) : vcu + (st - spos) * G;
                    attn_sample_unit(su >> 2, su & 3, QB, QS32, KCS, KCS32, SKV, WKV, cache_slc, cache_win, page_table, GATES, rel_table, MIX, SSQA, out, lds, tid, wave, lane);
                    fresh = true;
                } else {
                    const int u = vcu + (st < spos ? st : st - nsu) * G;
                    const int slot = u >> 8, w = u & 255, bk = w >> 4, jj = w & 15;
                    const int ih = jj >> 1, od = jj & 1;
                    const int qb = (G != 256) ? (slot == 0 ? jj : (slot == 1 ? 31 - jj : (slot == 2 ? 32 + jj : 63 - jj)))
                                 : (slot == 0 ? jj : (slot == 1 ? 31 - jj : (slot == 2 ? 32 + 8 * od + ih : 55 + 8 * od - ih)));
                    attn_prompt_unit(fresh || G != 256, bk >> 2, bk & 3, qb, QB, KCP, SKV, WKV, GATES, rel_table, KMP, MIX, SSQA, lds, tid, wave, lane);
                    fresh = false;
                }
            }
        }
    }
    if (IN(6) != IN(7)) SEAM(6);
    if (IN(7)) {
    {
        const int c_lo = (G == 256) ? (vcu >> 1) * 8 : vcu, c_n = (G == 256) ? ((vcu & 1) ? 8 : 0) : (1024 - vcu + G - 1) / G, c_st = (G == 256) ? 1 : G;
        if (c_n > 0 && IN(6)) {
            if (tid == 0) { unsigned* bw_ = (unsigned*)(ctl + CW_BAR); XB_SPIN(xb_ld((unsigned*)(ctl + CW_SCAN)) < (unsigned)G, bw_);
                __builtin_amdgcn_fence(__ATOMIC_ACQUIRE, "agent"); asm volatile("s_waitcnt vmcnt(0)" ::: "memory"); }
            __syncthreads();
        }
        _Pragma("unroll 1") for (int rep_ = 0; rep_ < REP_7B; ++rep_) {
            if (c_st == 1) ssd_c_pair_run(c_lo, c_n, XCV, BCV, CCV, SCV, d_skip, STB, ZB, MIX, SSQY, lds, tid, wave, lane);
            else for (int k = 0, u = c_lo; k < c_n; ++k, u += c_st) ssd_c_pair_run(u, 1, XCV, BCV, CCV, SCV, d_skip, STB, ZB, MIX, SSQY, lds, tid, wave, lane);
        }
        _Pragma("unroll 1") for (int rep_ = 0; rep_ < REP_7C; ++rep_) {
            const int s0 = (G == 256) ? ((vcu & 1) ? vcu >> 1 : SBAT * 16) : vcu, sst = (G == 256) ? 128 : G;
            for (int u = s0; u < SBAT * 16; u += sst) ssd_sample_unit(u, XBC, DTR, dt_bias, a_log, conv_w, conv_b, d_skip, state_ssm, state_conv, ZB, MIX, SSQY, out + O_SSSM, lds, tid);
        }
    }}
    SEAM(7);
    if (IN(9)) {
    _Pragma("unroll") for (int rep_ = 0; rep_ < REP_9; ++rep_) {
        pg8::Gemm g{MIX, WOUT, MT, DM, DMIX}; MixedOrder S; S.S.init(NPR, DM, G, bx, DMIX); S.nks = DMIX / 256;
        {
            pg8::Unit u0, u1; const bool h0_ = S.next(0, u0), h1_ = S.next(1, u1);
            if (h0_) rs_fill((LAS float*)(lds + 131072), u0.pm, SSQA, SSQY, tid);
            if (h1_) rs_fill((LAS float*)(lds + 131072), u1.pm, SSQA, SSQY, tid);
            __syncthreads();
        }
        EpiOutProj E{(bf16*)O32, PART, (const LAS float*)(lds + 131072)};
        pg8::gemm_phase<EpiOutProj, MixedOrder, true, true>(lds, g, S, E);
        {
            int ln = lane; asm volatile("" : "+v"(ln));
            LAS float* scr = (LAS float*)(lds + wave * 16896);
            const int first = (G == 256) ? 4 * (DMIX / 256) : 0;
            if (bx >= first) for (int it = (bx - first) * NWAVES + wave; it < (DFF / 64) * (DM / 64); it += (G - first) * NWAVES)
                transpose_item64<1>(ffn2_w_out, DFF, DM, W2B, nullptr, nullptr, scr, it, DM / 64, ln);
        }
    }}
    SEAM(9);
    if (IN(10)) {
        int ln = lane; asm volatile("" : "+v"(ln));
        for (int m = gw; m < NPR; m += 2 * NGW) {
            RowRegs ra, rb; const int m2 = (m + NGW < NPR) ? m + NGW : m;
            row_load(ra, X1 + (size_t)m * DM, (const bf16*)O32 + (size_t)m * DM, ln); row_load(rb, X1 + (size_t)m2 * DM, (const bf16*)O32 + (size_t)m2 * DM, ln);
            row_finish(ra, mix_post, 1.0f, X1 + (size_t)m * DM, ffn2_pre, XN + (size_t)m * DM, ln, false);
            row_finish(rb, mix_post, 1.0f, X1 + (size_t)m2 * DM, ffn2_pre, XN + (size_t)m2 * DM, ln, false);
        }
        for (int m = NPR + gw; m < MT; m += NGW)
            row_post<false>(X1 + (size_t)m * DM, PART + (size_t)(m - NPR) * DM, DMIX / 256, (size_t)NSA * DM, mix_post, 1.0f, X1 + (size_t)m * DM, ffn2_pre, XN + (size_t)m * DM, ln);
    }
    SEAM(10);
    if (IN(11)) {
    _Pragma("unroll") for (int rep_ = 0; rep_ < REP_11; ++rep_) {
        pg8::Gemm g{XN, W2A, MT, 2 * DFF, DM}; pg8::StaticOrder S; S.init(MT, 2 * DFF, G, bx, DM);
        EpiSwiglu E{ACT};
        pg8::gemm_phase<EpiSwiglu, pg8::StaticOrder, true, true>(lds, g, S, E);
        {
            const int first = (G == 256) ? (65 * 22) % 256 : 0, nw_ = (G - first) * NWAVES, w0 = (bx - first) * NWAVES + wave;
            if (bx >= first) for (int r = w0; r < SBAT * 504; r += nw_) {
                const int b = r / 504, j = r % 504;
                const GAS f32x4* s_ = (const GAS f32x4*)(cache_win + ((size_t)b * 512 + j + 8) * KVW) + lane;
                GAS f32x4* d_ = (GAS f32x4*)(out + O_SWIN + ((size_t)b * 512 + j) * KVW) + lane;
                __builtin_nontemporal_store(s_[0], d_); __builtin_nontemporal_store(s_[64], d_ + 64);
            }
        }
    }}
    SEAM(11);
    if (IN(12)) {
    _Pragma("unroll") for (int rep_ = 0; rep_ < REP_12; ++rep_) {
        pg8::Gemm g{ACT, W2B, MT, DM, DFF}; MixedOrder S; S.S.init(NPR, DM, G, bx, DFF); S.nks = DFF / 256; EpiF32Mixed E{XN  , PART};
        pg8::gemm_phase<EpiF32Mixed, MixedOrder, true, true>(lds, g, S, E);
    }}
    SEAM(12);
    if (IN(13)) {
    _Pragma("unroll 1") for (int rep13_ = 0; rep13_ < REP_13; ++rep13_) {
        int ln = lane; asm volatile("" : "+v"(ln));
        for (int m = gw; m < NPR; m += 2 * NGW) {
            RowRegs2 ra, rb; const int m2 = (m + NGW < NPR) ? m + NGW : m;
            row_load2(ra, X1 + (size_t)m * DM, (const bf16*)O32 + (size_t)m * DM, XN + (size_t)m * DM, ln); row_load2(rb, X1 + (size_t)m2 * DM, (const bf16*)O32 + (size_t)m2 * DM, XN + (size_t)m2 * DM, ln);
            row_finish2(ra, mix_post, ffn2_post, 0.5f, out + (size_t)m * DM, ln);
            row_finish2(rb, mix_post, ffn2_post, 0.5f, out + (size_t)m2 * DM, ln);
        }
        for (int m = NPR + gw; m < MT; m += NGW)
            row_post<false>(X1 + (size_t)m * DM, PART + (size_t)(m - NPR) * DM, DFF / 256, (size_t)NSA * DM, ffn2_post, 0.5f, out + (size_t)m * DM, nullptr, nullptr, ln);
    }}

#undef IN
#undef SEAM
}

#undef x_prompt
#undef x_sample
#undef cache_cmp
#undef cache_slc
#undef cache_win
#undef state_ssm
#undef state_conv
#undef page_table
#undef rel_table
#undef ffn1_pre
#undef ffn1_post
#undef ffn1_w_in
#undef ffn1_w_out
#undef mix_pre
#undef mix_post
#undef w_in
#undef w_out
#undef att_out_norm
#undef cmp_pe
#undef w_cmp
#undef conv_w
#undef conv_b
#undef dt_bias
#undef a_log
#undef d_skip
#undef ssd_norm
#undef ffn2_pre
#undef ffn2_post
#undef ffn2_w_in
#undef ffn2_w_out
#undef W1A
#undef W1B
#undef WIN
#undef WOUT
#undef W2A
#undef W2B
#undef WCF
#undef PEB
#undef WCFL
#undef QS32
#undef KCS32
#undef GATES
#undef DTR
#undef SSQA
#undef SSQY
#undef DC
#undef KCP
#undef KCS
#undef XN
#undef QB
#undef CKV
#undef SKV
#undef WKV
#undef ZB
#undef XBC
#undef ACT
#undef O32
#undef X1
#undef MIX
#undef STB
#undef PART
#undef KMP
#undef XCV
#undef BCV
#undef CCV
#undef SCV
extern "C" void kernel_launch(void* const* d_in, const int* in_sizes, int n_in, void* d_out, int out_size, void* d_ws, size_t ws_size, hipStream_t stream) {
    static int grid = 0;
    if (grid == 0) {
        if (n_in != 30 || out_size != (int)O_END || ws_size < WS_END) { fprintf(stderr, "kernel_launch: unexpected shapes n_in %d out %d ws %zu\n", n_in, out_size, ws_size); grid = -1; return; }
        int dev = 0, cus = 0, per_cu = 0;
        if (hipGetDevice(&dev) != hipSuccess || hipDeviceGetAttribute(&cus, hipDeviceAttributeMultiprocessorCount, dev) != hipSuccess) { grid = -1; return; }
        if (hipFuncSetAttribute((const void*)mk_fwd, hipFuncAttributeMaxDynamicSharedMemorySize, LDS_BYTES) != hipSuccess) { fprintf(stderr, "kernel_launch: hipFuncSetAttribute failed\n"); grid = -1; return; }
        if (hipOccupancyMaxActiveBlocksPerMultiprocessor(&per_cu, (const void*)mk_fwd, NWAVES * 64, LDS_BYTES) != hipSuccess || per_cu < 1) { fprintf(stderr, "kernel_launch: occupancy query says %d\n", per_cu); }
        (void)hipGetLastError();
        grid = cus;
    }
    if (grid < 0) return;
    if (hipMemsetAsync((char*)d_ws + WS_CTL, 0, CTL_ZERO_BYTES, stream) != hipSuccess) return;
    Args a{};
    for (int i = 0; i < 30; ++i) a.in[i] = (const float*)d_in[i];
    a.out = (float*)d_out; a.ws = (unsigned char*)d_ws; a.ph_lo = 0; a.ph_hi = N_PHASES;
    hipLaunchKernelGGL(mk_fwd, dim3(grid), dim3(NWAVES * 64), LDS_BYTES, stream, a);
}
```
